# Optimizing an MI355X kernel written in HIP

```python
import math
import jax, jax.numpy as jnp
from jax import lax
import numpy as np

D_MODEL = 1024
BATCH = 8
SEQ = 4096
DEPTH = 2

N_MIXERS = 2
BLOCK_Q = 128
DA_HEADS = 8
DA_HEAD_DIM = 64
SB_HEADS = 16
SB_HEAD_DIM = 64
REL_BUCKETS = 32
REL_MAX_DIST = 128
MOE_GROUPS = 4
MOE_EXPERTS_PER_GROUP = 8
MOE_TOP_K = 2
MOE_HIDDEN = 512
N_EXPERTS = MOE_GROUPS * MOE_EXPERTS_PER_GROUP
DEEPNORM_ALPHA = (2 * DEPTH) ** 0.25
DEEPNORM_BETA = (8 * DEPTH) ** -0.25
LN_EPS = 1e-5
RMS_EPS = 1e-6
NEG_INF = -1e30
N_DA_LAYERS = (DEPTH + 1) // 2
N_SB_LAYERS = DEPTH // 2

kernel_name = "hybrid_diffattn_stickbreak_hmoe_deepnorm"


def layer_norm(x, g, b):
    xf = x.astype(jnp.float32)
    mu = jnp.mean(xf, axis=-1, keepdims=True)
    xc = xf - mu
    var = jnp.mean(xc * xc, axis=-1, keepdims=True)
    return (xc * lax.rsqrt(var + LN_EPS) * g.astype(jnp.float32) + b.astype(jnp.float32)).astype(x.dtype)


def rel_bucket(q_pos, k_pos):
    n = jnp.maximum(q_pos[:, None] - k_pos[None, :], 0)
    max_exact = REL_BUCKETS // 2
    nf = jnp.maximum(n, 1).astype(jnp.float32)
    large = max_exact + (jnp.log(nf / max_exact) / math.log(REL_MAX_DIST / max_exact)
                         * (REL_BUCKETS - max_exact)).astype(jnp.int32)
    large = jnp.minimum(large, REL_BUCKETS - 1)
    return jnp.where(n < max_exact, n, large)


def diff_attention(x, wq, wk, wv, wo, lq1, lk1, lq2, lk2, subln_g, rel_table, layer_idx):
    b, s, _ = x.shape
    q = (x @ wq).reshape(b, s, DA_HEADS, 2, DA_HEAD_DIM)
    k = (x @ wk).reshape(b, s, DA_HEADS, 2, DA_HEAD_DIM)
    v = (x @ wv).reshape(b, s, DA_HEADS, 2 * DA_HEAD_DIM)
    lam_init = 0.8 - 0.6 * math.exp(-0.3 * layer_idx)
    f32 = jnp.float32
    lam = (jnp.exp(jnp.sum(lq1.astype(f32) * lk1.astype(f32)))
           - jnp.exp(jnp.sum(lq2.astype(f32) * lk2.astype(f32))) + lam_init)
    k_pos = jnp.arange(s)
    scale = DA_HEAD_DIM ** -0.5
    g = subln_g.astype(f32)

    def block(i):
        start = i * BLOCK_Q
        qb = lax.dynamic_slice_in_dim(q, start, BLOCK_Q, axis=1)
        q_pos = start + jnp.arange(BLOCK_Q)
        bias = jnp.transpose(rel_table[rel_bucket(q_pos, k_pos)], (2, 0, 1)).astype(f32)
        logits = jnp.einsum('bqhcd,bkhcd->bhcqk', qb, k).astype(f32) * scale + bias[None, :, None]
        causal = k_pos[None, :] <= q_pos[:, None]
        logits = jnp.where(causal, logits, NEG_INF)
        p = jax.nn.softmax(logits, axis=-1)
        attn = p[:, :, 0] - lam * p[:, :, 1]
        o = jnp.einsum('bhqk,bkhe->bqhe', attn.astype(x.dtype), v).astype(f32)
        o = o * lax.rsqrt(jnp.mean(o * o, axis=-1, keepdims=True) + RMS_EPS) * g
        return (o * (1.0 - lam_init)).astype(x.dtype)

    blocks = lax.map(block, jnp.arange(s // BLOCK_Q))
    o = jnp.moveaxis(blocks, 0, 1).reshape(b, s, DA_HEADS * 2 * DA_HEAD_DIM)
    return o @ wo


def stick_breaking(x, wq, wk, wv, wo):
    b, s, _ = x.shape
    q = (x @ wq).reshape(b, s, SB_HEADS, SB_HEAD_DIM)
    k = (x @ wk).reshape(b, s, SB_HEADS, SB_HEAD_DIM)
    v = (x @ wv).reshape(b, s, SB_HEADS, SB_HEAD_DIM)
    k_pos = jnp.arange(s)
    scale = SB_HEAD_DIM ** -0.5

    def block(i):
        start = i * BLOCK_Q
        qb = lax.dynamic_slice_in_dim(q, start, BLOCK_Q, axis=1)
        q_pos = start + jnp.arange(BLOCK_Q)
        z = jnp.einsum('bqhd,bkhd->bhqk', qb, k).astype(jnp.float32) * scale
        strict = k_pos[None, :] < q_pos[:, None]
        log_fail = jnp.where(strict, jax.nn.log_sigmoid(-z), 0.0)
        later = lax.cumsum(log_fail, axis=3, reverse=True) - log_fail
        w = jnp.where(strict, jnp.exp(jax.nn.log_sigmoid(z) + later), 0.0)
        return jnp.einsum('bhqk,bkhd->bqhd', w.astype(x.dtype), v)

    blocks = lax.map(block, jnp.arange(s // BLOCK_Q))
    o = jnp.moveaxis(blocks, 0, 1).reshape(b, s, SB_HEADS * SB_HEAD_DIM)
    return o @ wo


def hier_moe(x, w_group, b_group, w_expert, b_expert, w1, w3, w2):
    b, s, d = x.shape
    t = b * s
    f32 = jnp.float32
    xt = x.reshape(t, d)
    g_prob = jax.nn.softmax((xt @ w_group + b_group).astype(f32), axis=-1)
    g_gate, g_idx = lax.top_k(g_prob, 1)
    e_logits = (xt @ w_expert + b_expert).astype(f32).reshape(t, MOE_GROUPS, MOE_EXPERTS_PER_GROUP)
    e_logits = jnp.take_along_axis(e_logits, g_idx[:, :, None], axis=1)[:, 0]
    e_prob = jax.nn.softmax(e_logits, axis=-1)
    e_gate, e_idx = lax.top_k(e_prob, MOE_TOP_K)
    e_gate = e_gate / jnp.sum(e_gate, axis=-1, keepdims=True)
    weight = g_gate * e_gate
    expert_id = g_idx * MOE_EXPERTS_PER_GROUP + e_idx
    gates = jnp.sum(jax.nn.one_hot(expert_id, N_EXPERTS, dtype=f32) * weight[..., None], axis=1)

    def step(acc, ew):
        w1e, w3e, w2e, ge = ew
        h = jax.nn.silu(xt @ w1e) * (xt @ w3e)
        return acc + ge[:, None] * (h @ w2e).astype(f32), None

    y, _ = lax.scan(step, jnp.zeros((t, d), f32), (w1, w3, w2, gates.T))
    return y.astype(x.dtype).reshape(b, s, d)


def setup_inputs(seed: int = 0) -> dict:
    key = jax.random.key(seed)
    ks = jax.random.split(key, 26)
    nrm = jax.random.normal
    D = D_MODEL
    da_qk = DA_HEADS * 2 * DA_HEAD_DIM
    da_v = DA_HEADS * 2 * DA_HEAD_DIM
    sb_w = SB_HEADS * SB_HEAD_DIM
    inv = D ** -0.5
    return {
        "x": nrm(ks[0], (BATCH, SEQ, D), jnp.float32),
        "rel_table": 0.5 * nrm(ks[1], (REL_BUCKETS, DA_HEADS), jnp.float32),
        "da_wq": inv * nrm(ks[2], (N_DA_LAYERS, D, da_qk), jnp.float32),
        "da_wk": inv * nrm(ks[3], (N_DA_LAYERS, D, da_qk), jnp.float32),
        "da_wv": DEEPNORM_BETA * inv * nrm(ks[4], (N_DA_LAYERS, D, da_v), jnp.float32),
        "da_wo": DEEPNORM_BETA * da_v ** -0.5 * nrm(ks[5], (N_DA_LAYERS, da_v, D), jnp.float32),
        "da_lq1": 0.1 * nrm(ks[6], (N_DA_LAYERS, DA_HEAD_DIM), jnp.float32),
        "da_lk1": 0.1 * nrm(ks[7], (N_DA_LAYERS, DA_HEAD_DIM), jnp.float32),
        "da_lq2": 0.1 * nrm(ks[8], (N_DA_LAYERS, DA_HEAD_DIM), jnp.float32),
        "da_lk2": 0.1 * nrm(ks[9], (N_DA_LAYERS, DA_HEAD_DIM), jnp.float32),
        "da_subln_g": 1.0 + 0.02 * nrm(ks[10], (N_DA_LAYERS, 2 * DA_HEAD_DIM), jnp.float32),
        "sb_wq": inv * nrm(ks[11], (N_SB_LAYERS, D, sb_w), jnp.float32),
        "sb_wk": inv * nrm(ks[12], (N_SB_LAYERS, D, sb_w), jnp.float32),
        "sb_wv": DEEPNORM_BETA * inv * nrm(ks[13], (N_SB_LAYERS, D, sb_w), jnp.float32),
        "sb_wo": DEEPNORM_BETA * sb_w ** -0.5 * nrm(ks[14], (N_SB_LAYERS, sb_w, D), jnp.float32),
        "ln_mix_g": 1.0 + 0.02 * nrm(ks[15], (DEPTH, D), jnp.float32),
        "ln_mix_b": 0.02 * nrm(ks[16], (DEPTH, D), jnp.float32),
        "ln_ffn_g": 1.0 + 0.02 * nrm(ks[17], (DEPTH, D), jnp.float32),
        "ln_ffn_b": 0.02 * nrm(ks[18], (DEPTH, D), jnp.float32),
        "moe_w_group": inv * nrm(ks[19], (DEPTH, D, MOE_GROUPS), jnp.float32),
        "moe_b_group": 0.01 * nrm(ks[20], (DEPTH, MOE_GROUPS), jnp.float32),
        "moe_w_expert": inv * nrm(ks[21], (DEPTH, D, N_EXPERTS), jnp.float32),
        "moe_b_expert": 0.01 * nrm(ks[22], (DEPTH, N_EXPERTS), jnp.float32),
        "moe_w1": inv * nrm(ks[23], (DEPTH, N_EXPERTS, D, MOE_HIDDEN), jnp.float32),
        "moe_w3": inv * nrm(ks[24], (DEPTH, N_EXPERTS, D, MOE_HIDDEN), jnp.float32),
        "moe_w2": DEEPNORM_BETA * MOE_HIDDEN ** -0.5 * nrm(ks[25], (DEPTH, N_EXPERTS, MOE_HIDDEN, D), jnp.float32),
    }


def reference(x, rel_table, da_wq, da_wk, da_wv, da_wo, da_lq1, da_lk1, da_lq2, da_lk2, da_subln_g,
              sb_wq, sb_wk, sb_wv, sb_wo, ln_mix_g, ln_mix_b, ln_ffn_g, ln_ffn_b,
              moe_w_group, moe_b_group, moe_w_expert, moe_b_expert, moe_w1, moe_w3, moe_w2):
    for layer in range(DEPTH):
        j = layer // N_MIXERS
        if layer % N_MIXERS == 0:
            mix = diff_attention(x, da_wq[j], da_wk[j], da_wv[j], da_wo[j], da_lq1[j], da_lk1[j],
                                 da_lq2[j], da_lk2[j], da_subln_g[j], rel_table, layer)
        else:
            mix = stick_breaking(x, sb_wq[j], sb_wk[j], sb_wv[j], sb_wo[j])
        x = layer_norm(DEEPNORM_ALPHA * x + mix, ln_mix_g[layer], ln_mix_b[layer])
        ffn = hier_moe(x, moe_w_group[layer], moe_b_group[layer], moe_w_expert[layer],
                       moe_b_expert[layer], moe_w1[layer], moe_w3[layer], moe_w2[layer])
        x = layer_norm(DEEPNORM_ALPHA * x + ffn, ln_ffn_g[layer], ln_ffn_b[layer])
    return x
```

```cpp
#include <hip/hip_runtime.h>
#include <cstdio>
#include <cstdint>
namespace pg8 {
#define PG8_LAS __attribute__((address_space(3)))
typedef unsigned short bf16_t;
typedef short bf16x8 __attribute__((ext_vector_type(8)));
typedef float f32x4 __attribute__((ext_vector_type(4)));
typedef unsigned u32x4 __attribute__((ext_vector_type(4)));
constexpr int BM = 256, BK = 64, HALF = 128, HTB = HALF * BK * 2  , STAGE_BYTES = 8 * HTB, NXCD = 8, WGM = 8;

__host__ __device__ __forceinline__ int lds_byte(int r, int c) { const int st = (r >> 4) * 2 + (c >> 5), rr = r & 15, cc = c & 31, ob = rr * 64 + cc * 2; return st * 1024 + (ob ^ (((ob >> 9) & 1) << 5)); }
__host__ __device__ __forceinline__ void stage_rc(int b, int& R, int& C) { const int st = b / 1024, sb = b % 1024, swz = sb ^ (((sb >> 9) & 1) << 5); R = (st >> 1) * 16 + swz / 64; C = (st & 1) * 32 + (swz % 64) / 2; }
__host__ __device__ __forceinline__ int perm32(int rho) { const int n = rho >> 4, i = rho & 15; return 8 * (i >> 2) + 4 * n + (i & 3); }

struct Unit { int pm, pn; };
struct Gemm { const bf16_t* A; const bf16_t* Bt; int M, N, K; const int* rowidx; };

struct StaticOrder {
    int nM, nN, nwg, G, c;
    __host__ __device__ void init(int M, int N, int G_, int c_) { nM = M / BM; nN = N / BM; nwg = nM * nN; G = G_; c = c_; }
    __host__ __device__ bool next(int i, Unit& u) const {
        const long L = (long)i * G + c; if (L >= nwg) return false;
        int wgid = (int)L; { const int q = nwg / NXCD, r = nwg % NXCD, xcd = wgid % NXCD, off = wgid / NXCD; wgid = (xcd < r ? xcd * (q + 1) : r * (q + 1) + (xcd - r) * q) + off; }
        const int nig = WGM * nN, gid = wgid / nig, fm = gid * WGM, gsz = (nM - fm) < WGM ? (nM - fm) : WGM;
        u.pm = fm + ((wgid % nig) % gsz); u.pn = (wgid % nig) / gsz; return true;
    }
    __device__ __forceinline__ void a_ready(const Unit&) const {}
    __device__ __forceinline__ void done(const Unit&) const {}
};

__device__ __forceinline__ unsigned cvt_pk_bf16(float lo, float hi) { unsigned r; asm volatile("v_cvt_pk_bf16_f32 %0, %1, %2" : "=v"(r) : "v"(lo), "v"(hi)); return r; }
typedef float f32x2 __attribute__((ext_vector_type(2)));
typedef unsigned u32x2 __attribute__((ext_vector_type(2)));
__device__ __forceinline__ void st16_wt(void* p, u32x4 v) { asm volatile("global_store_dwordx4 %0, %1, off sc1\n\ts_nop 1" :: "v"(p), "v"(v) : "memory"); }
template <int PROBE = 0> struct EpiQKV_ {
    static constexpr bool PERM = true, AFTER_DRAIN = false, COLMAP2 = false; static constexpr int VMOPS = 16;
    bf16_t* Q; size_t kv_stride; float scale0;
    __device__ __forceinline__ void operator()(const f32x4 (&acc)[2][2][4][2], const Unit& u, int wr, int wc, int fr, int fq) const {
        if (PROBE == 2) { asm volatile("" :: "v"(acc[0][0][0][0]), "v"(acc[1][1][3][1])); return; }
        const int t = u.pn >> 2; const float sc = t == 0 ? scale0 : 1.f;
        const int Rw0 = u.pm * BM + wr * 64, cw0 = (u.pn & 3) * BM + wc * 32;
        const int lane_off = t == 0 ? fr * 8 + fq * 128 : t == 1 ? fr * 8 + fq * 512 : fr * 32 + 8 * fq;
        bf16_t* base = Q + (size_t)t * kv_stride + lane_off;
#pragma unroll
        for (int ai = 0; ai < 2; ++ai)
#pragma unroll
            for (int m = 0; m < 4; ++m) { const int Rw = Rw0 + ai * HALF + m * 16, bb = Rw >> 12, s = Rw & 4095;
                const size_t ro = t == 0 ? (size_t)bb * 4194304 + (size_t)((s >> 4) * 1024) : t == 1 ? (size_t)bb * 4194304 + (size_t)((s >> 6) * 4096 + (s & 63) * 8) : (size_t)bb * 4194304 + (size_t)((s >> 6) * 2048 + ((s >> 4) & 3) * 512);
#pragma unroll
                for (int bj = 0; bj < 2; ++bj) { const f32x4 v0 = acc[ai][bj][m][0] * sc, v1 = acc[ai][bj][m][1] * sc; const int cw = cw0 + bj * HALF;
                    const size_t co = t == 0 ? (size_t)((cw >> 6) * 262144 + ((cw >> 5) & 1) * 512) : t == 1 ? (size_t)((cw >> 6) * 262144 + ((cw >> 5) & 1) * 2048) : (size_t)((cw >> 5) * 131072);
                    u32x4 w; w.x = cvt_pk_bf16(v0[0], v0[1]); w.y = cvt_pk_bf16(v0[2], v0[3]); w.z = cvt_pk_bf16(v1[0], v1[1]); w.w = cvt_pk_bf16(v1[2], v1[3]);
                    if (PROBE == 0 || PROBE == 4) *(u32x4*)(base + ro + co) = w; else if (PROBE == 3) *(u32x4*)(Q + ((size_t)(blockIdx.x * 512 + threadIdx.x) * 8)) = w; else asm volatile("" :: "v"(w)); } }
    }
};
typedef EpiQKV_<0> EpiQKV;
struct EpiRes {
    static constexpr bool PERM = true, AFTER_DRAIN = false, COLMAP2 = false; static constexpr int VMOPS = 16;
    const bf16_t* __restrict__ xprev; bf16_t* __restrict__ out; float alpha;
    __device__ __forceinline__ void operator()(const f32x4 (&acc)[2][2][4][2], const Unit& u, int wr, int wc, int fr, int fq) const {
        const int row0 = u.pm * BM + wr * 64 + fr; const int col0 = u.pn * BM + wc * 32 + 8 * fq;
#pragma unroll
        for (int ai = 0; ai < 2; ++ai) {
            u32x4 xw[4][2];
#pragma unroll
            for (int m = 0; m < 4; ++m)
#pragma unroll
                for (int bj = 0; bj < 2; ++bj) xw[m][bj] = *(const u32x4*)(xprev + (size_t)(row0 + ai * HALF + m * 16) * 1024 + col0 + bj * HALF);
#pragma unroll
            for (int m = 0; m < 4; ++m)
#pragma unroll
                for (int bj = 0; bj < 2; ++bj) { const u32x4 w = xw[m][bj]; const f32x4 a0 = acc[ai][bj][m][0], a1 = acc[ai][bj][m][1];
                    u32x4 o;
                    o.x = cvt_pk_bf16(__uint_as_float(w.x << 16) * alpha + a0[0], __uint_as_float(w.x & 0xffff0000u) * alpha + a0[1]);
                    o.y = cvt_pk_bf16(__uint_as_float(w.y << 16) * alpha + a0[2], __uint_as_float(w.y & 0xffff0000u) * alpha + a0[3]);
                    o.z = cvt_pk_bf16(__uint_as_float(w.z << 16) * alpha + a1[0], __uint_as_float(w.z & 0xffff0000u) * alpha + a1[1]);
                    o.w = cvt_pk_bf16(__uint_as_float(w.w << 16) * alpha + a1[2], __uint_as_float(w.w & 0xffff0000u) * alpha + a1[3]);
                    *(u32x4*)(out + (size_t)(row0 + ai * HALF + m * 16) * 1024 + col0 + bj * HALF) = o; }
        }
    }
};
struct EpiSwiGLU {
    static constexpr bool PERM = true, AFTER_DRAIN = false, COLMAP2 = false; static constexpr int VMOPS = 8;
    bf16_t* H;
    __device__ __forceinline__ void operator()(const f32x4 (&acc)[2][2][4][2], const Unit& u, int wr, int wc, int fr, int fq) const {
        const int Rw0 = u.pm * BM + wr * 64, chw = (u.pn & 3) * 16 + wc * 4;
        bf16_t* base = H + fq * 128 + fr * 8;
#pragma unroll
        for (int ai = 0; ai < 2; ++ai)
#pragma unroll
            for (int m = 0; m < 4; ++m) { const int Rw = Rw0 + ai * HALF + m * 16; u32x4 w;
#pragma unroll
                for (int bj = 0; bj < 2; ++bj) { const f32x4 a = acc[ai][bj][m][0], b = acc[ai][bj][m][1]; f32x4 hv;
#pragma unroll
                    for (int i = 0; i < 4; ++i) { const float e = __builtin_amdgcn_exp2f(a[i] * -1.4426950408889634f); hv[i] = a[i] * __builtin_amdgcn_rcpf(1.0f + e) * b[i]; }
                    w[2 * bj] = cvt_pk_bf16(hv[0], hv[1]); w[2 * bj + 1] = cvt_pk_bf16(hv[2], hv[3]); }
                *(u32x4*)(base + (size_t)((Rw >> 4) * 64 + chw) * 128) = w; }
    }
};
struct EpiY {
    static constexpr bool PERM = true, AFTER_DRAIN = false, COLMAP2 = true; static constexpr int VMOPS = 16;
    bf16_t* Y;
    __device__ __forceinline__ void operator()(const f32x4 (&acc)[2][2][4][2], const Unit& u, int wr, int wc, int fr, int fq) const {
        const bool lo = fr < 8;
        bf16_t* base = Y + (size_t)(u.pm * BM + wr * 64 + (fr & 7)) * 1024 + (u.pn & 3) * BM + wc * 64 + (fr >> 3) * 32 + 8 * fq;
#pragma unroll
        for (int ai = 0; ai < 2; ++ai)
#pragma unroll
            for (int m = 0; m < 4; ++m) { u32x4 p[2];
#pragma unroll
                for (int bj = 0; bj < 2; ++bj) { const f32x4 v0 = acc[ai][bj][m][0], v1 = acc[ai][bj][m][1];
                    p[bj].x = cvt_pk_bf16(v0[0], v0[1]); p[bj].y = cvt_pk_bf16(v0[2], v0[3]); p[bj].z = cvt_pk_bf16(v1[0], v1[1]); p[bj].w = cvt_pk_bf16(v1[2], v1[3]); }
                u32x4 s1, s2;
#pragma unroll
                for (int c = 0; c < 4; ++c) { const unsigned send = lo ? p[1][c] : p[0][c];
                    const unsigned x = (unsigned)__builtin_amdgcn_update_dpp(0, (int)send, 0x128, 0xf, 0xf, false);
                    s1[c] = lo ? p[0][c] : x; s2[c] = lo ? x : p[1][c]; }
                bf16_t* rp = base + (size_t)(ai * HALF + m * 16) * 1024;
                *(u32x4*)rp = s1; *(u32x4*)(rp + 8 * 1024) = s2; }
    }
};
struct GroupedOrder {
    const PG8_LAS int* tile_e; int ntiles, G, c;
    __device__ __forceinline__ bool next(int i, Unit& u) const {
        const int L = i * G + c; if (L >= ntiles * 4) return false;
        const int pm = L >> 2; u.pm = pm; u.pn = __builtin_amdgcn_readfirstlane(tile_e[pm]) * 4 + (L & 3); return true;
    }
    __device__ __forceinline__ void a_ready(const Unit&) const {}
    __device__ __forceinline__ void done(const Unit&) const {}
};

template <class Epi, class Sched, bool ALIGN_EPI = false, bool SP2 = false, bool GATHER = false, bool AIMG = false, bool PEEL = false>
__device__ __forceinline__ void gemm_phase(PG8_LAS unsigned char* lds, const Gemm g, const Sched& S, const Epi& E) {
    int tid_ = threadIdx.x; asm volatile("" : "+v"(tid_));
    const int tid = tid_, wid = __builtin_amdgcn_readfirstlane(tid >> 6), lane = tid & 63, wr = wid >> 2, wc = wid & 3, fr = lane & 15, fq = lane >> 4;
    const int K = g.K, nt = K / BK;
    static_assert(!GATHER || SP2, "GATHER is written for the SP2 loop");
    unsigned voffA[2], voffB[2], voffA1[2], nvoA[2], nvoA1[2]; int gR[2]; unsigned gC2[2];
#pragma unroll
    for (int i = 0; i < 2; ++i) { int R, C; stage_rc(tid * 16 + i * 8192, R, C); const int Rb = Epi::COLMAP2 ? (64 * (R >> 5) + perm32(R & 31)) : Epi::PERM ? ((R & ~31) + perm32(R & 31)) : R;
        voffA[i] = AIMG ? (unsigned)(((R >> 4) * (K >> 3) + (C >> 3)) * 256 + (R & 15) * 16) : (unsigned)(R * K + C) * 2u; voffB[i] = (unsigned)(Rb * K + C) * 2u; gR[i] = R; gC2[i] = (unsigned)C * 2u; voffA1[i] = voffA[i]; nvoA[i] = voffA[i]; nvoA1[i] = voffA[i]; }
    const size_t kstep = (size_t)(BK * 2);
    const size_t kstepA = AIMG ? (size_t)2048 : kstep;
    const size_t hstep = (size_t)HALF * K * 2;
    const size_t tstep = 2 * hstep;
    const size_t hstepB = Epi::COLMAP2 ? (size_t)32 * K * 2 : hstep;
    const size_t hstepA = GATHER ? (size_t)0 : hstep;
    const unsigned ldsw = (unsigned)wid * 1024u;
    const int aoff = lds_byte(wr * 64 + fr, fq * 8), boff = lds_byte(wc * 32 + fr, fq * 8);
#define PG8_SA(b, h) (((b) * 2 + (h)) * HTB)
#define PG8_SB(b, h) ((4 + (b) * 2 + (h)) * HTB)
#define PG8_STAGE(bufoff, gbase, voff) do { _Pragma("unroll") for (int _i = 0; _i < 2; ++_i) \
        __builtin_amdgcn_global_load_lds((const unsigned*)((const char*)(gbase) + (voff)[_i]), (PG8_LAS unsigned*)(lds + (bufoff) + ldsw + _i * 8192), 16, 0, 0); } while (0)
#define PG8_LDA(dst, b, h) do { _Pragma("unroll") for (int m = 0; m < 4; ++m) _Pragma("unroll") for (int k = 0; k < 2; ++k) dst[m][k] = *(const PG8_LAS bf16x8*)(lds + PG8_SA(b, h) + aoff + m * 2048 + k * 1024); } while (0)
#define PG8_LDB(dst, b, h) do { _Pragma("unroll") for (int n = 0; n < 2; ++n) _Pragma("unroll") for (int k = 0; k < 2; ++k) dst[n][k] = *(const PG8_LAS bf16x8*)(lds + PG8_SB(b, h) + boff + n * 2048 + k * 1024); } while (0)
#define PG8_MMA(ai, bj, At, Bt) do { __builtin_amdgcn_s_setprio(1); _Pragma("unroll") for (int m = 0; m < 4; ++m) _Pragma("unroll") for (int n = 0; n < 2; ++n) _Pragma("unroll") for (int k = 0; k < 2; ++k) \
        acc[ai][bj][m][n] = __builtin_amdgcn_mfma_f32_16x16x32_bf16(Bt[n][k], At[m][k], acc[ai][bj][m][n], 0, 0, 0); __builtin_amdgcn_s_setprio(0); } while (0)
#define PG8_WAIT_V(n) asm volatile("s_waitcnt vmcnt(" #n ")" ::: "memory")
#define PG8_WAIT_VX(n) asm volatile("s_waitcnt vmcnt(%0)" :: "n"(n) : "memory")
#define PG8_WAIT_L(n) asm volatile("s_waitcnt lgkmcnt(" #n ")" ::: "memory")
#define PG8_BAR __builtin_amdgcn_s_barrier()
#define PG8_SCHED __builtin_amdgcn_sched_barrier(0)
    Unit cur, nxt; int ui = 0;
    if (!S.next(0, cur)) return;
    f32x4 acc[2][2][4][2];
#pragma unroll
    for (int a = 0; a < 2; ++a)
#pragma unroll
        for (int b = 0; b < 2; ++b)
#pragma unroll
            for (int m = 0; m < 4; ++m)
#pragma unroll
                for (int n = 0; n < 2; ++n) acc[a][b][m][n] = (f32x4){0.f, 0.f, 0.f, 0.f};
    bf16x8 At[4][2], B0[2][2], B1[2][2];
    const char* cA = GATHER ? (const char*)g.A : (const char*)g.A + (size_t)cur.pm * tstep; const char* cB = (const char*)g.Bt + (size_t)cur.pn * tstep;
    if constexpr (GATHER) {
        typedef const __attribute__((address_space(1))) int* gip_; const gip_ rix = (gip_)g.rowidx + cur.pm * BM;
        const int r0_ = rix[gR[0]], r1_ = rix[gR[1]], r2_ = rix[HALF + gR[0]], r3_ = rix[HALF + gR[1]];
        __builtin_amdgcn_sched_barrier(0);
        voffA[0] = (unsigned)r0_ * (unsigned)(K * 2) + gC2[0]; voffA[1] = (unsigned)r1_ * (unsigned)(K * 2) + gC2[1]; voffA1[0] = (unsigned)r2_ * (unsigned)(K * 2) + gC2[0]; voffA1[1] = (unsigned)r3_ * (unsigned)(K * 2) + gC2[1];
#pragma unroll
        for (int i = 0; i < 2; ++i) { nvoA[i] = voffA[i]; nvoA1[i] = voffA1[i]; } }
    S.a_ready(cur);
    if constexpr (SP2) {
        PG8_STAGE(PG8_SB(0, 0), cB, voffB); PG8_STAGE(PG8_SB(0, 1), cB + hstepB, voffB); PG8_STAGE(PG8_SA(0, 0), cA, voffA); PG8_STAGE(PG8_SA(0, 1), cA + hstepA, voffA1);
        if (wr == 1) PG8_BAR;
        PG8_WAIT_V(2); PG8_BAR;
        PG8_STAGE(PG8_SB(1, 0), cB + kstep, voffB); PG8_STAGE(PG8_SA(1, 0), cA + kstepA, voffA); PG8_STAGE(PG8_SB(1, 1), cB + hstepB + kstep, voffB);
        PG8_WAIT_V(6); PG8_BAR;
    } else {
        PG8_STAGE(PG8_SB(0, 0), cB, voffB); PG8_STAGE(PG8_SA(0, 0), cA, voffA); PG8_STAGE(PG8_SB(0, 1), cB + hstepB, voffB); PG8_STAGE(PG8_SA(0, 1), cA + hstep, voffA);
        if (wr == 1) PG8_BAR;
        PG8_WAIT_V(4); PG8_BAR;
        PG8_STAGE(PG8_SB(1, 0), cB + kstep, voffB); PG8_STAGE(PG8_SA(1, 0), cA + kstepA, voffA); PG8_STAGE(PG8_SB(1, 1), cB + hstepB + kstep, voffB);
        PG8_WAIT_V(6); PG8_BAR;
    }
    for (;;) {
        const bool has_next = S.next(ui + 1, nxt);
        const char* nA = GATHER ? (const char*)g.A : (has_next ? (const char*)g.A + (size_t)nxt.pm * tstep : cA); const char* nB = has_next ? (const char*)g.Bt + (size_t)nxt.pn * tstep : cB;
        if constexpr (GATHER) {
            if (has_next) { typedef const __attribute__((address_space(1))) int* gip_; const gip_ rix = (gip_)g.rowidx + nxt.pm * BM;
                const int r0_ = rix[gR[0]], r1_ = rix[gR[1]], r2_ = rix[HALF + gR[0]], r3_ = rix[HALF + gR[1]];
                __builtin_amdgcn_sched_barrier(0);
                nvoA[0] = (unsigned)r0_ * (unsigned)(K * 2) + gC2[0]; nvoA[1] = (unsigned)r1_ * (unsigned)(K * 2) + gC2[1]; nvoA1[0] = (unsigned)r2_ * (unsigned)(K * 2) + gC2[0]; nvoA1[1] = (unsigned)r3_ * (unsigned)(K * 2) + gC2[1]; } }
#define PG8_TRIP(WX_) do { \
            const bool last = (t == nt - 2); \
            const bool relax = (ui > 0) && (t == 0); \
            const char* a1 = cA + (size_t)(t + 1) * kstepA; \
            const char* a2 = last ? nA : cA + (size_t)(t + 2) * kstepA; const char* b2 = last ? nB : cB + (size_t)(t + 2) * kstep; \
            const char* a3 = a2 + kstepA; const char* b3 = b2 + kstep; \
            if (last && has_next) S.a_ready(nxt); \
            unsigned so0[2], so1[2]; \
_Pragma("unroll") \
            for (int i = 0; i < 2; ++i) { so0[i] = (GATHER && last) ? nvoA[i] : voffA[i]; so1[i] = (GATHER && last) ? nvoA1[i] : voffA1[i]; } \
            if constexpr (SP2) { \
            PG8_LDB(B0, 0, 0); PG8_LDB(B1, 0, 1); PG8_SCHED; PG8_LDA(At, 0, 0); PG8_STAGE(PG8_SA(1, 1), a1 + hstepA, voffA1); \
            WX_; PG8_WAIT_L(0); PG8_BAR; PG8_MMA(0, 0, At, B0); PG8_MMA(0, 1, At, B1); PG8_BAR; PG8_SCHED; \
            PG8_LDA(At, 0, 1); PG8_STAGE(PG8_SB(0, 0), b2, voffB); PG8_STAGE(PG8_SB(0, 1), b2 + hstepB, voffB); PG8_STAGE(PG8_SA(0, 0), a2, so0); \
            WX_; PG8_WAIT_L(0); PG8_BAR; PG8_MMA(1, 0, At, B0); PG8_MMA(1, 1, At, B1); PG8_BAR; PG8_SCHED; \
            PG8_LDB(B0, 1, 0); PG8_LDB(B1, 1, 1); PG8_SCHED; PG8_LDA(At, 1, 0); PG8_STAGE(PG8_SA(0, 1), a2 + hstepA, so1); \
            PG8_WAIT_V(8); PG8_WAIT_L(0); PG8_BAR; PG8_MMA(0, 0, At, B0); PG8_MMA(0, 1, At, B1); PG8_BAR; PG8_SCHED; \
            PG8_LDA(At, 1, 1); PG8_STAGE(PG8_SB(1, 0), b3, voffB); PG8_STAGE(PG8_SB(1, 1), b3 + hstepB, voffB); PG8_STAGE(PG8_SA(1, 0), a3, so0); \
            PG8_WAIT_V(8); PG8_WAIT_L(0); PG8_BAR; PG8_MMA(1, 0, At, B0); PG8_MMA(1, 1, At, B1); PG8_BAR; PG8_SCHED; \
            } else { \
            PG8_LDB(B0, 0, 0); PG8_SCHED; PG8_LDA(At, 0, 0); PG8_STAGE(PG8_SA(1, 1), a1 + hstep, voffA); \
            PG8_WAIT_L(8); PG8_BAR; PG8_WAIT_L(0); PG8_MMA(0, 0, At, B0); PG8_BAR; PG8_SCHED; \
            PG8_LDB(B1, 0, 1); PG8_STAGE(PG8_SB(0, 0), b2, voffB); \
            PG8_BAR; PG8_WAIT_L(0); PG8_MMA(0, 1, At, B1); PG8_BAR; \
            PG8_LDA(At, 0, 1); PG8_STAGE(PG8_SA(0, 0), a2, voffA); \
            PG8_BAR; PG8_WAIT_L(0); PG8_MMA(1, 0, At, B0); PG8_BAR; PG8_SCHED; \
            PG8_STAGE(PG8_SB(0, 1), b2 + hstepB, voffB); \
            PG8_WAIT_V(6); PG8_BAR; PG8_MMA(1, 1, At, B1); PG8_BAR; \
            PG8_LDB(B0, 1, 0); PG8_SCHED; PG8_LDA(At, 1, 0); PG8_STAGE(PG8_SA(0, 1), a2 + hstep, voffA); \
            PG8_WAIT_L(8); PG8_BAR; PG8_WAIT_L(0); PG8_MMA(0, 0, At, B0); PG8_BAR; PG8_SCHED; \
            PG8_LDB(B1, 1, 1); PG8_STAGE(PG8_SB(1, 0), b3, voffB); \
            PG8_BAR; PG8_WAIT_L(0); PG8_MMA(0, 1, At, B1); PG8_BAR; \
            PG8_LDA(At, 1, 1); PG8_STAGE(PG8_SA(1, 0), a3, voffA); \
            PG8_BAR; PG8_WAIT_L(0); PG8_MMA(1, 0, At, B0); PG8_BAR; PG8_SCHED; \
            PG8_STAGE(PG8_SB(1, 1), b3 + hstepB, voffB); \
            PG8_WAIT_V(6); PG8_BAR; PG8_MMA(1, 1, At, B1); PG8_BAR; \
            } \
        } while (0)
        int t = 0;
        if constexpr (PEEL) { if (SP2 && ui > 0) { PG8_TRIP(PG8_WAIT_VX(8 + Epi::VMOPS)); t = 2; } }
        for (; t < nt; t += 2) { PG8_TRIP(PG8_WAIT_V(8)); }
#undef PG8_TRIP
        if constexpr (ALIGN_EPI) { if (wr == 0) PG8_BAR; }
        if constexpr (!Epi::AFTER_DRAIN) { int t2_ = threadIdx.x; asm volatile("" : "+v"(t2_)); E(acc, cur, wr, wc, t2_ & 15, (t2_ & 63) >> 4); S.done(cur); }
        if (!has_next) break;
#pragma unroll
        for (int a = 0; a < 2; ++a)
#pragma unroll
            for (int b = 0; b < 2; ++b)
#pragma unroll
                for (int m = 0; m < 4; ++m)
#pragma unroll
                    for (int n = 0; n < 2; ++n) acc[a][b][m][n] = (f32x4){0.f, 0.f, 0.f, 0.f};
        cur = nxt; cA = nA; cB = nB; ++ui;
        if constexpr (GATHER) {
#pragma unroll
            for (int i = 0; i < 2; ++i) { voffA[i] = nvoA[i]; voffA1[i] = nvoA1[i]; } }
        if constexpr (ALIGN_EPI) { if (wr == 1) PG8_BAR; }
    }
    PG8_WAIT_V(0);
    if constexpr (!ALIGN_EPI) { if (wr == 0) PG8_BAR; }
    PG8_BAR;
    if constexpr (Epi::AFTER_DRAIN) { E.fused(acc, cur, wr, wc, fr, fq, lds, wid, lane); S.done(cur); }
#undef PG8_SA
#undef PG8_SB
#undef PG8_STAGE
#undef PG8_LDA
#undef PG8_LDB
#undef PG8_MMA
#undef PG8_WAIT_V
#undef PG8_WAIT_VX
#undef PG8_WAIT_L
#undef PG8_BAR
#undef PG8_SCHED
}
}
#define GAS __attribute__((address_space(1)))
#define LAS __attribute__((address_space(3)))
typedef unsigned short bf16;
typedef short bf16x8 __attribute__((ext_vector_type(8)));
typedef short s16x4 __attribute__((ext_vector_type(4)));
typedef short v4i16_t __attribute__((ext_vector_type(4)));
typedef float f32x4 __attribute__((ext_vector_type(4)));
typedef float f32x16 __attribute__((ext_vector_type(16)));
typedef unsigned u32x4 __attribute__((ext_vector_type(4)));
typedef unsigned u32x2 __attribute__((ext_vector_type(2)));
typedef GAS unsigned gu32;
constexpr int NB = 8, SEQ = 4096, DM = 1024, T = NB * SEQ;
constexpr int NEXP = 32, HID = 512, SLOT_ROWS = 73728, MAX_TILES = SLOT_ROWS / 256;
constexpr int NCHUNK = T / 128;
constexpr float LOG2E = 1.4426950408889634f;
constexpr float C2 = 0.125f * LOG2E;
constexpr float ALPHA = 1.4142135623730951f;
constexpr float LN_EPS = 1e-5f, RMS_EPS = 1e-6f;
constexpr float LAM_INIT = 0.2f;

namespace att {
constexpr int KSLOT = 8192, VSLOT = 16384, LDS_V = 2 * KSLOT, SBSLOT = 16384, SBRING = 6, LDS_O1S = 65536, LDS_LUT = 131072, LDS_FLG = LDS_LUT + 1280, ATT_LDS = LDS_FLG + 64, LDS_GAIN = ATT_LDS, LDS_REL = LDS_GAIN + 512;
typedef LAS const unsigned char* lcp;
__device__ __forceinline__ void glds16(const void* gsrc, unsigned lds_dst) { unsigned keep;
    asm volatile("s_mov_b32 %0, m0\n\ts_mov_b32 m0, %2\n\ts_nop 0\n\tglobal_load_lds_dwordx4 %1, off\n\ts_mov_b32 m0, %0" : "=&s"(keep) : "v"(gsrc), "s"(lds_dst) : "memory"); }
typedef float f32x2_t __attribute__((ext_vector_type(2))); typedef __bf16 bf16x2_t __attribute__((ext_vector_type(2)));
__device__ __forceinline__ unsigned cvtpk(float lo, float hi) { f32x2_t v = {lo, hi}; bf16x2_t b = __builtin_convertvector(v, bf16x2_t); return __builtin_bit_cast(unsigned, b); }
__device__ __forceinline__ s16x4 vtr(lcp p) { return __builtin_bit_cast(s16x4, __builtin_amdgcn_ds_read_tr16_b64_v4i16((LAS v4i16_t*)p)); }
#define ATT_MFMA(a, b, c) __builtin_amdgcn_mfma_f32_32x32x16_bf16((a), (b), (c), 0, 0, 0)
__device__ __forceinline__ float max3f(float a, float b, float c) { float r; asm("v_max3_f32 %0, %1, %2, %3" : "=v"(r) : "v"(a), "v"(b), "v"(c)); return r; }
__device__ __forceinline__ float max2f(float a, float b) { float r; asm("v_max_f32_e32 %0, %1, %2" : "=v"(r) : "v"(a), "v"(b)); return r; }
__device__ __forceinline__ float fadd_s(float a, float b) { float r; asm("v_add_f32_e32 %0, %1, %2" : "=v"(r) : "v"(a), "v"(b)); return r; }

template <int MODE, int VAR = 0>
__device__ __forceinline__ void attn_unit(LAS unsigned char* lds, const bf16* Qb, const bf16* Kb, const bf16* Vb, bf16* Ob,
                                          int b, int qcol0, int vcol0, int qb, const float* rel_table, int h, int cmap = 0, float lam = 0.f, const float* subg = nullptr) {
    constexpr int NDQ = MODE == 0 ? 4 : 2;
    int tid_ = threadIdx.x; asm volatile("" : "+v"(tid_));
    const int tid = tid_, lane = tid & 63, r32 = lane & 31, hi = lane >> 5;
    const int wid = __builtin_amdgcn_readfirstlane(tid >> 6);
    const long rowbase = (long)b * SEQ; const int q0 = qb * 256, qw0 = q0 + wid * 32;
    const unsigned lds0 = (unsigned)(uintptr_t)lds;
    asm volatile("s_waitcnt vmcnt(0) lgkmcnt(0)\n\ts_barrier" ::: "memory");
    if (MODE == 1 && tid < 16) ((LAS int*)(lds + LDS_FLG))[tid] = 0;
    if (MODE == 0) {
        if (tid < 320) {
            const int n = tid < 64 ? 0 : tid - 64; int bk = n;
            if (n >= 16) { const float v = __logf((float)n * 0.0625f) / 2.0794415416798357f * 16.0f; bk = 16 + (int)v; bk = bk > 31 ? 31 : bk; }
            { const LAS float* relL = (const LAS float*)(lds + LDS_REL);
              ((LAS float*)(lds + LDS_LUT))[tid] = (relL[bk * 8 + h] - relL[31 * 8 + h]) * LOG2E; }
        }
    }
    const bf16* ksrc = Kb + (((long)b * 16 + (qcol0 >> 6)) * 64) * 4096 + wid * 512 + lane * 8;
    const bf16* vsrc = Vb + (((long)b * 32 + (vcol0 >> 5) + (wid >> 2)) * 64) * 2048 + (wid & 3) * 512 + lane * 8;
#define ATT_KOFF(t, ii) (MODE == 0 ? ((ii) & 1) * KSLOT : ((t) % SBRING) * SBSLOT)
#define ATT_VOFF(t, ii) (MODE == 0 ? LDS_V + ((ii) % 3) * VSLOT : ((t) % SBRING) * SBSLOT + 8192)
#define ATT_DMA(t, ii) do { const long ko_ = (long)(t) * 4096, vo_ = (long)(t) * 2048; const unsigned kb_ = lds0 + (unsigned)ATT_KOFF(t, ii) + (unsigned)wid * 1024u, vb_ = lds0 + (unsigned)ATT_VOFF(t, ii) + (unsigned)wid * 1024u; \
        glds16(ksrc + ko_, (unsigned)__builtin_amdgcn_readfirstlane(kb_)); glds16(vsrc + vo_, (unsigned)__builtin_amdgcn_readfirstlane(vb_)); \
        if (MODE == 0) glds16(vsrc + vo_ + 2 * 64 * 2048, (unsigned)__builtin_amdgcn_readfirstlane(vb_ + 8192u)); } while (0)
    const int NT = 4 * qb + 4;
    const int dg = 4 * qb + (wid >> 1);
    if (VAR != 2) { if (MODE == 0) ATT_DMA(0, 0); else { ATT_DMA(NT - 1, 0); ATT_DMA(NT - 2, 0); ATT_DMA(NT - 3, 0); ATT_DMA(NT - 4, 0); } }
    bf16x8 qr[4];
    { const int sq = qw0 + r32; const bf16* Qw = Qb + ((((long)b * 16 + (qcol0 >> 6)) * 256 + (sq >> 4)) * 1024 + (sq & 15) * 8 + hi * 128);
#pragma unroll
      for (int d0 = 0; d0 < 4; ++d0) qr[d0] = *(const bf16x8*)(Qw + d0 * 256); }
    asm volatile("" : "+v"(qr[0]), "+v"(qr[1]), "+v"(qr[2]), "+v"(qr[3]));
    f32x16 o[NDQ];
#pragma unroll
    for (int d = 0; d < NDQ; ++d)
#pragma unroll
        for (int r = 0; r < 16; ++r) o[d][r] = 0.f;
    float mrun = 0.f, lrun = 0.f, Rrun = MODE == 1 ? 1.f : 0.f;
    bool anyref = false;
    const int vlane = ((lane >> 4) & 1) * 32 + (lane & 3) * 8 + (4 * hi + ((lane & 15) >> 2)) * 64;
    u32x4 pw[4]; int pvslot = LDS_V; bool pend = false; const bool late = wid >= 4;
#define ATT_VRD(buf, d) do { _Pragma("unroll") for (int ks = 0; ks < 4; ++ks) { buf[2 * ks] = vtr(vp_ + (d) * 4096 + ks * 1024); buf[2 * ks + 1] = vtr(vp_ + (d) * 4096 + ks * 1024 + 512); } } while (0)
#define ATT_VMM(buf, d) do { _Pragma("unroll") for (int ks = 0; ks < 4; ++ks) { const bf16x8 vf_ = (bf16x8){buf[2 * ks][0], buf[2 * ks][1], buf[2 * ks][2], buf[2 * ks][3], buf[2 * ks + 1][0], buf[2 * ks + 1][1], buf[2 * ks + 1][2], buf[2 * ks + 1][3]}; \
        o[d] = ATT_MFMA(vf_, __builtin_bit_cast(bf16x8, pw[ks]), o[d]); } } while (0)
#define ATT_PV(vs) do { lcp vp_ = (lcp)(lds + (vs)) + vlane; s16x4 va_[8], vb_[8]; \
        ATT_VRD(va_, 0); ATT_VRD(vb_, 1); __builtin_amdgcn_sched_barrier(0); ATT_VMM(va_, 0); \
        if (NDQ == 4) { ATT_VRD(va_, 2); __builtin_amdgcn_sched_barrier(0); ATT_VMM(vb_, 1); ATT_VRD(vb_, 3); __builtin_amdgcn_sched_barrier(0); ATT_VMM(va_, 2); __builtin_amdgcn_sched_barrier(0); ATT_VMM(vb_, NDQ - 1); } \
        else { __builtin_amdgcn_sched_barrier(0); ATT_VMM(vb_, 1); } } while (0)
    for (int i = 0; i < NT; ++i) {
        const int t = MODE == 0 ? i : dg - i;
        asm volatile("s_waitcnt vmcnt(0) lgkmcnt(0)\n\ts_barrier" ::: "memory");
        if (MODE == 1 && i > 0) {
            const LAS int* fl = (const LAS int*)(lds + LDS_FLG) + ((i - 1) & 1) * 8;
            const int all_done = fl[0] & fl[1] & fl[2] & fl[3] & fl[4] & fl[5] & fl[6] & fl[7];
            if (__builtin_amdgcn_readfirstlane(all_done)) break;
        }
        if (VAR != 2) { if (MODE == 0) { if (i + 1 < NT) ATT_DMA(i + 1, i + 1); } else if (NT - 5 - i >= 0) ATT_DMA(NT - 5 - i, 0); }
        if (VAR == 1) continue;
        if (late && pend) { ATT_PV(pvslot); pend = false; }
        const int k0 = 64 * t;
        if (MODE == 0 ? (k0 > qw0 + 31) : (t < 0)) { if (MODE == 1 && lane == 0) ((LAS int*)(lds + LDS_FLG))[(i & 1) * 8 + wid] = 1; continue; }
        lcp kp = (lcp)(lds + ATT_KOFF(t, i)) + hi * 1024 + r32 * 16;
        const int qrel = qw0 + r32 - k0 - 4 * hi;
        f32x16 p0, p1;
        if (MODE == 0) {
            const bool nearb = (qw0 - k0) < 176;
            { bf16x8 kf[8];
#pragma unroll
              for (int j = 0; j < 8; ++j) kf[j] = *(LAS const bf16x8*)(kp + (j >> 1) * 2048 + (j & 1) * 512);
              __builtin_amdgcn_sched_barrier(0);
              { f32x16 z_; _Pragma("unroll") for (int r = 0; r < 16; ++r) z_[r] = 0.f; p0 = ATT_MFMA(kf[0], qr[0], z_); p1 = ATT_MFMA(kf[1], qr[0], z_); }
#pragma unroll
              for (int d0 = 1; d0 < 4; ++d0) { p0 = ATT_MFMA(kf[2 * d0], qr[d0], p0); p1 = ATT_MFMA(kf[2 * d0 + 1], qr[d0], p1); } }
            __builtin_amdgcn_sched_barrier(0);
            if (nearb) {
                unsigned lb_ = lds0 + (unsigned)LDS_LUT + 4u * (unsigned)(qrel + 5); asm volatile("" : "+v"(lb_));
                float bia[32];
#pragma unroll
                for (int r = 0; r < 16; ++r) { bia[r] = *(const LAS float*)(uintptr_t)(lb_ + 4u * (unsigned)(59 - ((r & 3) + 8 * (r >> 2)))); bia[16 + r] = *(const LAS float*)(uintptr_t)(lb_ + 4u * (unsigned)(27 - ((r & 3) + 8 * (r >> 2)))); }
                __builtin_amdgcn_sched_barrier(0);
#pragma unroll
                for (int r = 0; r < 16; ++r) { p0[r] += bia[r]; p1[r] += bia[16 + r]; }
                if (k0 + 63 > qw0) {
#pragma unroll
                    for (int r = 0; r < 16; ++r) { const int n0 = qrel - ((r & 3) + 8 * (r >> 2)), n1 = n0 - 32;
                        p0[r] = n0 >= 0 ? p0[r] : -INFINITY; p1[r] = n1 >= 0 ? p1[r] : -INFINITY; }
                }
            }
            if (anyref) {
#pragma unroll
                for (int r = 0; r < 16; ++r) { p0[r] -= mrun; p1[r] -= mrun; } }
            asm volatile("s_nop 15\n\ts_nop 7" : "+v"(p0), "+v"(p1));
            if (VAR != 3) {
            float rm;
            { float a = max3f(p0[0], p0[1], p1[0]), b = max3f(p0[2], p0[3], p1[1]); a = max3f(a, p1[2], p1[3]);
#pragma unroll
              for (int r = 4; r < 16; r += 4) { a = max3f(a, p0[r], p0[r + 1]); b = max3f(b, p0[r + 2], p0[r + 3]); a = max3f(a, p1[r], p1[r + 1]); b = max3f(b, p1[r + 2], p1[r + 3]); }
              rm = max2f(a, b);
              const auto rr = __builtin_amdgcn_permlane32_swap(__float_as_uint(rm), __float_as_uint(rm), false, false); rm = max2f(__uint_as_float(rr[0]), __uint_as_float(rr[1])); }
            if (__any(rm > 8.0f)) {
                const float dl = fmaxf(rm, 0.f); mrun += dl; const float f = __builtin_amdgcn_exp2f(-dl); lrun *= f;
                anyref = true;
#pragma unroll
                for (int r = 0; r < 16; ++r) { p0[r] -= dl; p1[r] -= dl; }
#pragma unroll
                for (int d = 0; d < NDQ; ++d)
#pragma unroll
                    for (int r = 0; r < 16; ++r) o[d][r] *= f;
            }
            float ls0 = 0.f, ls1 = 0.f;
#pragma unroll
            for (int r = 0; r < 16; ++r) { p0[r] = __builtin_amdgcn_exp2f(p0[r]); p1[r] = __builtin_amdgcn_exp2f(p1[r]); ls0 += p0[r]; ls1 += p1[r]; asm volatile("" : "+v"(ls0), "+v"(ls1)); }
            lrun += ls0 + ls1;
            } else lrun = 1.f;
        } else {
#pragma unroll
            for (int r = 0; r < 16; ++r) { p0[r] = 0.f; p1[r] = 0.f; }
            { bf16x8 kf[8];
#pragma unroll
              for (int j = 0; j < 8; ++j) kf[j] = *(LAS const bf16x8*)(kp + (j >> 1) * 2048 + (j & 1) * 512);
              __builtin_amdgcn_sched_barrier(0);
#pragma unroll
              for (int d0 = 0; d0 < 4; ++d0) { p0 = ATT_MFMA(kf[2 * d0], qr[d0], p0); p1 = ATT_MFMA(kf[2 * d0 + 1], qr[d0], p1); } }
            const bool diag = (k0 + 63 >= qw0);
            f32x16 a0v, a1v;
#pragma unroll
            for (int r = 0; r < 16; ++r) { const int n0 = qrel - ((r & 3) + 8 * (r >> 2)), n1 = n0 - 32;
                const float e0 = __builtin_amdgcn_exp2f(p0[r]), e1 = __builtin_amdgcn_exp2f(p1[r]);
                float x0 = __builtin_amdgcn_rcpf(1.0f + e0), x1 = __builtin_amdgcn_rcpf(1.0f + e1);
                if (diag) { if (n0 <= 0) x0 = 1.f; if (n1 <= 0) x1 = 1.f; }
                a0v[r] = x0; a1v[r] = x1; p0[r] = 1.0f - x0; p1[r] = 1.0f - x1; }
#define ATT_GRP(av, m) ((av[4 * (m)] * av[4 * (m) + 1]) * (av[4 * (m) + 2] * av[4 * (m) + 3]))
#define ATT_XCH(v, lo_, hi_) do { const auto rr_ = __builtin_amdgcn_permlane32_swap(__float_as_uint(v), __float_as_uint(v), false, false); lo_ = __uint_as_float(rr_[0]); hi_ = __uint_as_float(rr_[1]); } while (0)
#define ATT_INGRP(av, wv, m, P0_) do { float P_ = (P0_); wv[4 * (m) + 3] *= P_; P_ *= av[4 * (m) + 3]; wv[4 * (m) + 2] *= P_; P_ *= av[4 * (m) + 2]; wv[4 * (m) + 1] *= P_; P_ *= av[4 * (m) + 1]; wv[4 * (m)] *= P_; } while (0)
#define ATT_SCAN(av, wv, C, Tt) do { \
                const float l0_ = ATT_GRP(av, 0), l1_ = ATT_GRP(av, 1), l2_ = ATT_GRP(av, 2), l3_ = ATT_GRP(av, 3); \
                float G0_, G1_, G2_, G3_, G4_, G5_, G6_, G7_; ATT_XCH(l0_, G0_, G1_); ATT_XCH(l1_, G2_, G3_); ATT_XCH(l2_, G4_, G5_); ATT_XCH(l3_, G6_, G7_); \
                const float S7_ = (C), S6_ = S7_ * G7_, S5_ = S6_ * G6_, S4_ = S5_ * G5_, S3_ = S4_ * G4_, S2_ = S3_ * G3_, S1_ = S2_ * G2_, S0_ = S1_ * G1_; \
                Tt = S0_ * G0_; \
                ATT_INGRP(av, wv, 0, hi ? S1_ : S0_); ATT_INGRP(av, wv, 1, hi ? S3_ : S2_); ATT_INGRP(av, wv, 2, hi ? S5_ : S4_); ATT_INGRP(av, wv, 3, hi ? S7_ : S6_); } while (0)
            float T1, T0;
            ATT_SCAN(a1v, p1, Rrun, T1);
            ATT_SCAN(a0v, p0, T1, T0);
#undef ATT_SCAN
#undef ATT_GRP
#undef ATT_XCH
#undef ATT_INGRP
            Rrun = T0;
            { const int dn = __all(Rrun < 3.5527137e-15f) ? 1 : 0; if (lane == 0) ((LAS int*)(lds + LDS_FLG))[(i & 1) * 8 + wid] = dn; }
        }
        pw[0] = (u32x4){cvtpk(p0[0], p0[1]), cvtpk(p0[2], p0[3]), cvtpk(p0[4], p0[5]), cvtpk(p0[6], p0[7])};
        pw[1] = (u32x4){cvtpk(p0[8], p0[9]), cvtpk(p0[10], p0[11]), cvtpk(p0[12], p0[13]), cvtpk(p0[14], p0[15])};
        pw[2] = (u32x4){cvtpk(p1[0], p1[1]), cvtpk(p1[2], p1[3]), cvtpk(p1[4], p1[5]), cvtpk(p1[6], p1[7])};
        pw[3] = (u32x4){cvtpk(p1[8], p1[9]), cvtpk(p1[10], p1[11]), cvtpk(p1[12], p1[13]), cvtpk(p1[14], p1[15])};
        pvslot = ATT_VOFF(t, i);
        if (VAR != 4) { if (late) pend = true; else ATT_PV(pvslot); } else { asm volatile("" :: "v"(pw[0]), "v"(pw[1]), "v"(pw[2]), "v"(pw[3])); }
    }
    if (late && pend) ATT_PV(pvslot);
    bf16* Ow = Ob + (((rowbase + qw0 + r32) >> 4) * 128 + (vcol0 >> 3) + hi) * 128 + ((qw0 + r32) & 15) * 8;
#define ATT_OST(d, gg, w0, w1) do { const auto sx_ = __builtin_amdgcn_permlane32_swap((w0).x, (w1).x, false, false); const auto sy_ = __builtin_amdgcn_permlane32_swap((w0).y, (w1).y, false, false); \
        *(u32x4*)(Ow + (4 * (d) + 2 * (gg)) * 128) = (u32x4){sx_[0], sy_[0], sx_[1], sy_[1]}; } while (0)
    if (MODE == 0) {
        { const auto rr = __builtin_amdgcn_permlane32_swap(__float_as_uint(lrun), __float_as_uint(lrun), false, false); lrun = __uint_as_float(rr[0]) + __uint_as_float(rr[1]); }
        const float inv = 1.0f / lrun;
        LAS u32x2* stg = (LAS u32x2*)(lds + LDS_O1S + wid * 8192) + lane;
        if (cmap == 0) {
#pragma unroll
            for (int d = 0; d < NDQ; ++d)
#pragma unroll
                for (int g = 0; g < 4; ++g) { u32x2 w; w.x = cvtpk(o[d][4 * g] * inv, o[d][4 * g + 1] * inv); w.y = cvtpk(o[d][4 * g + 2] * inv, o[d][4 * g + 3] * inv); stg[(d * 4 + g) * 64] = w; }
        } else {
            float ss = 0.f;
#pragma unroll
            for (int d = 0; d < NDQ; ++d)
#pragma unroll
                for (int g = 0; g < 4; ++g) { const u32x2 w = stg[(d * 4 + g) * 64];
                    o[d][4 * g] = __uint_as_float(w.x << 16) - lam * (o[d][4 * g] * inv); o[d][4 * g + 1] = __uint_as_float(w.x & 0xffff0000u) - lam * (o[d][4 * g + 1] * inv);
                    o[d][4 * g + 2] = __uint_as_float(w.y << 16) - lam * (o[d][4 * g + 2] * inv); o[d][4 * g + 3] = __uint_as_float(w.y & 0xffff0000u) - lam * (o[d][4 * g + 3] * inv);
                    ss += (o[d][4 * g] * o[d][4 * g] + o[d][4 * g + 1] * o[d][4 * g + 1]) + (o[d][4 * g + 2] * o[d][4 * g + 2] + o[d][4 * g + 3] * o[d][4 * g + 3]); }
            { const auto rr = __builtin_amdgcn_permlane32_swap(__float_as_uint(ss), __float_as_uint(ss), false, false); ss = __uint_as_float(rr[0]) + __uint_as_float(rr[1]); }
            const float rs = (1.0f - LAM_INIT) / sqrtf(ss * (1.0f / 128.0f) + RMS_EPS);
#pragma unroll
            for (int d = 0; d < NDQ; ++d)
#pragma unroll
                for (int g2 = 0; g2 < 2; ++g2) { u32x2 w[2];
#pragma unroll
                    for (int gi = 0; gi < 2; ++gi) { const int g = 2 * g2 + gi; const f32x4 gg = *(const LAS f32x4*)((const LAS float*)(lds + LDS_GAIN) + 32 * d + 8 * g + 4 * hi);
                        w[gi].x = cvtpk(o[d][4 * g] * rs * gg[0], o[d][4 * g + 1] * rs * gg[1]); w[gi].y = cvtpk(o[d][4 * g + 2] * rs * gg[2], o[d][4 * g + 3] * rs * gg[3]); }
                    ATT_OST(d, g2, w[0], w[1]); }
        }
    } else {
#pragma unroll
        for (int d = 0; d < NDQ; ++d)
#pragma unroll
            for (int g2 = 0; g2 < 2; ++g2) { u32x2 w[2];
#pragma unroll
                for (int gi = 0; gi < 2; ++gi) { const int g = 2 * g2 + gi; w[gi].x = cvtpk(o[d][4 * g], o[d][4 * g + 1]); w[gi].y = cvtpk(o[d][4 * g + 2], o[d][4 * g + 3]); }
                ATT_OST(d, g2, w[0], w[1]); }
    }
#undef ATT_OST
#undef ATT_DMA
#undef ATT_KOFF
#undef ATT_VOFF
#undef ATT_PV
#undef ATT_VRD
#undef ATT_VMM
#undef ATT_BF
}
}
constexpr size_t MiB = 1u << 20;
constexpr size_t WS_CTL = 0, CTL_ZERO_BYTES = 1 * MiB;
constexpr size_t WS_TOK = 1 * MiB;
constexpr size_t TOK_E = WS_TOK, TOK_W = TOK_E + (size_t)T * 4, TOK_SLOT = TOK_W + (size_t)T * 8, BLKCNT = TOK_SLOT + (size_t)T * 8, EOFF = BLKCNT + (size_t)NCHUNK * 32 * 4, SLOT_TOK = EOFF + 256;
static_assert(SLOT_TOK + (size_t)SLOT_ROWS * 4 <= 2 * MiB, "router tables");
constexpr size_t WS_WQKV = 2 * MiB;
constexpr size_t WS_WO = 14 * MiB;
constexpr size_t WS_W13 = 18 * MiB;
constexpr size_t WS_W2 = 82 * MiB;
constexpr size_t WS_XB = 114 * MiB;
constexpr size_t WS_Q = 178 * MiB, WS_K = 242 * MiB, WS_V = 306 * MiB;
static_assert(WS_V - WS_K == WS_K - WS_Q, "Q | K | V at one stride");
constexpr size_t WS_O1 = 370 * MiB, WS_O2 = 434 * MiB;
constexpr size_t WS_XS = 178 * MiB;
constexpr size_t WS_H = 322 * MiB;
constexpr size_t WS_Y = 178 * MiB;
constexpr size_t WS_W13B = 434 * MiB, WS_W2B = 498 * MiB;
constexpr size_t WS_END = 538 * MiB;
static_assert(WS_Y + (size_t)SLOT_ROWS * 2048 <= WS_H && WS_H + (size_t)SLOT_ROWS * 1024 <= 434 * MiB && WS_W13B + 64 * MiB <= WS_W2B && WS_W2B + 32 * MiB <= WS_END && WS_O1 + 64 * MiB <= WS_W13B, "MoE overlay");
constexpr int CW_BAR = 4096;
constexpr int RING_BYTES = 131072;
constexpr int MISC_OFF = 147456;
constexpr int LDS_BYTES = MISC_OFF + 4096 + 256;
constexpr int MI_BAR = 0, MI_LAM = 12, MI_EOFF = 16, MI_CNT = 64, MI_TILE = 128, MI_LGT = 424, MI_PTR = 1000;
static_assert(MI_LGT >= MI_TILE + MAX_TILES && MI_PTR >= MI_LGT + 8 * 72 && (MI_PTR + 52) * 4 <= 4096 + 256 && MI_PTR % 2 == 0, "MISC map");
constexpr int NWAVES = 8;

#define XB_TMO      128
#define XB_XCNT(j)  (256  + 64 * (j))
#define XB_XSUB(j)  (1280 + 64 * (j))
#define XB_XGEN(j)  (2304 + 64 * (j))
#define XB_TOP      3328
#define XB_TOPGEN   3392
#define XCD_BAR_WORDS 3456
#define XB_SPIN_CAP (1u << 18)

__device__ __forceinline__ unsigned xb_ld(unsigned* p)              { return __hip_atomic_load(p, __ATOMIC_RELAXED, __HIP_MEMORY_SCOPE_AGENT); }
__device__ __forceinline__ unsigned xb_add(unsigned* p, unsigned v) { return __hip_atomic_fetch_add(p, v, __ATOMIC_RELAXED, __HIP_MEMORY_SCOPE_AGENT); }
__device__ __forceinline__ unsigned xb_xcc_id() { return (unsigned)__builtin_amdgcn_s_getreg((3 << 11) | 20) & 0xFu; }
#define XB_SPIN(cond, bar) do { unsigned _sp = 0; while (cond) { __builtin_amdgcn_s_sleep(1); \
    if ((++_sp & 255u) == 0u) { if (xb_ld(&(bar)[XB_TMO])) break; if (_sp > XB_SPIN_CAP) { atomicAdd(&(bar)[XB_TMO], 1u); break; } } } } while (0)

struct XcdBarrier {
    unsigned* bar; unsigned x;
    volatile LAS unsigned* st;
};

__device__ __forceinline__ XcdBarrier xcd_barrier_post(unsigned* bar, volatile LAS unsigned* st) {
    XcdBarrier b; b.bar = bar; b.x = xb_xcc_id(); b.st = st;
    if (threadIdx.x == 0) (void)xb_add(&bar[XB_XCNT(b.x)], 1u);
    return b;
}
__device__ __forceinline__ void xcd_barrier_complete(unsigned* bar, unsigned x, unsigned& nloc, unsigned& nx) {
    const unsigned G = gridDim.x * gridDim.y * gridDim.z;
    unsigned sum, cnt, mine, sp = 0u;
    for (;;) {
        sum = 0u; cnt = 0u; mine = 0u;
        unsigned cv[16];
        { const __attribute__((address_space(1))) unsigned* cb = (const __attribute__((address_space(1))) unsigned*)&bar[XB_XCNT(0)];
          asm volatile("global_load_dword %0, %16, off sc1\n\tglobal_load_dword %1, %16, off offset:256 sc1\n\tglobal_load_dword %2, %16, off offset:512 sc1\n\tglobal_load_dword %3, %16, off offset:768 sc1\n\t"
                       "global_load_dword %4, %16, off offset:1024 sc1\n\tglobal_load_dword %5, %16, off offset:1280 sc1\n\tglobal_load_dword %6, %16, off offset:1536 sc1\n\tglobal_load_dword %7, %16, off offset:1792 sc1\n\t"
                       "global_load_dword %8, %16, off offset:2048 sc1\n\tglobal_load_dword %9, %16, off offset:2304 sc1\n\tglobal_load_dword %10, %16, off offset:2560 sc1\n\tglobal_load_dword %11, %16, off offset:2816 sc1\n\t"
                       "global_load_dword %12, %16, off offset:3072 sc1\n\tglobal_load_dword %13, %16, off offset:3328 sc1\n\tglobal_load_dword %14, %16, off offset:3584 sc1\n\tglobal_load_dword %15, %16, off offset:3840 sc1\n\ts_waitcnt vmcnt(0)"
                       : "=&v"(cv[0]), "=&v"(cv[1]), "=&v"(cv[2]), "=&v"(cv[3]), "=&v"(cv[4]), "=&v"(cv[5]), "=&v"(cv[6]), "=&v"(cv[7]), "=&v"(cv[8]), "=&v"(cv[9]), "=&v"(cv[10]), "=&v"(cv[11]), "=&v"(cv[12]), "=&v"(cv[13]), "=&v"(cv[14]), "=&v"(cv[15])
                       : "v"(cb) : "memory"); }
#pragma unroll
        for (unsigned j = 0; j < 16; ++j) { const unsigned c = cv[j]; sum += c; cnt += (c > 0u) ? 1u : 0u; mine = (j == x) ? c : mine; }
        if (sum == G) break;
        __builtin_amdgcn_s_sleep(1);
        if ((++sp & 255u) == 0u) { if (xb_ld(&bar[XB_TMO])) break; if (sp > XB_SPIN_CAP) { atomicAdd(&bar[XB_TMO], 1u); break; } }
    }
    nloc = mine > 0u ? mine : 1u; nx = cnt > 0u ? cnt : 1u;
}

__device__ __forceinline__ void xcd_barrier(const XcdBarrier& b) {
    asm volatile("s_waitcnt vmcnt(0)" ::: "memory");
    __syncthreads();
    if (threadIdx.x == 0) {
        unsigned* bar = b.bar;
        __builtin_amdgcn_s_waitcnt(0);
        unsigned nloc = b.st[0], nx = b.st[1];
        if (nloc == 0u) { xcd_barrier_complete(bar, b.x, nloc, nx); b.st[0] = nloc; b.st[1] = nx; }
        const unsigned old = xb_add(&bar[XB_XSUB(b.x)], 1u);
        const unsigned gen = old / nloc;
        if (old + 1u == (gen + 1u) * nloc) {
            __builtin_amdgcn_fence(__ATOMIC_RELEASE, "agent");
            asm volatile("s_waitcnt vmcnt(0)" ::: "memory");
            const unsigned og = xb_add(&bar[XB_TOP], 1u);
            const unsigned tg = og / nx;
            if (og + 1u == (tg + 1u) * nx) xb_add(&bar[XB_TOPGEN], 1u);
            else XB_SPIN(xb_ld(&bar[XB_TOPGEN]) == tg, bar);
            __builtin_amdgcn_fence(__ATOMIC_ACQUIRE, "agent");
            xb_add(&bar[XB_XGEN(b.x)], 1u);
            asm volatile("s_waitcnt vmcnt(0)" ::: "memory");
        } else {
            XB_SPIN(xb_ld(&bar[XB_XGEN(b.x)]) == gen, bar);
            __builtin_amdgcn_fence(__ATOMIC_ACQUIRE, "agent");
            asm volatile("s_waitcnt vmcnt(0)" ::: "memory");
        }
    }
    __syncthreads();
}
#define RLX_AGENT __ATOMIC_RELAXED, __HIP_MEMORY_SCOPE_AGENT
#define LDS_WAIT() asm volatile("s_waitcnt lgkmcnt(0)" ::: "memory")
__device__ __forceinline__ unsigned f2bf(float f) { unsigned u = __builtin_bit_cast(unsigned, f); return (u + 0x7fffu + ((u >> 16) & 1u)) >> 16; }
__device__ __forceinline__ unsigned pk2(float lo, float hi) { return f2bf(lo) | (f2bf(hi) << 16); }
__device__ __forceinline__ float bflo(unsigned w) { return __uint_as_float(w << 16); }
__device__ __forceinline__ float bfhi(unsigned w) { return __uint_as_float(w & 0xffff0000u); }
template <int CTRL> __device__ __forceinline__ float dpp_f(float v) { return __builtin_bit_cast(float, __builtin_amdgcn_update_dpp(0, __builtin_bit_cast(int, v), CTRL, 0xf, 0xf, true)); }
__device__ __forceinline__ float row_sum16(float v) { v += dpp_f<0xB1>(v); v += dpp_f<0x4E>(v); v += dpp_f<0x141>(v); v += dpp_f<0x140>(v); return v; }
__device__ __forceinline__ float swap16_sum(float v) { const auto r = __builtin_amdgcn_permlane16_swap(__float_as_uint(v), __float_as_uint(v), false, false); return __uint_as_float(r[0]) + __uint_as_float(r[1]); }
__device__ __forceinline__ float swap32_sum(float v) { const auto r = __builtin_amdgcn_permlane32_swap(__float_as_uint(v), __float_as_uint(v), false, false); return __uint_as_float(r[0]) + __uint_as_float(r[1]); }
__device__ __forceinline__ float wave_sum(float v) { return swap32_sum(swap16_sum(row_sum16(v))); }
struct Frame {
    LAS unsigned char* lds; LAS int* MISC; unsigned char* ws;
    int tid, lane, wave, vcu, G, bx;
    float* out;
};
__device__ __forceinline__ Frame launder(const Frame& F0) {
    Frame F = F0;
    asm volatile("" : "+s"(F.ws), "+s"(F.out), "+s"(F.G), "+s"(F.vcu), "+s"(F.bx), "+v"(F.tid));
    F.lane = F.tid & 63; F.wave = __builtin_amdgcn_readfirstlane(F.tid >> 6);
    return F;
}
__device__ __forceinline__ const float* inp(const Frame& F, int k) {
    const unsigned long long v = ((const LAS unsigned long long*)(F.MISC + MI_PTR))[k];
    const unsigned lo = __builtin_amdgcn_readfirstlane((unsigned)v), hi = __builtin_amdgcn_readfirstlane((unsigned)(v >> 32));
    return (const float*)(((unsigned long long)hi << 32) | lo);
}

template <class RowMap>
__device__ __forceinline__ void transpose_item(const float* W, int K, int N, bf16* WT, const RowMap& rm, LAS float* scr, int item, int lane) {
    const int nblk = N / 32, kb = item / nblk, nb = item % nblk, k0 = 64 * kb, n0 = 32 * nb;
    float tv[32];
#pragma unroll
    for (int i = 0; i < 32; ++i) tv[i] = W[(size_t)(k0 + 2 * i + (lane >> 5)) * N + n0 + (lane & 31)];
#pragma unroll
    for (int i = 0; i < 32; ++i) scr[(2 * i + (lane >> 5)) * 33 + (lane & 31)] = tv[i];
    LDS_WAIT(); asm volatile("" ::: "memory");
    const int c = lane & 7;
#pragma unroll
    for (int j = 0; j < 4; ++j) { const int n = (lane >> 3) + 8 * j; const LAS float* s = scr + (8 * c) * 33 + n;
        u32x4 o; o.x = pk2(s[0 * 33], s[1 * 33]); o.y = pk2(s[2 * 33], s[3 * 33]); o.z = pk2(s[4 * 33], s[5 * 33]); o.w = pk2(s[6 * 33], s[7 * 33]);
        *(u32x4*)(WT + (size_t)rm(n0 + n) * K + k0 + 8 * c) = o; }
    LDS_WAIT(); asm volatile("" ::: "memory");
}
struct RowId { int off; __device__ __forceinline__ int operator()(int n) const { return off + n; } };
struct RowW13 { int type; __device__ __forceinline__ int operator()(int n) const { const int jh = n & 127; return 256 * (n >> 7) + 128 * ((jh >> 2) & 1) + 32 * (jh >> 5) + 8 * ((jh >> 3) & 3) + 4 * type + (jh & 3); } };

__device__ __forceinline__ void attn_weight_item(Frame& F, int it, LAS float* scr) {
    bf16* Wqkv = (bf16*)(F.ws + WS_WQKV); bf16* Wo = (bf16*)(F.ws + WS_WO);
    const int l = it >> 11, mtx = (it >> 9) & 3, r = it & 511;
    const int pk = (l == 0 ? 2 : 11) + mtx;
    const float* W = (const float*)((const LAS unsigned long long*)(F.MISC + MI_PTR))[pk];
    if (mtx < 3) transpose_item(W, 1024, 1024, Wqkv + (size_t)l * 3072 * 1024, RowId{mtx * 1024}, scr, r, F.lane);
    else transpose_item(W, 1024, 1024, Wo + (size_t)l * 1024 * 1024, RowId{0}, scr, r, F.lane);
}
__device__ __forceinline__ void phase_prologue(Frame& F) {
    LAS float* scr = (LAS float*)(F.lds + F.wave * 16384);
    const int gw = F.vcu * NWAVES + F.wave, NGW = F.G * NWAVES;
    bf16* Wqkv = (bf16*)(F.ws + WS_WQKV); bf16* Wo = (bf16*)(F.ws + WS_WO);
    for (int it = gw; it < 4 * 512; it += NGW) attn_weight_item(F, it, scr);
    const float* x = inp(F, 0); bf16* xb = (bf16*)(F.ws + WS_XB);
    { const size_t step = (size_t)F.G * 512 * 8;
      for (size_t i = (size_t)(F.bx * 512 + F.tid) * 8; i < (size_t)T * DM; i += 4 * step) {
        f32x4 a[4], b[4];
#pragma unroll
        for (int u = 0; u < 4; ++u) { a[u] = *(const f32x4*)(x + i + u * step); b[u] = *(const f32x4*)(x + i + u * step + 4); }
#pragma unroll
        for (int u = 0; u < 4; ++u) { u32x4 o; o.x = pk2(a[u][0], a[u][1]); o.y = pk2(a[u][2], a[u][3]); o.z = pk2(b[u][0], b[u][1]); o.w = pk2(b[u][2], b[u][3]); *(u32x4*)(xb + i + u * step) = o; } } }
    if (F.wave == 0) {
        const float s1 = wave_sum(inp(F, 6)[F.lane] * inp(F, 7)[F.lane]);
        const float s2 = wave_sum(inp(F, 8)[F.lane] * inp(F, 9)[F.lane]);
        if (F.lane == 0) F.MISC[MI_LAM] = __float_as_int(expf(s1) - expf(s2) + LAM_INIT); }
}
__device__ __forceinline__ void moe_weight_item(Frame& F, int layer, int it, LAS float* scr) {
    bf16* W13 = (bf16*)(F.ws + (layer == 0 ? WS_W13 : WS_W13B)); bf16* W2 = (bf16*)(F.ws + (layer == 0 ? WS_W2 : WS_W2B));
    const float* w1 = inp(F, 23) + (size_t)layer * NEXP * 1024 * 512; const float* w3 = inp(F, 24) + (size_t)layer * NEXP * 1024 * 512; const float* w2 = inp(F, 25) + (size_t)layer * NEXP * 512 * 1024;
    const int mtx = it >> 13, e = (it >> 8) & 31, r = it & 255;
    if (mtx == 0) transpose_item(w1 + (size_t)e * 1024 * 512, 1024, 512, W13 + (size_t)e * 1024 * 1024, RowW13{0}, scr, r, F.lane);
    else if (mtx == 1) transpose_item(w3 + (size_t)e * 1024 * 512, 1024, 512, W13 + (size_t)e * 1024 * 1024, RowW13{1}, scr, r, F.lane);
    else transpose_item(w2 + (size_t)e * 512 * 1024, 512, 1024, W2 + (size_t)e * 1024 * 512, RowId{0}, scr, r, F.lane);
}
constexpr int MW_ITEMS = 3 * NEXP * 256;
__device__ __forceinline__ void phase_moe_weights(Frame& F, int layer, int first = 0, int end = MW_ITEMS) {
    LAS float* scr = (LAS float*)(F.lds + F.wave * 16384);
    const int gw = F.vcu * NWAVES + F.wave, NGW = F.G * NWAVES;
    for (int it = first + gw; it < end; it += NGW) moe_weight_item(F, layer, it, scr);
}
constexpr int W2_FIRST = 2 * NEXP * 256, WIN1 = W2_FIRST - 3072, AW1_ITEMS = 4 * 512;
constexpr int WIN_ITEMS = MW_ITEMS + (W2_FIRST - WIN1) + AW1_ITEMS;
__device__ __forceinline__ void window_convert(Frame& F, int cw, int ncw) {
    LAS float* scr = (LAS float*)(F.lds + F.wave * 16384);
    for (int j = cw; j < WIN_ITEMS; j += ncw) { if (j < MW_ITEMS) moe_weight_item(F, 0, j, scr); else if (j < WIN_ITEMS - AW1_ITEMS) moe_weight_item(F, 1, j - MW_ITEMS + WIN1, scr); else attn_weight_item(F, 2048 + (j - (WIN_ITEMS - AW1_ITEMS)), scr); }
}
constexpr int UP_PER = 48, DN_PER = 24;
__device__ __forceinline__ int moe_idle_blocks(int ntiles, int G) { const int rem = (ntiles * 4) % G; return rem == 0 ? 0 : G - rem; }
__device__ __forceinline__ void moe_tail_items(Frame& F, int ntiles, int base, int per) {
    const int rem = (ntiles * 4) % F.G; if (rem == 0 || F.bx < rem) return;
    LAS float* scr = (LAS float*)(F.lds + F.wave * 16384);
    const int first = base + (F.bx - rem) * per;
    for (int it = first + F.wave; it < first + per && it < WIN1; it += NWAVES) moe_weight_item(F, 1, it, scr);
}
__device__ __forceinline__ void moe_tail_w2(Frame& F, int ntiles) {
    LAS float* scr = (LAS float*)(F.lds + F.wave * 16384);
    const int rem = (ntiles * 4) % F.G;
    if (rem == 0) { for (int it = W2_FIRST + F.bx * NWAVES + F.wave; it < MW_ITEMS; it += F.G * NWAVES) moe_weight_item(F, 1, it, scr); return; }
    if (F.bx < rem) return;
    const int idle = F.G - rem, per = (MW_ITEMS - W2_FIRST + idle - 1) / idle, first = W2_FIRST + (F.bx - rem) * per;
    for (int it = first + F.wave; it < first + per && it < MW_ITEMS; it += NWAVES) moe_weight_item(F, 1, it, scr);
}

template <int MODE, int VAR = 0, class PreFn>
__device__ __forceinline__ void phase_attention(Frame& F, PreFn pre) {
    const bf16* Q = (const bf16*)(F.ws + WS_Q); const bf16* K = (const bf16*)(F.ws + WS_K); const bf16* V = (const bf16*)(F.ws + WS_V);
    bf16* O1 = VAR ? (bf16*)F.out : (bf16*)(F.ws + WS_O1);
    const float* rel = inp(F, 1);
    if (MODE == 0) {
        const float lam = __int_as_float(F.MISC[MI_LAM]);
        const float* subg = inp(F, 10);
        if (F.tid < 256) ((LAS float*)(F.lds + att::LDS_REL))[F.tid] = rel[F.tid];
        if (F.tid < 128) ((LAS float*)(F.lds + att::LDS_GAIN))[F.tid] = subg[F.tid];
        pre();
        for (int P = F.vcu; P < 512; P += F.G) {
            const int bh = P >> 3, s = P & 7, b = bh >> 3, h = bh & 7;
#pragma unroll 1
            for (int k = 0; k < 4; ++k) {
                const int qb = k < 2 ? 15 - s : s, c = k & 1;
                att::attn_unit<0, VAR>(F.lds, Q, K, V, O1, b, 128 * h + 64 * c, 128 * h, qb, rel, h, c, lam, subg);
            }
        }
    } else {
        pre();
        for (int P = F.vcu; P < 1024; P += F.G) {
            const int bh = P >> 3, s = P & 7, b = bh >> 4, hh = bh & 15;
#pragma unroll 1
            for (int k = 0; k < 2; ++k) att::attn_unit<1, VAR>(F.lds, Q, K, V, O1, b, 64 * hh, 64 * hh, k == 0 ? 15 - s : s, rel, 0);
        }
    }
    asm volatile("s_waitcnt vmcnt(0) lgkmcnt(0)\n\ts_barrier" ::: "memory");
}
__device__ __forceinline__ void ln16(f32x4 (&v)[4], const f32x4 (&g)[4], const f32x4 (&bb)[4]) {
    float s = 0.f;
#pragma unroll
    for (int j = 0; j < 4; ++j) s += (v[j][0] + v[j][1]) + (v[j][2] + v[j][3]);
    const float mean = wave_sum(s) * (1.0f / DM); float s2 = 0.f;
#pragma unroll
    for (int j = 0; j < 4; ++j) { v[j] = v[j] - mean; s2 += (v[j][0] * v[j][0] + v[j][1] * v[j][1]) + (v[j][2] * v[j][2] + v[j][3] * v[j][3]); }
    const float rstd = 1.0f / sqrtf(wave_sum(s2) * (1.0f / DM) + LN_EPS);
#pragma unroll
    for (int j = 0; j < 4; ++j) v[j] = v[j] * rstd * g[j] + bb[j];
}
template <class PreFn>
__device__ __forceinline__ void phase_ln_router(Frame& F, int layer, PreFn pre) {
    constexpr int AROW = 2064, A_HI = 0, A_LO = 16 * AROW, RED = 2 * 16 * AROW, LGO = RED + 8 * 3 * 1024, RBIAS = LGO + 2304;
    const float* wg = inp(F, 19) + (size_t)layer * 1024 * 4; const float* we = inp(F, 21) + (size_t)layer * 1024 * 32;
    const int lane = F.lane, wave = F.wave, col = lane & 15, kq = lane >> 4;
    u32x4 bh[4][3], bl[4][3];
#pragma unroll
    for (int s = 0; s < 4; ++s)
#pragma unroll
        for (int blk = 0; blk < 3; ++blk) { const int o = 16 * blk + col; float w8[8];
#pragma unroll
            for (int j = 0; j < 8; ++j) { const int k = 128 * wave + 32 * s + 8 * kq + j; w8[j] = o < 4 ? wg[k * 4 + o] : (o < 36 ? we[k * 32 + o - 4] : 0.f); }
#pragma unroll
            for (int jp = 0; jp < 4; ++jp) { const unsigned wh = pk2(w8[2 * jp], w8[2 * jp + 1]); bh[s][blk][jp] = wh; bl[s][blk][jp] = pk2(w8[2 * jp] - bflo(wh), w8[2 * jp + 1] - bfhi(wh)); } }
    const float* bg = inp(F, 20) + layer * 4; const float* be = inp(F, 22) + layer * 32;
    const float* lg = inp(F, 15) + layer * 1024; const float* lb = inp(F, 16) + layer * 1024;
    LAS int* cnt = F.MISC + MI_CNT; const LAS float* lgv = (const LAS float*)(F.lds + LGO);
    int* tok_e = (int*)(F.ws + TOK_E); float* tok_w = (float*)(F.ws + TOK_W); int* blkcnt = (int*)(F.ws + BLKCNT);
    GAS bf16* xb = (GAS bf16*)(F.ws + WS_XB); const GAS bf16* tb = (const GAS bf16*)(F.ws + WS_Q);
    LAS float* rbL = (LAS float*)(F.lds + RBIAS);
    if (F.tid < 4) rbL[F.tid] = bg[F.tid]; else if (F.tid >= 32 && F.tid < 64) rbL[4 + F.tid - 32] = be[F.tid - 32];
    pre();
    for (int c = F.bx; c < NCHUNK; c += F.G) {
        if (F.tid < 32) cnt[F.tid] = 0;
        u32x2 ra[4], rb[4];
        { const GAS bf16* xr = tb + (size_t)(c * 128 + 2 * wave) * DM;
#pragma unroll
          for (int j = 0; j < 4; ++j) { ra[j] = *(const GAS u32x2*)(xr + 4 * lane + 256 * j); rb[j] = *(const GAS u32x2*)(xr + DM + 4 * lane + 256 * j); } }
        __syncthreads();
#pragma unroll 1
        for (int st = 0; st < 8; ++st) {
            const int tok = c * 128 + st * 16 + 2 * wave;
            f32x4 va[4], vb[4];
#pragma unroll
            for (int j = 0; j < 4; ++j) { va[j] = (f32x4){bflo(ra[j].x), bfhi(ra[j].x), bflo(ra[j].y), bfhi(ra[j].y)}; vb[j] = (f32x4){bflo(rb[j].x), bfhi(rb[j].x), bflo(rb[j].y), bfhi(rb[j].y)}; }
            { const GAS float* lgp = (const GAS float*)lg; const GAS float* lbp = (const GAS float*)lb; asm volatile("" : "+s"(lgp), "+s"(lbp));
              f32x4 gv[4], bv[4];
#pragma unroll
              for (int j = 0; j < 4; ++j) { gv[j] = *(const GAS f32x4*)(lgp + 4 * lane + 256 * j); bv[j] = *(const GAS f32x4*)(lbp + 4 * lane + 256 * j); }
              { const GAS bf16* xr = tb + (size_t)(st < 7 ? tok + 16 : tok) * DM;
#pragma unroll
                  for (int j = 0; j < 4; ++j) { ra[j] = *(const GAS u32x2*)(xr + 4 * lane + 256 * j); rb[j] = *(const GAS u32x2*)(xr + DM + 4 * lane + 256 * j); } }
              ln16(va, gv, bv); ln16(vb, gv, bv); }
#pragma unroll
            for (int j = 0; j < 4; ++j) {
                const unsigned ah0 = pk2(va[j][0], va[j][1]), ah1 = pk2(va[j][2], va[j][3]), bh0 = pk2(vb[j][0], vb[j][1]), bh1 = pk2(vb[j][2], vb[j][3]);
                *(GAS u32x2*)(xb + (size_t)tok * DM + 4 * lane + 256 * j) = (u32x2){ah0, ah1}; *(GAS u32x2*)(xb + (size_t)(tok + 1) * DM + 4 * lane + 256 * j) = (u32x2){bh0, bh1};
                const unsigned al0 = pk2(va[j][0] - bflo(ah0), va[j][1] - bfhi(ah0)), al1 = pk2(va[j][2] - bflo(ah1), va[j][3] - bfhi(ah1));
                const unsigned bl0 = pk2(vb[j][0] - bflo(bh0), vb[j][1] - bfhi(bh0)), bl1 = pk2(vb[j][2] - bflo(bh1), vb[j][3] - bfhi(bh1));
                const int ko = (4 * lane + 256 * j) * 2;
                *(LAS u32x2*)(F.lds + A_HI + (2 * wave) * AROW + ko) = (u32x2){ah0, ah1}; *(LAS u32x2*)(F.lds + A_LO + (2 * wave) * AROW + ko) = (u32x2){al0, al1};
                *(LAS u32x2*)(F.lds + A_HI + (2 * wave + 1) * AROW + ko) = (u32x2){bh0, bh1}; *(LAS u32x2*)(F.lds + A_LO + (2 * wave + 1) * AROW + ko) = (u32x2){bl0, bl1}; }
            __syncthreads();
            f32x4 acc[3];
#pragma unroll
            for (int blk = 0; blk < 3; ++blk) acc[blk] = (f32x4){0.f, 0.f, 0.f, 0.f};
#pragma unroll
            for (int s = 0; s < 4; ++s) { const int kb = (128 * wave + 32 * s + 8 * kq) * 2;
                const bf16x8 ah = *(const LAS bf16x8*)(F.lds + A_HI + col * AROW + kb), al = *(const LAS bf16x8*)(F.lds + A_LO + col * AROW + kb);
#pragma unroll
                for (int blk = 0; blk < 3; ++blk) {
                    acc[blk] = __builtin_amdgcn_mfma_f32_16x16x32_bf16(ah, __builtin_bit_cast(bf16x8, bh[s][blk]), acc[blk], 0, 0, 0);
                    acc[blk] = __builtin_amdgcn_mfma_f32_16x16x32_bf16(al, __builtin_bit_cast(bf16x8, bh[s][blk]), acc[blk], 0, 0, 0);
                    acc[blk] = __builtin_amdgcn_mfma_f32_16x16x32_bf16(ah, __builtin_bit_cast(bf16x8, bl[s][blk]), acc[blk], 0, 0, 0); } }
#pragma unroll
            for (int blk = 0; blk < 3; ++blk) *(LAS f32x4*)(F.lds + RED + ((wave * 3 + blk) * 64 + lane) * 16) = acc[blk];
            __syncthreads();
            { const int t = F.tid >> 5, oo = F.tid & 31;
              float s0 = 0.f, s1 = 0.f;
#pragma unroll
              for (int w = 0; w < 8; ++w) { s0 += *(const LAS float*)(F.lds + RED + ((w * 3 + (oo >> 4)) * 64 + (t >> 2) * 16 + (oo & 15)) * 16 + (t & 3) * 4);
                  if (oo < 4) s1 += *(const LAS float*)(F.lds + RED + ((w * 3 + 2) * 64 + (t >> 2) * 16 + oo) * 16 + (t & 3) * 4); }
              ((LAS float*)(F.lds + LGO))[t * 36 + oo] = s0; if (oo < 4) ((LAS float*)(F.lds + LGO))[t * 36 + 32 + oo] = s1; }
            __syncthreads();
            if (lane < 2) {
                const LAS float* L = lgv + 36 * (2 * wave + lane); const int mytok = tok + lane;
                float gl[4];
#pragma unroll
                for (int j = 0; j < 4; ++j) gl[j] = L[j] + rbL[j];
                int gi = 0; float gm = gl[0];
#pragma unroll
                for (int j = 1; j < 4; ++j) if (gl[j] > gm) { gm = gl[j]; gi = j; }
                float gs = 0.f;
#pragma unroll
                for (int j = 0; j < 4; ++j) gs += expf(gl[j] - gm);
                const float ggate = 1.0f / gs;
                float el[8];
#pragma unroll
                for (int j = 0; j < 8; ++j) el[j] = L[4 + 8 * gi + j] + rbL[4 + 8 * gi + j];
                int i1 = 0; float m1 = el[0];
#pragma unroll
                for (int j = 1; j < 8; ++j) if (el[j] > m1) { m1 = el[j]; i1 = j; }
                int i2 = -1; float m2 = -INFINITY;
#pragma unroll
                for (int j = 0; j < 8; ++j) if (j != i1 && el[j] > m2) { m2 = el[j]; i2 = j; }
                const float ex = expf(m2 - m1); const float wa = ggate / (1.0f + ex), wb = ggate * ex / (1.0f + ex);
                const int ea = gi * 8 + i1, eb = gi * 8 + i2;
                tok_e[mytok] = ea | (eb << 8); tok_w[2 * mytok] = wa; tok_w[2 * mytok + 1] = wb;
                __hip_atomic_fetch_add(cnt + ea, 1, __ATOMIC_RELAXED, __HIP_MEMORY_SCOPE_WORKGROUP); __hip_atomic_fetch_add(cnt + eb, 1, __ATOMIC_RELAXED, __HIP_MEMORY_SCOPE_WORKGROUP);
            }
        }
        __syncthreads();
        if (F.tid < 32) blkcnt[c * 32 + F.tid] = cnt[F.tid];
        __syncthreads();
    }
}
__device__ __forceinline__ void phase_slots(Frame& F) {
    LAS int* tab = (LAS int*)F.lds;
    const int* blkcnt = (const int*)(F.ws + BLKCNT);
    const int* tok_e = (const int*)(F.ws + TOK_E);
    const int te0 = (F.tid < 256 && F.bx < NCHUNK) ? tok_e[F.bx * 128 + (F.tid >> 1)] : 0;
    { int tv[16];
#pragma unroll
      for (int i = 0; i < 16; ++i) tv[i] = __hip_atomic_load(blkcnt + F.tid + 512 * i, RLX_AGENT);
#pragma unroll
      for (int i = 0; i < 16; ++i) tab[F.tid + 512 * i] = tv[i]; }
    __syncthreads();
    LAS int* eoff = F.MISC + MI_EOFF; LAS int* cur = F.MISC + MI_CNT;
    {
        const int e = F.tid & 31, g = F.tid >> 5; LAS int* gsum = F.MISC + MI_LGT;
        int v[16], acc = 0;
#pragma unroll
        for (int i = 0; i < 16; ++i) v[i] = tab[(16 * g + i) * 32 + e];
#pragma unroll
        for (int i = 0; i < 16; ++i) { const int t = v[i]; v[i] = acc; acc += t; }
        gsum[g * 32 + e] = acc;
        __syncthreads();
        int goff = 0;
#pragma unroll
        for (int gg = 0; gg < 16; ++gg) { const int t = gsum[gg * 32 + e]; goff += gg < g ? t : 0; }
#pragma unroll
        for (int i = 0; i < 16; ++i) tab[(16 * g + i) * 32 + e] = v[i] + goff;
        if (g == 15) cur[e] = goff + acc;
    }
    __syncthreads();
    if (F.tid < 33) {
        typedef int i32x4_ __attribute__((ext_vector_type(4))); i32x4_ cv[8];
#pragma unroll
        for (int q = 0; q < 8; ++q) cv[q] = ((const LAS i32x4_*)cur)[q];
        __builtin_amdgcn_sched_barrier(0);
        int o = 0;
#pragma unroll
        for (int q = 0; q < 8; ++q)
#pragma unroll
            for (int c4 = 0; c4 < 4; ++c4) o += (4 * q + c4 < F.tid) ? ((cv[q][c4] + 255) & ~255) : 0;
        eoff[F.tid] = o; }
    __syncthreads();
    { LAS int* tile_e = F.MISC + MI_TILE; int ntl = eoff[32] >> 8; ntl = ntl > MAX_TILES ? MAX_TILES : ntl;
      if (F.tid < ntl) { typedef int i32x4_ __attribute__((ext_vector_type(4))); i32x4_ ev[8];
#pragma unroll
          for (int q = 0; q < 8; ++q) ev[q] = ((const LAS i32x4_*)eoff)[q];
          __builtin_amdgcn_sched_barrier(0);
          int e = 0;
#pragma unroll
          for (int q = 0; q < 8; ++q)
#pragma unroll
              for (int c4 = 0; c4 < 4; ++c4) if (4 * q + c4 >= 1 && ev[q][c4] <= 256 * F.tid) e = 4 * q + c4;
          tile_e[F.tid] = e; } }
    int* slot_tok = (int*)(F.ws + SLOT_TOK);
    for (int e = F.bx; e < 32; e += F.G) for (int s = eoff[e] + cur[e] + F.tid; s < eoff[e + 1]; s += 512) slot_tok[s] = 0;
    int* tok_slot = (int*)(F.ws + TOK_SLOT);
    for (int c = F.bx; c < NCHUNK; c += F.G) {
        const int te = (c == F.bx) ? te0 : ((F.tid < 256) ? tok_e[c * 128 + (F.tid >> 1)] : 0);
        __syncthreads();
        if (F.tid < 32) cur[F.tid] = 0;
        __syncthreads();
        if (F.tid < 256) { const int tok = c * 128 + (F.tid >> 1), k = F.tid & 1; const int e = (te >> (8 * k)) & 255;
            const int pos = eoff[e] + tab[c * 32 + e] + __hip_atomic_fetch_add(cur + e, 1, __ATOMIC_RELAXED, __HIP_MEMORY_SCOPE_WORKGROUP);
            tok_slot[2 * tok + k] = pos; slot_tok[pos] = tok; }
    }
}
__device__ __forceinline__ int load_tiles(Frame& F) {
    LAS int* eoff = F.MISC + MI_EOFF;
    __syncthreads();
    int nt = eoff[32] >> 8; nt = nt > MAX_TILES ? MAX_TILES : nt;
    return __builtin_amdgcn_readfirstlane(nt);
}
template <class PreFn>
__device__ __forceinline__ void phase_moe_combine(Frame& F, int layer, PreFn pre) {
    const float* lg = inp(F, 17) + layer * 1024; const float* lb = inp(F, 18) + layer * 1024;
    f32x4 gv[4], bv[4];
#pragma unroll
    for (int j = 0; j < 4; ++j) { gv[j] = *(const f32x4*)(lg + 4 * F.lane + 256 * j); bv[j] = *(const f32x4*)(lb + 4 * F.lane + 256 * j); }
    const float* tok_w = (const float*)(F.ws + TOK_W); const int* tok_slot = (const int*)(F.ws + TOK_SLOT);
    const bf16* Y = (const bf16*)(F.ws + WS_Y); bf16* xb = (bf16*)(F.ws + WS_XB);
    const int gw = F.vcu * NWAVES + F.wave, NGW = F.G * NWAVES;
    int slv = 0; float wvv = 0.f;
    if (2 * gw < T) { slv = __hip_atomic_load(tok_slot + 2 * (2 * gw) + (F.lane & 3), RLX_AGENT); wvv = __hip_atomic_load(tok_w + 2 * (2 * gw) + (F.lane & 3), RLX_AGENT); }
    pre();
    for (int tok = 2 * gw; tok < T; tok += 2 * NGW) {
        const int ntok = tok + 2 * NGW < T ? tok + 2 * NGW : tok;
        const int nslv = __hip_atomic_load(tok_slot + 2 * ntok + (F.lane & 3), RLX_AGENT); const float nwvv = __hip_atomic_load(tok_w + 2 * ntok + (F.lane & 3), RLX_AGENT);
        const int sa0 = __builtin_amdgcn_readlane(slv, 0), sa1 = __builtin_amdgcn_readlane(slv, 1), sb0 = __builtin_amdgcn_readlane(slv, 2), sb1 = __builtin_amdgcn_readlane(slv, 3);
        float wv[4];
#pragma unroll
        for (int i = 0; i < 4; ++i) wv[i] = __uint_as_float(__builtin_amdgcn_readlane(__float_as_uint(wvv), i));
        bf16* xbr = xb + (size_t)tok * DM;
        f32x4 va[4], vb[4]; u32x2 xa[4], xc[4], ya0[4], ya1[4], yb0[4], yb1[4];
#pragma unroll
        for (int j = 0; j < 4; ++j) { const int o = 4 * F.lane + 256 * j;
            xa[j] = *(const u32x2*)(xbr + o); xc[j] = *(const u32x2*)(xbr + DM + o);
            ya0[j] = *(const u32x2*)(Y + (size_t)sa0 * DM + o); ya1[j] = *(const u32x2*)(Y + (size_t)sa1 * DM + o);
            yb0[j] = *(const u32x2*)(Y + (size_t)sb0 * DM + o); yb1[j] = *(const u32x2*)(Y + (size_t)sb1 * DM + o); }
#pragma unroll
        for (int j = 0; j < 4; ++j) {
            va[j][0] = ALPHA * bflo(xa[j].x) + (wv[0] * bflo(ya0[j].x) + wv[1] * bflo(ya1[j].x)); va[j][1] = ALPHA * bfhi(xa[j].x) + (wv[0] * bfhi(ya0[j].x) + wv[1] * bfhi(ya1[j].x));
            va[j][2] = ALPHA * bflo(xa[j].y) + (wv[0] * bflo(ya0[j].y) + wv[1] * bflo(ya1[j].y)); va[j][3] = ALPHA * bfhi(xa[j].y) + (wv[0] * bfhi(ya0[j].y) + wv[1] * bfhi(ya1[j].y));
            vb[j][0] = ALPHA * bflo(xc[j].x) + (wv[2] * bflo(yb0[j].x) + wv[3] * bflo(yb1[j].x)); vb[j][1] = ALPHA * bfhi(xc[j].x) + (wv[2] * bfhi(yb0[j].x) + wv[3] * bfhi(yb1[j].x));
            vb[j][2] = ALPHA * bflo(xc[j].y) + (wv[2] * bflo(yb0[j].y) + wv[3] * bflo(yb1[j].y)); vb[j][3] = ALPHA * bfhi(xc[j].y) + (wv[2] * bfhi(yb0[j].y) + wv[3] * bfhi(yb1[j].y)); }
        ln16(va, gv, bv); ln16(vb, gv, bv);
#pragma unroll
        for (int j = 0; j < 4; ++j) { const int o = 4 * F.lane + 256 * j;
            if (layer == 0) { u32x2 w; w.x = pk2(va[j][0], va[j][1]); w.y = pk2(va[j][2], va[j][3]); *(u32x2*)(xbr + o) = w;
                w.x = pk2(vb[j][0], vb[j][1]); w.y = pk2(vb[j][2], vb[j][3]); *(u32x2*)(xbr + DM + o) = w; }
            else { float* xr = F.out + (size_t)tok * DM; *(f32x4*)(xr + o) = va[j]; *(f32x4*)(xr + DM + o) = vb[j]; } }
        slv = nslv; wvv = nwvv;
    }
}
constexpr int NPH = 19;
#ifndef PROBE_QKV
#define PROBE_QKV 0
#endif
#ifndef NCVG
#define NCVG 8
#endif
#ifndef REP_QKV
#define REP_QKV 1
#endif
#ifndef PROBE_DA
#define PROBE_DA 0
#endif
#ifndef REP_SB
#define REP_SB 1
#endif
#ifndef REP_UP
#define REP_UP 1
#endif
#ifndef REP_DOWN
#define REP_DOWN 1
#endif
#ifndef REP_PRO
#define REP_PRO 1
#endif
#ifndef REP_WO
#define REP_WO 1
#endif
#ifndef REP_LNR
#define REP_LNR 1
#endif
#ifndef REP_SLOTS
#define REP_SLOTS 1
#endif
#ifndef REP_COMB1
#define REP_COMB1 1
#endif
#ifndef REP_MW1
#define REP_MW1 1
#endif
#ifndef MK_SPLIT
#define MK_SPLIT 0
#endif
struct Args { const float* in[26]; float* out; unsigned char* ws; int ph_lo, ph_hi, li, pad; };
__global__ void __launch_bounds__(NWAVES * 64, 2) fwd(Args args) {
    extern __shared__ __attribute__((aligned(16))) unsigned char lds_raw[];
    Frame F;
    F.lds = (LAS unsigned char*)lds_raw; F.MISC = (LAS int*)(F.lds + MISC_OFF); F.ws = args.ws; F.out = args.out;
    F.tid = threadIdx.x; F.lane = F.tid & 63; F.wave = __builtin_amdgcn_readfirstlane(F.tid >> 6);
    F.G = gridDim.x; F.bx = blockIdx.x; F.vcu = (F.G % 8 == 0) ? (F.bx % 8) * (F.G / 8) + F.bx / 8 : F.bx;
    if (F.tid < 64) F.MISC[F.tid] = 0;
    if (F.tid == 0) {
#pragma unroll
        for (int i = 0; i < 26; ++i) ((LAS unsigned long long*)(F.MISC + MI_PTR))[i] = (unsigned long long)args.in[i];
    }
    __syncthreads();
    XcdBarrier bar = xcd_barrier_post((unsigned*)(F.ws + WS_CTL) + CW_BAR + args.li * XCD_BAR_WORDS, (volatile LAS unsigned*)(F.MISC + MI_BAR));
    const int lo = args.ph_lo, hi = args.ph_hi;
#define IN(k) (lo <= (k) && (k) < hi)
#ifndef SKEW_SLEEP
#define SKEW_SLEEP 0
#endif
#define PHASE_SKEW(P) do { if (SKEW_SLEEP) { const int g_ = ((P).bx >> 3) & 7; for (int i_ = 0; i_ < g_; ++i_) __builtin_amdgcn_s_sleep(SKEW_SLEEP); } } while (0)
#define SEAM(k) do { if ((k) + 1 < hi) { XcdBarrier b_ = bar; asm volatile("" : "+s"(b_.bar), "+s"(b_.x)); xcd_barrier(b_); } } while (0)
    if (IN(0)) { Frame P = launder(F); for (int rep = 0; rep < REP_PRO; ++rep) { phase_prologue(P); } SEAM(0); }
#pragma unroll 1
    for (int l = 0; l < 2; ++l) {
        const int pb = 1 + 9 * l;
        if (IN(pb + 0)) { Frame P = launder(F);
            pg8::Gemm g{(const bf16*)(P.ws + WS_XB), (const bf16*)(P.ws + WS_WQKV) + (size_t)l * 3072 * 1024, T, 3072, 1024, nullptr}; pg8::StaticOrder S;
            bool conv = false; { int G2 = P.G, c2 = P.bx;
              if (l == 0) { const int ng = P.G >> 3, ncvg = ((P.G & 7) == 0 && ng >= 2 * NCVG) ? NCVG : 0;
                if (ncvg == 0) window_convert(P, P.bx * NWAVES + P.wave, P.G * NWAVES);
                else { const int grp = P.bx >> 3, ncb = grp * ncvg / ng; conv = ((grp + 1) * ncvg / ng) != ncb; G2 = P.G - 8 * ncvg; c2 = (grp - ncb) * 8 + (P.bx & 7);
                       if (conv) window_convert(P, (ncb * 8 + (P.bx & 7)) * NWAVES + P.wave, 8 * ncvg * NWAVES); } }
              S.init(T, 3072, G2, c2); }
            pg8::EpiQKV E{(bf16*)(P.ws + WS_Q), (size_t)(WS_K - WS_Q) / 2, C2};
            if (PROBE_QKV) { pg8::EpiQKV_<PROBE_QKV> E2{(bf16*)(P.ws + WS_Q), (size_t)(WS_K - WS_Q) / 2, C2}; if (PROBE_QKV != 4 || (P.bx & 1) == 0) pg8::gemm_phase<pg8::EpiQKV_<PROBE_QKV>, pg8::StaticOrder, true, true>(P.lds, g, S, E2); }
            PHASE_SKEW(P);
            if (!conv) for (int rep = 0; rep < REP_QKV; ++rep) pg8::gemm_phase<pg8::EpiQKV, pg8::StaticOrder, true, true>(P.lds, g, S, E);
            if (!IN(pb + 1)) SEAM(pb + 0);
        }
        if (IN(pb + 1)) { Frame P = launder(F);
            const bool seam0 = IN(pb + 0); auto pre0 = [&]() { if (seam0) SEAM(pb + 0); };
            if (l == 0) phase_attention<0, 0>(P, pre0); else phase_attention<1, 0>(P, pre0);
            SEAM(pb + 1);
        }
        if (IN(pb + 3)) { Frame P = launder(F);
            pg8::Gemm g{(const bf16*)(P.ws + WS_O1), (const bf16*)(P.ws + WS_WO) + (size_t)l * 1024 * 1024, T, 1024, 1024, nullptr}; pg8::StaticOrder S; S.init(T, 1024, P.G, P.bx);
            pg8::EpiRes E{(const bf16*)(P.ws + WS_XB), (bf16*)(P.ws + WS_Q), ALPHA};
            PHASE_SKEW(P);
            for (int rep = 0; rep < REP_WO; ++rep) pg8::gemm_phase<pg8::EpiRes, pg8::StaticOrder, true, true, false, true, true>(P.lds, g, S, E);
            if (!IN(pb + 4)) SEAM(pb + 3);
        }
        if (IN(pb + 4)) { Frame P = launder(F); const bool seam3 = IN(pb + 3); phase_ln_router(P, l, [&]() { if (seam3) SEAM(pb + 3); }); SEAM(pb + 4); }
        if (IN(pb + 5)) { Frame P = launder(F); for (int rep = 0; rep < REP_SLOTS; ++rep) phase_slots(P); SEAM(pb + 5); }
        if (IN(pb + 6)) { Frame P = launder(F);
            const int nt = load_tiles(P);
            pg8::Gemm g{(const bf16*)(P.ws + WS_XB), (const bf16*)(P.ws + (l == 0 ? WS_W13 : WS_W13B)), SLOT_ROWS, 1024, 1024, (const int*)(P.ws + SLOT_TOK)};     pg8::GroupedOrder S{P.MISC + MI_TILE, nt, P.G, P.bx};
            pg8::EpiSwiGLU E{(bf16*)(P.ws + WS_H)};
            PHASE_SKEW(P);
            for (int rep = 0; rep < REP_UP; ++rep) pg8::gemm_phase<pg8::EpiSwiGLU, pg8::GroupedOrder, true, true, true>(P.lds, g, S, E);
            if (l == 0) moe_tail_items(P, nt, 0, UP_PER); else moe_tail_w2(P, nt);
            SEAM(pb + 6);
        }
        if (IN(pb + 7)) { Frame P = launder(F);
            const int nt = load_tiles(P);
            pg8::Gemm g{(const bf16*)(P.ws + WS_H), (const bf16*)(P.ws + (l == 0 ? WS_W2 : WS_W2B)), SLOT_ROWS, 1024, 512, nullptr}; pg8::GroupedOrder S{P.MISC + MI_TILE, nt, P.G, P.bx};
            pg8::EpiY E{(bf16*)(P.ws + WS_Y)};
            PHASE_SKEW(P);
            for (int rep = 0; rep < REP_DOWN; ++rep) pg8::gemm_phase<pg8::EpiY, pg8::GroupedOrder, true, true, false, true, true>(P.lds, g, S, E);
            if (l == 0) moe_tail_items(P, nt, moe_idle_blocks(nt, P.G) * UP_PER, DN_PER);
            if (!IN(pb + 8)) SEAM(pb + 7);
        }
        if (IN(pb + 8)) { Frame P = launder(F); const bool seam7 = IN(pb + 7); phase_moe_combine(P, l, [&]() { if (seam7) SEAM(pb + 7); }); if (l == 0) { const int nt = load_tiles(P); for (int rep = 0; rep < REP_MW1; ++rep) phase_moe_weights(P, 1, moe_idle_blocks(nt, P.G) * (UP_PER + DN_PER), WIN1); } SEAM(pb + 8); }
    }
#undef IN
#undef SEAM
}

extern "C" void kernel_launch(void* const* d_in, const int* in_sizes, int n_in, void* d_out, int out_size, void* d_ws, size_t ws_size, hipStream_t stream) {
    static int grid = 0;
    if (grid == 0) {
        if (n_in != 26 || in_sizes[0] != T * DM || out_size != T * DM || ws_size < WS_END) { fprintf(stderr, "kernel_launch: unexpected shapes / workspace (n_in %d, ws %zu); nothing launched\n", n_in, ws_size); grid = -1; return; }
        int dev = 0, cus = 0, per_cu = 0;
        if (hipGetDevice(&dev) != hipSuccess || hipDeviceGetAttribute(&cus, hipDeviceAttributeMultiprocessorCount, dev) != hipSuccess) { grid = -1; return; }
        if (hipFuncSetAttribute((const void*)fwd, hipFuncAttributeMaxDynamicSharedMemorySize, LDS_BYTES) != hipSuccess) { fprintf(stderr, "kernel_launch: hipFuncSetAttribute failed\n"); grid = -1; return; }
        if (hipOccupancyMaxActiveBlocksPerMultiprocessor(&per_cu, (const void*)fwd, NWAVES * 64, LDS_BYTES) != hipSuccess || per_cu < 1) { fprintf(stderr, "kernel_launch: occupancy query says %d\n", per_cu); }
        (void)hipGetLastError();
        grid = cus;
    }
    if (grid < 0) return;
    if (hipMemsetAsync((char*)d_ws + WS_CTL + (size_t)CW_BAR * 4, 0, (size_t)(MK_SPLIT ? NPH : 1) * XCD_BAR_WORDS * 4, stream) != hipSuccess) return;
    Args a{};
    for (int i = 0; i < 26; ++i) a.in[i] = (const float*)d_in[i];
    a.out = (float*)d_out; a.ws = (unsigned char*)d_ws; a.pad = 0;
#if MK_SPLIT
    int li = 0;
    for (int p = 0; p < NPH; ++p) { if (p == 1 + 9 + 2) continue; a.ph_lo = p; a.ph_hi = p + 1; a.li = li++; hipLaunchKernelGGL(fwd, dim3(grid), dim3(NWAVES * 64), LDS_BYTES, stream, a); }
#else
    a.ph_lo = 0; a.ph_hi = NPH; a.li = 0;
    hipLaunchKernelGGL(fwd, dim3(grid), dim3(NWAVES * 64), LDS_BYTES, stream, a);
#endif
}
```

```cpp
#include <hip/hip_runtime.h>
#include <cstdio>
#include <cstdint>
namespace pg8 {
#define PG8_LAS __attribute__((address_space(3)))
typedef unsigned short bf16_t;
typedef short bf16x8 __attribute__((ext_vector_type(8)));
typedef float f32x4 __attribute__((ext_vector_type(4)));
typedef unsigned u32x4 __attribute__((ext_vector_type(4)));
constexpr int BM = 256, BK = 64, HALF = 128, HTB = HALF * BK * 2  , STAGE_BYTES = 8 * HTB, NXCD = 8, WGM = 8;

__host__ __device__ __forceinline__ int lds_byte(int r, int c) { const int st = (r >> 4) * 2 + (c >> 5), rr = r & 15, cc = c & 31, ob = rr * 64 + cc * 2; return st * 1024 + (ob ^ (((ob >> 9) & 1) << 5)); }
__host__ __device__ __forceinline__ void stage_rc(int b, int& R, int& C) { const int st = b / 1024, sb = b % 1024, swz = sb ^ (((sb >> 9) & 1) << 5); R = (st >> 1) * 16 + swz / 64; C = (st & 1) * 32 + (swz % 64) / 2; }
__host__ __device__ __forceinline__ int perm32(int rho) { const int n = rho >> 4, i = rho & 15; return 8 * (i >> 2) + 4 * n + (i & 3); }

struct Unit { int pm, pn; };
struct Gemm { const bf16_t* A; const bf16_t* Bt; int M, N, K; const int* rowidx; };

struct StaticOrder {
    int nM, nN, nwg, G, c;
    __host__ __device__ void init(int M, int N, int G_, int c_) { nM = M / BM; nN = N / BM; nwg = nM * nN; G = G_; c = c_; }
    __host__ __device__ bool next(int i, Unit& u) const {
        const long L = (long)i * G + c; if (L >= nwg) return false;
        int wgid = (int)L; { const int q = nwg / NXCD, r = nwg % NXCD, xcd = wgid % NXCD, off = wgid / NXCD; wgid = (xcd < r ? xcd * (q + 1) : r * (q + 1) + (xcd - r) * q) + off; }
        const int nig = WGM * nN, gid = wgid / nig, fm = gid * WGM, gsz = (nM - fm) < WGM ? (nM - fm) : WGM;
        u.pm = fm + ((wgid % nig) % gsz); u.pn = (wgid % nig) / gsz; return true;
    }
    __device__ __forceinline__ void a_ready(const Unit&) const {}
    __device__ __forceinline__ void done(const Unit&) const {}
};

__device__ __forceinline__ unsigned cvt_pk_bf16(float lo, float hi) { unsigned r; asm volatile("v_cvt_pk_bf16_f32 %0, %1, %2" : "=v"(r) : "v"(lo), "v"(hi)); return r; }
typedef float f32x2 __attribute__((ext_vector_type(2)));
typedef unsigned u32x2 __attribute__((ext_vector_type(2)));
__device__ __forceinline__ void st16_wt(void* p, u32x4 v) { asm volatile("global_store_dwordx4 %0, %1, off sc1\n\ts_nop 1" :: "v"(p), "v"(v) : "memory"); }
template <int PROBE = 0> struct EpiQKV_ {
    static constexpr bool PERM = true, AFTER_DRAIN = false, COLMAP2 = false; static constexpr int VMOPS = 16;
    bf16_t* Q; size_t kv_stride; float scale0;
    __device__ __forceinline__ void operator()(const f32x4 (&acc)[2][2][4][2], const Unit& u, int wr, int wc, int fr, int fq) const {
        if (PROBE == 2) { asm volatile("" :: "v"(acc[0][0][0][0]), "v"(acc[1][1][3][1])); return; }
        const int t = u.pn >> 2; const float sc = t == 0 ? scale0 : 1.f;
        const int Rw0 = u.pm * BM + wr * 64, cw0 = (u.pn & 3) * BM + wc * 32;
        const int lane_off = t == 0 ? fr * 8 + fq * 128 : t == 1 ? fr * 8 + fq * 512 : fr * 32 + 8 * fq;
        bf16_t* base = Q + (size_t)t * kv_stride + lane_off;
#pragma unroll
        for (int ai = 0; ai < 2; ++ai)
#pragma unroll
            for (int m = 0; m < 4; ++m) { const int Rw = Rw0 + ai * HALF + m * 16, bb = Rw >> 12, s = Rw & 4095;
                const size_t ro = t == 0 ? (size_t)bb * 4194304 + (size_t)((s >> 4) * 1024) : t == 1 ? (size_t)bb * 4194304 + (size_t)((s >> 6) * 4096 + (s & 63) * 8) : (size_t)bb * 4194304 + (size_t)((s >> 6) * 2048 + ((s >> 4) & 3) * 512);
#pragma unroll
                for (int bj = 0; bj < 2; ++bj) { const f32x4 v0 = acc[ai][bj][m][0] * sc, v1 = acc[ai][bj][m][1] * sc; const int cw = cw0 + bj * HALF;
                    const size_t co = t == 0 ? (size_t)((cw >> 6) * 262144 + ((cw >> 5) & 1) * 512) : t == 1 ? (size_t)((cw >> 6) * 262144 + ((cw >> 5) & 1) * 2048) : (size_t)((cw >> 5) * 131072);
                    u32x4 w; w.x = cvt_pk_bf16(v0[0], v0[1]); w.y = cvt_pk_bf16(v0[2], v0[3]); w.z = cvt_pk_bf16(v1[0], v1[1]); w.w = cvt_pk_bf16(v1[2], v1[3]);
                    if (PROBE == 0 || PROBE == 4) *(u32x4*)(base + ro + co) = w; else if (PROBE == 3) *(u32x4*)(Q + ((size_t)(blockIdx.x * 512 + threadIdx.x) * 8)) = w; else asm volatile("" :: "v"(w)); } }
    }
};
typedef EpiQKV_<0> EpiQKV;
struct EpiRes {
    static constexpr bool PERM = true, AFTER_DRAIN = false, COLMAP2 = false; static constexpr int VMOPS = 16;
    const bf16_t* __restrict__ xprev; bf16_t* __restrict__ out; float alpha;
    __device__ __forceinline__ void operator()(const f32x4 (&acc)[2][2][4][2], const Unit& u, int wr, int wc, int fr, int fq) const {
        const int row0 = u.pm * BM + wr * 64 + fr; const int col0 = u.pn * BM + wc * 32 + 8 * fq;
#pragma unroll
        for (int ai = 0; ai < 2; ++ai) {
            u32x4 xw[4][2];
#pragma unroll
            for (int m = 0; m < 4; ++m)
#pragma unroll
                for (int bj = 0; bj < 2; ++bj) xw[m][bj] = *(const u32x4*)(xprev + (size_t)(row0 + ai * HALF + m * 16) * 1024 + col0 + bj * HALF);
#pragma unroll
            for (int m = 0; m < 4; ++m)
#pragma unroll
                for (int bj = 0; bj < 2; ++bj) { const u32x4 w = xw[m][bj]; const f32x4 a0 = acc[ai][bj][m][0], a1 = acc[ai][bj][m][1];
                    u32x4 o;
                    o.x = cvt_pk_bf16(__uint_as_float(w.x << 16) * alpha + a0[0], __uint_as_float(w.x & 0xffff0000u) * alpha + a0[1]);
                    o.y = cvt_pk_bf16(__uint_as_float(w.y << 16) * alpha + a0[2], __uint_as_float(w.y & 0xffff0000u) * alpha + a0[3]);
                    o.z = cvt_pk_bf16(__uint_as_float(w.z << 16) * alpha + a1[0], __uint_as_float(w.z & 0xffff0000u) * alpha + a1[1]);
                    o.w = cvt_pk_bf16(__uint_as_float(w.w << 16) * alpha + a1[2], __uint_as_float(w.w & 0xffff0000u) * alpha + a1[3]);
                    *(u32x4*)(out + (size_t)(row0 + ai * HALF + m * 16) * 1024 + col0 + bj * HALF) = o; }
        }
    }
};
struct EpiSwiGLU {
    static constexpr bool PERM = true, AFTER_DRAIN = false, COLMAP2 = false; static constexpr int VMOPS = 8;
    bf16_t* H;
    __device__ __forceinline__ void operator()(const f32x4 (&acc)[2][2][4][2], const Unit& u, int wr, int wc, int fr, int fq) const {
        const int Rw0 = u.pm * BM + wr * 64, chw = (u.pn & 3) * 16 + wc * 4;
        bf16_t* base = H + fq * 128 + fr * 8;
#pragma unroll
        for (int ai = 0; ai < 2; ++ai)
#pragma unroll
            for (int m = 0; m < 4; ++m) { const int Rw = Rw0 + ai * HALF + m * 16; u32x4 w;
#pragma unroll
                for (int bj = 0; bj < 2; ++bj) { const f32x4 a = acc[ai][bj][m][0], b = acc[ai][bj][m][1]; f32x4 hv;
#pragma unroll
                    for (int i = 0; i < 4; ++i) { const float e = __builtin_amdgcn_exp2f(a[i] * -1.4426950408889634f); hv[i] = a[i] * __builtin_amdgcn_rcpf(1.0f + e) * b[i]; }
                    w[2 * bj] = cvt_pk_bf16(hv[0], hv[1]); w[2 * bj + 1] = cvt_pk_bf16(hv[2], hv[3]); }
                *(u32x4*)(base + (size_t)((Rw >> 4) * 64 + chw) * 128) = w; }
    }
};
struct EpiY {
    static constexpr bool PERM = true, AFTER_DRAIN = false, COLMAP2 = true; static constexpr int VMOPS = 16;
    bf16_t* Y;
    __device__ __forceinline__ void operator()(const f32x4 (&acc)[2][2][4][2], const Unit& u, int wr, int wc, int fr, int fq) const {
        const bool lo = fr < 8;
        bf16_t* base = Y + (size_t)(u.pm * BM + wr * 64 + (fr & 7)) * 1024 + (u.pn & 3) * BM + wc * 64 + (fr >> 3) * 32 + 8 * fq;
#pragma unroll
        for (int ai = 0; ai < 2; ++ai)
#pragma unroll
            for (int m = 0; m < 4; ++m) { u32x4 p[2];
#pragma unroll
                for (int bj = 0; bj < 2; ++bj) { const f32x4 v0 = acc[ai][bj][m][0], v1 = acc[ai][bj][m][1];
                    p[bj].x = cvt_pk_bf16(v0[0], v0[1]); p[bj].y = cvt_pk_bf16(v0[2], v0[3]); p[bj].z = cvt_pk_bf16(v1[0], v1[1]); p[bj].w = cvt_pk_bf16(v1[2], v1[3]); }
                u32x4 s1, s2;
#pragma unroll
                for (int c = 0; c < 4; ++c) { const unsigned send = lo ? p[1][c] : p[0][c];
                    const unsigned x = (unsigned)__builtin_amdgcn_update_dpp(0, (int)send, 0x128, 0xf, 0xf, false);
                    s1[c] = lo ? p[0][c] : x; s2[c] = lo ? x : p[1][c]; }
                bf16_t* rp = base + (size_t)(ai * HALF + m * 16) * 1024;
                *(u32x4*)rp = s1; *(u32x4*)(rp + 8 * 1024) = s2; }
    }
};
struct GroupedOrder {
    const PG8_LAS int* tile_e; int ntiles, G, c;
    __device__ __forceinline__ bool next(int i, Unit& u) const {
        const int L = i * G + c; if (L >= ntiles * 4) return false;
        const int pm = L >> 2; u.pm = pm; u.pn = __builtin_amdgcn_readfirstlane(tile_e[pm]) * 4 + (L & 3); return true;
    }
    __device__ __forceinline__ void a_ready(const Unit&) const {}
    __device__ __forceinline__ void done(const Unit&) const {}
};

template <class Epi, class Sched, bool ALIGN_EPI = false, bool SP2 = false, bool GATHER = false, bool AIMG = false, bool PEEL = false>
__device__ __forceinline__ void gemm_phase(PG8_LAS unsigned char* lds, const Gemm g, const Sched& S, const Epi& E) {
    int tid_ = threadIdx.x; asm volatile("" : "+v"(tid_));
    const int tid = tid_, wid = __builtin_amdgcn_readfirstlane(tid >> 6), lane = tid & 63, wr = wid >> 2, wc = wid & 3, fr = lane & 15, fq = lane >> 4;
    const int K = g.K, nt = K / BK;
    static_assert(!GATHER || SP2, "GATHER is written for the SP2 loop");
    unsigned voffA[2], voffB[2], voffA1[2], nvoA[2], nvoA1[2]; int gR[2]; unsigned gC2[2];
#pragma unroll
    for (int i = 0; i < 2; ++i) { int R, C; stage_rc(tid * 16 + i * 8192, R, C); const int Rb = Epi::COLMAP2 ? (64 * (R >> 5) + perm32(R & 31)) : Epi::PERM ? ((R & ~31) + perm32(R & 31)) : R;
        voffA[i] = AIMG ? (unsigned)(((R >> 4) * (K >> 3) + (C >> 3)) * 256 + (R & 15) * 16) : (unsigned)(R * K + C) * 2u; voffB[i] = (unsigned)(Rb * K + C) * 2u; gR[i] = R; gC2[i] = (unsigned)C * 2u; voffA1[i] = voffA[i]; nvoA[i] = voffA[i]; nvoA1[i] = voffA[i]; }
    const size_t kstep = (size_t)(BK * 2);
    const size_t kstepA = AIMG ? (size_t)2048 : kstep;
    const size_t hstep = (size_t)HALF * K * 2;
    const size_t tstep = 2 * hstep;
    const size_t hstepB = Epi::COLMAP2 ? (size_t)32 * K * 2 : hstep;
    const size_t hstepA = GATHER ? (size_t)0 : hstep;
    const unsigned ldsw = (unsigned)wid * 1024u;
    const int aoff = lds_byte(wr * 64 + fr, fq * 8), boff = lds_byte(wc * 32 + fr, fq * 8);
#define PG8_SA(b, h) (((b) * 2 + (h)) * HTB)
#define PG8_SB(b, h) ((4 + (b) * 2 + (h)) * HTB)
#define PG8_STAGE(bufoff, gbase, voff) do { _Pragma("unroll") for (int _i = 0; _i < 2; ++_i) \
        { unsigned vo_ = (voff)[_i]; asm volatile("" : "+v"(vo_));     \
        __builtin_amdgcn_global_load_lds((const unsigned*)((const char*)(gbase) + vo_), (PG8_LAS unsigned*)(lds + (bufoff) + ldsw + _i * 8192), 16, 0, 0); } } while (0)
#define PG8_LDA(dst, b, h) do { _Pragma("unroll") for (int m = 0; m < 4; ++m) _Pragma("unroll") for (int k = 0; k < 2; ++k) dst[m][k] = *(const PG8_LAS bf16x8*)(lds + PG8_SA(b, h) + aoff + m * 2048 + k * 1024); } while (0)
#define PG8_LDB(dst, b, h) do { _Pragma("unroll") for (int n = 0; n < 2; ++n) _Pragma("unroll") for (int k = 0; k < 2; ++k) dst[n][k] = *(const PG8_LAS bf16x8*)(lds + PG8_SB(b, h) + boff + n * 2048 + k * 1024); } while (0)
#define PG8_MMA(ai, bj, At, Bt) do { __builtin_amdgcn_s_setprio(1); _Pragma("unroll") for (int m = 0; m < 4; ++m) _Pragma("unroll") for (int n = 0; n < 2; ++n) _Pragma("unroll") for (int k = 0; k < 2; ++k) \
        acc[ai][bj][m][n] = __builtin_amdgcn_mfma_f32_16x16x32_bf16(Bt[n][k], At[m][k], acc[ai][bj][m][n], 0, 0, 0); __builtin_amdgcn_s_setprio(0); } while (0)
#define PG8_WAIT_V(n) asm volatile("s_waitcnt vmcnt(" #n ")" ::: "memory")
#define PG8_WAIT_VX(n) asm volatile("s_waitcnt vmcnt(%0)" :: "n"(n) : "memory")
#define PG8_WAIT_L(n) asm volatile("s_waitcnt lgkmcnt(" #n ")" ::: "memory")
#define PG8_BAR __builtin_amdgcn_s_barrier()
#define PG8_SCHED __builtin_amdgcn_sched_barrier(0)
    Unit cur, nxt; int ui = 0;
    if (!S.next(0, cur)) return;
    f32x4 acc[2][2][4][2];
#pragma unroll
    for (int a = 0; a < 2; ++a)
#pragma unroll
        for (int b = 0; b < 2; ++b)
#pragma unroll
            for (int m = 0; m < 4; ++m)
#pragma unroll
                for (int n = 0; n < 2; ++n) acc[a][b][m][n] = (f32x4){0.f, 0.f, 0.f, 0.f};
    bf16x8 At[4][2], B0[2][2], B1[2][2];
    const char* cA = GATHER ? (const char*)g.A : (const char*)g.A + (size_t)cur.pm * tstep; const char* cB = (const char*)g.Bt + (size_t)cur.pn * tstep;
    if constexpr (GATHER) {
        typedef const __attribute__((address_space(1))) int* gip_; const gip_ rix = (gip_)g.rowidx + cur.pm * BM;
        const int r0_ = rix[gR[0]], r1_ = rix[gR[1]], r2_ = rix[HALF + gR[0]], r3_ = rix[HALF + gR[1]];
        __builtin_amdgcn_sched_barrier(0);
        voffA[0] = (unsigned)r0_ * (unsigned)(K * 2) + gC2[0]; voffA[1] = (unsigned)r1_ * (unsigned)(K * 2) + gC2[1]; voffA1[0] = (unsigned)r2_ * (unsigned)(K * 2) + gC2[0]; voffA1[1] = (unsigned)r3_ * (unsigned)(K * 2) + gC2[1];
#pragma unroll
        for (int i = 0; i < 2; ++i) { nvoA[i] = voffA[i]; nvoA1[i] = voffA1[i]; } }
    S.a_ready(cur);
    if constexpr (SP2) {
        PG8_STAGE(PG8_SB(0, 0), cB, voffB); PG8_STAGE(PG8_SB(0, 1), cB + hstepB, voffB); PG8_STAGE(PG8_SA(0, 0), cA, voffA); PG8_STAGE(PG8_SA(0, 1), cA + hstepA, voffA1);
        if (wr == 1) PG8_BAR;
        PG8_WAIT_V(2); PG8_BAR;
        PG8_STAGE(PG8_SB(1, 0), cB + kstep, voffB); PG8_STAGE(PG8_SA(1, 0), cA + kstepA, voffA); PG8_STAGE(PG8_SB(1, 1), cB + hstepB + kstep, voffB);
        PG8_WAIT_V(6); PG8_BAR;
    } else {
        PG8_STAGE(PG8_SB(0, 0), cB, voffB); PG8_STAGE(PG8_SA(0, 0), cA, voffA); PG8_STAGE(PG8_SB(0, 1), cB + hstepB, voffB); PG8_STAGE(PG8_SA(0, 1), cA + hstep, voffA);
        if (wr == 1) PG8_BAR;
        PG8_WAIT_V(4); PG8_BAR;
        PG8_STAGE(PG8_SB(1, 0), cB + kstep, voffB); PG8_STAGE(PG8_SA(1, 0), cA + kstepA, voffA); PG8_STAGE(PG8_SB(1, 1), cB + hstepB + kstep, voffB);
        PG8_WAIT_V(6); PG8_BAR;
    }
    for (;;) {
        const bool has_next = S.next(ui + 1, nxt);
        const char* nA = GATHER ? (const char*)g.A : (has_next ? (const char*)g.A + (size_t)nxt.pm * tstep : cA); const char* nB = has_next ? (const char*)g.Bt + (size_t)nxt.pn * tstep : cB;
        if constexpr (GATHER) {
            if (has_next) { typedef const __attribute__((address_space(1))) int* gip_; const gip_ rix = (gip_)g.rowidx + nxt.pm * BM;
                const int r0_ = rix[gR[0]], r1_ = rix[gR[1]], r2_ = rix[HALF + gR[0]], r3_ = rix[HALF + gR[1]];
                __builtin_amdgcn_sched_barrier(0);
                nvoA[0] = (unsigned)r0_ * (unsigned)(K * 2) + gC2[0]; nvoA[1] = (unsigned)r1_ * (unsigned)(K * 2) + gC2[1]; nvoA1[0] = (unsigned)r2_ * (unsigned)(K * 2) + gC2[0]; nvoA1[1] = (unsigned)r3_ * (unsigned)(K * 2) + gC2[1]; } }
#define PG8_TRIP(WX_) do { \
            const bool last = (t == nt - 2); \
            const bool relax = (ui > 0) && (t == 0); \
            const char* a1 = cA + (size_t)(t + 1) * kstepA; \
            const char* a2 = last ? nA : cA + (size_t)(t + 2) * kstepA; const char* b2 = last ? nB : cB + (size_t)(t + 2) * kstep; \
            const char* a3 = a2 + kstepA; const char* b3 = b2 + kstep; \
            if (last && has_next) S.a_ready(nxt); \
            unsigned so0[2], so1[2]; \
_Pragma("unroll") \
            for (int i = 0; i < 2; ++i) { so0[i] = (GATHER && last) ? nvoA[i] : voffA[i]; so1[i] = (GATHER && last) ? nvoA1[i] : voffA1[i]; } \
            if constexpr (SP2) { \
            PG8_LDB(B0, 0, 0); PG8_LDB(B1, 0, 1); PG8_SCHED; PG8_LDA(At, 0, 0); PG8_STAGE(PG8_SA(1, 1), a1 + hstepA, voffA1); \
            WX_; PG8_WAIT_L(0); PG8_BAR; PG8_MMA(0, 0, At, B0); PG8_MMA(0, 1, At, B1); PG8_BAR; PG8_SCHED; \
            PG8_LDA(At, 0, 1); PG8_STAGE(PG8_SB(0, 0), b2, voffB); PG8_STAGE(PG8_SB(0, 1), b2 + hstepB, voffB); PG8_STAGE(PG8_SA(0, 0), a2, so0); \
            WX_; PG8_WAIT_L(0); PG8_BAR; PG8_MMA(1, 0, At, B0); PG8_MMA(1, 1, At, B1); PG8_BAR; PG8_SCHED; \
            PG8_LDB(B0, 1, 0); PG8_LDB(B1, 1, 1); PG8_SCHED; PG8_LDA(At, 1, 0); PG8_STAGE(PG8_SA(0, 1), a2 + hstepA, so1); \
            PG8_WAIT_V(8); PG8_WAIT_L(0); PG8_BAR; PG8_MMA(0, 0, At, B0); PG8_MMA(0, 1, At, B1); PG8_BAR; PG8_SCHED; \
            PG8_LDA(At, 1, 1); PG8_STAGE(PG8_SB(1, 0), b3, voffB); PG8_STAGE(PG8_SB(1, 1), b3 + hstepB, voffB); PG8_STAGE(PG8_SA(1, 0), a3, so0); \
            PG8_WAIT_V(8); PG8_WAIT_L(0); PG8_BAR; PG8_MMA(1, 0, At, B0); PG8_MMA(1, 1, At, B1); PG8_BAR; PG8_SCHED; \
            } else { \
            PG8_LDB(B0, 0, 0); PG8_SCHED; PG8_LDA(At, 0, 0); PG8_STAGE(PG8_SA(1, 1), a1 + hstep, voffA); \
            PG8_WAIT_L(8); PG8_BAR; PG8_WAIT_L(0); PG8_MMA(0, 0, At, B0); PG8_BAR; PG8_SCHED; \
            PG8_LDB(B1, 0, 1); PG8_STAGE(PG8_SB(0, 0), b2, voffB); \
            PG8_BAR; PG8_WAIT_L(0); PG8_MMA(0, 1, At, B1); PG8_BAR; \
            PG8_LDA(At, 0, 1); PG8_STAGE(PG8_SA(0, 0), a2, voffA); \
            PG8_BAR; PG8_WAIT_L(0); PG8_MMA(1, 0, At, B0); PG8_BAR; PG8_SCHED; \
            PG8_STAGE(PG8_SB(0, 1), b2 + hstepB, voffB); \
            PG8_WAIT_V(6); PG8_BAR; PG8_MMA(1, 1, At, B1); PG8_BAR; \
            PG8_LDB(B0, 1, 0); PG8_SCHED; PG8_LDA(At, 1, 0); PG8_STAGE(PG8_SA(0, 1), a2 + hstep, voffA); \
            PG8_WAIT_L(8); PG8_BAR; PG8_WAIT_L(0); PG8_MMA(0, 0, At, B0); PG8_BAR; PG8_SCHED; \
            PG8_LDB(B1, 1, 1); PG8_STAGE(PG8_SB(1, 0), b3, voffB); \
            PG8_BAR; PG8_WAIT_L(0); PG8_MMA(0, 1, At, B1); PG8_BAR; \
            PG8_LDA(At, 1, 1); PG8_STAGE(PG8_SA(1, 0), a3, voffA); \
            PG8_BAR; PG8_WAIT_L(0); PG8_MMA(1, 0, At, B0); PG8_BAR; PG8_SCHED; \
            PG8_STAGE(PG8_SB(1, 1), b3 + hstepB, voffB); \
            PG8_WAIT_V(6); PG8_BAR; PG8_MMA(1, 1, At, B1); PG8_BAR; \
            } \
        } while (0)
        int t = 0;
        if constexpr (PEEL) { if (SP2 && ui > 0) { PG8_TRIP(PG8_WAIT_VX(8 + Epi::VMOPS)); t = 2; } }
        for (; t < nt; t += 2) { PG8_TRIP(PG8_WAIT_V(8)); }
#undef PG8_TRIP
        if constexpr (ALIGN_EPI) { if (wr == 0) PG8_BAR; }
        if constexpr (!Epi::AFTER_DRAIN) { int t2_ = threadIdx.x; asm volatile("" : "+v"(t2_)); E(acc, cur, wr, wc, t2_ & 15, (t2_ & 63) >> 4); S.done(cur); }
        if (!has_next) break;
#pragma unroll
        for (int a = 0; a < 2; ++a)
#pragma unroll
            for (int b = 0; b < 2; ++b)
#pragma unroll
                for (int m = 0; m < 4; ++m)
#pragma unroll
                    for (int n = 0; n < 2; ++n) acc[a][b][m][n] = (f32x4){0.f, 0.f, 0.f, 0.f};
        cur = nxt; cA = nA; cB = nB; ++ui;
        if constexpr (GATHER) {
#pragma unroll
            for (int i = 0; i < 2; ++i) { voffA[i] = nvoA[i]; voffA1[i] = nvoA1[i]; } }
        if constexpr (ALIGN_EPI) { if (wr == 1) PG8_BAR; }
    }
    PG8_WAIT_V(0);
    if constexpr (!ALIGN_EPI) { if (wr == 0) PG8_BAR; }
    PG8_BAR;
    if constexpr (Epi::AFTER_DRAIN) { E.fused(acc, cur, wr, wc, fr, fq, lds, wid, lane); S.done(cur); }
#undef PG8_SA
#undef PG8_SB
#undef PG8_STAGE
#undef PG8_LDA
#undef PG8_LDB
#undef PG8_MMA
#undef PG8_WAIT_V
#undef PG8_WAIT_VX
#undef PG8_WAIT_L
#undef PG8_BAR
#undef PG8_SCHED
}
}
#define GAS __attribute__((address_space(1)))
#define LAS __attribute__((address_space(3)))
typedef unsigned short bf16;
typedef short bf16x8 __attribute__((ext_vector_type(8)));
typedef short s16x4 __attribute__((ext_vector_type(4)));
typedef short v4i16_t __attribute__((ext_vector_type(4)));
typedef float f32x4 __attribute__((ext_vector_type(4)));
typedef float f32x16 __attribute__((ext_vector_type(16)));
typedef unsigned u32x4 __attribute__((ext_vector_type(4)));
typedef unsigned u32x2 __attribute__((ext_vector_type(2)));
typedef GAS unsigned gu32;
constexpr int NB = 8, SEQ = 4096, DM = 1024, T = NB * SEQ;
constexpr int NEXP = 32, HID = 512, SLOT_ROWS = 73728, MAX_TILES = SLOT_ROWS / 256;
constexpr int NCHUNK = T / 128;
constexpr float LOG2E = 1.4426950408889634f;
constexpr float C2 = 0.125f * LOG2E;
constexpr float ALPHA = 1.4142135623730951f;
constexpr float LN_EPS = 1e-5f, RMS_EPS = 1e-6f;
constexpr float LAM_INIT = 0.2f;

namespace att {
constexpr int KSLOT = 8192, VSLOT = 16384, LDS_V = 2 * KSLOT, SBSLOT = 16384, SBRING = 6, LDS_O1S = 65536, LDS_LUT = 131072, LDS_FLG = LDS_LUT + 1280, ATT_LDS = LDS_FLG + 64, LDS_GAIN = ATT_LDS, LDS_REL = LDS_GAIN + 512;
typedef LAS const unsigned char* lcp;
__device__ __forceinline__ void glds16(const void* gsrc, unsigned lds_dst) { unsigned keep;
    asm volatile("s_mov_b32 %0, m0\n\ts_mov_b32 m0, %2\n\ts_nop 0\n\tglobal_load_lds_dwordx4 %1, off\n\ts_mov_b32 m0, %0" : "=&s"(keep) : "v"(gsrc), "s"(lds_dst) : "memory"); }
typedef float f32x2_t __attribute__((ext_vector_type(2))); typedef __bf16 bf16x2_t __attribute__((ext_vector_type(2)));
__device__ __forceinline__ unsigned cvtpk(float lo, float hi) { f32x2_t v = {lo, hi}; bf16x2_t b = __builtin_convertvector(v, bf16x2_t); return __builtin_bit_cast(unsigned, b); }
__device__ __forceinline__ s16x4 vtr(lcp p) { return __builtin_bit_cast(s16x4, __builtin_amdgcn_ds_read_tr16_b64_v4i16((LAS v4i16_t*)p)); }
#define ATT_MFMA(a, b, c) __builtin_amdgcn_mfma_f32_32x32x16_bf16((a), (b), (c), 0, 0, 0)
__device__ __forceinline__ float max3f(float a, float b, float c) { float r; asm("v_max3_f32 %0, %1, %2, %3" : "=v"(r) : "v"(a), "v"(b), "v"(c)); return r; }
__device__ __forceinline__ float max2f(float a, float b) { float r; asm("v_max_f32_e32 %0, %1, %2" : "=v"(r) : "v"(a), "v"(b)); return r; }
__device__ __forceinline__ float fadd_s(float a, float b) { float r; asm("v_add_f32_e32 %0, %1, %2" : "=v"(r) : "v"(a), "v"(b)); return r; }

template <int MODE, int VAR = 0>
__device__ __forceinline__ void attn_unit(LAS unsigned char* lds, const bf16* Qb, const bf16* Kb, const bf16* Vb, bf16* Ob,
                                          int b, int qcol0, int vcol0, int qb, const float* rel_table, int h, int cmap = 0, float lam = 0.f, const float* subg = nullptr) {
    constexpr int NDQ = MODE == 0 ? 4 : 2;
    int tid_ = threadIdx.x; asm volatile("" : "+v"(tid_));
    const int tid = tid_, lane = tid & 63, r32 = lane & 31, hi = lane >> 5;
    const int wid = __builtin_amdgcn_readfirstlane(tid >> 6);
    const long rowbase = (long)b * SEQ; const int q0 = qb * 256, qw0 = q0 + wid * 32;
    const unsigned lds0 = (unsigned)(uintptr_t)lds;
    asm volatile("s_waitcnt vmcnt(0) lgkmcnt(0)\n\ts_barrier" ::: "memory");
    if (MODE == 1 && tid < 16) ((LAS int*)(lds + LDS_FLG))[tid] = 0;
    if (MODE == 0) {
        if (tid < 320) {
            const int n = tid < 64 ? 0 : tid - 64; int bk = n;
            if (n >= 16) { const float v = __logf((float)n * 0.0625f) / 2.0794415416798357f * 16.0f; bk = 16 + (int)v; bk = bk > 31 ? 31 : bk; }
            { const LAS float* relL = (const LAS float*)(lds + LDS_REL);
              ((LAS float*)(lds + LDS_LUT))[tid] = (relL[bk * 8 + h] - relL[31 * 8 + h]) * LOG2E; }
        }
    }
    const bf16* ksrc = Kb + (((long)b * 16 + (qcol0 >> 6)) * 64) * 4096 + wid * 512 + lane * 8;
    const bf16* vsrc = Vb + (((long)b * 32 + (vcol0 >> 5) + (wid >> 2)) * 64) * 2048 + (wid & 3) * 512 + lane * 8;
#define ATT_KOFF(t, ii) (MODE == 0 ? ((ii) & 1) * KSLOT : ((t) % SBRING) * SBSLOT)
#define ATT_VOFF(t, ii) (MODE == 0 ? LDS_V + ((ii) % 3) * VSLOT : ((t) % SBRING) * SBSLOT + 8192)
#define ATT_DMA(t, ii) do { const long ko_ = (long)(t) * 4096, vo_ = (long)(t) * 2048; const unsigned kb_ = lds0 + (unsigned)ATT_KOFF(t, ii) + (unsigned)wid * 1024u, vb_ = lds0 + (unsigned)ATT_VOFF(t, ii) + (unsigned)wid * 1024u; \
        glds16(ksrc + ko_, (unsigned)__builtin_amdgcn_readfirstlane(kb_)); glds16(vsrc + vo_, (unsigned)__builtin_amdgcn_readfirstlane(vb_)); \
        if (MODE == 0) glds16(vsrc + vo_ + 2 * 64 * 2048, (unsigned)__builtin_amdgcn_readfirstlane(vb_ + 8192u)); } while (0)
    const int NT = 4 * qb + 4;
    const int dg = 4 * qb + (wid >> 1);
    if (VAR != 2) { if (MODE == 0) ATT_DMA(0, 0); else { ATT_DMA(NT - 1, 0); ATT_DMA(NT - 2, 0); ATT_DMA(NT - 3, 0); ATT_DMA(NT - 4, 0); } }
    bf16x8 qr[4];
    { const int sq = qw0 + r32; const bf16* Qw = Qb + ((((long)b * 16 + (qcol0 >> 6)) * 256 + (sq >> 4)) * 1024 + (sq & 15) * 8 + hi * 128);
#pragma unroll
      for (int d0 = 0; d0 < 4; ++d0) qr[d0] = *(const bf16x8*)(Qw + d0 * 256); }
    asm volatile("" : "+v"(qr[0]), "+v"(qr[1]), "+v"(qr[2]), "+v"(qr[3]));
    f32x16 o[NDQ];
#pragma unroll
    for (int d = 0; d < NDQ; ++d)
#pragma unroll
        for (int r = 0; r < 16; ++r) o[d][r] = 0.f;
    float mrun = 0.f, lrun = 0.f, Rrun = MODE == 1 ? 1.f : 0.f;
    bool anyref = false;
    const int vlane = ((lane >> 4) & 1) * 32 + (lane & 3) * 8 + (4 * hi + ((lane & 15) >> 2)) * 64;
    u32x4 pw[4]; int pvslot = LDS_V; bool pend = false; const bool late = wid >= 4;
#define ATT_VRD(buf, d) do { _Pragma("unroll") for (int ks = 0; ks < 4; ++ks) { buf[2 * ks] = vtr(vp_ + (d) * 4096 + ks * 1024); buf[2 * ks + 1] = vtr(vp_ + (d) * 4096 + ks * 1024 + 512); } } while (0)
#define ATT_VMM(buf, d) do { _Pragma("unroll") for (int ks = 0; ks < 4; ++ks) { const bf16x8 vf_ = (bf16x8){buf[2 * ks][0], buf[2 * ks][1], buf[2 * ks][2], buf[2 * ks][3], buf[2 * ks + 1][0], buf[2 * ks + 1][1], buf[2 * ks + 1][2], buf[2 * ks + 1][3]}; \
        o[d] = ATT_MFMA(vf_, __builtin_bit_cast(bf16x8, pw[ks]), o[d]); } } while (0)
#define ATT_PV(vs) do { lcp vp_ = (lcp)(lds + (vs)) + vlane; s16x4 va_[8], vb_[8]; \
        ATT_VRD(va_, 0); ATT_VRD(vb_, 1); __builtin_amdgcn_sched_barrier(0); ATT_VMM(va_, 0); \
        if (NDQ == 4) { ATT_VRD(va_, 2); __builtin_amdgcn_sched_barrier(0); ATT_VMM(vb_, 1); ATT_VRD(vb_, 3); __builtin_amdgcn_sched_barrier(0); ATT_VMM(va_, 2); __builtin_amdgcn_sched_barrier(0); ATT_VMM(vb_, NDQ - 1); } \
        else { __builtin_amdgcn_sched_barrier(0); ATT_VMM(vb_, 1); } } while (0)
    for (int i = 0; i < NT; ++i) {
        const int t = MODE == 0 ? i : dg - i;
        asm volatile("s_waitcnt vmcnt(0) lgkmcnt(0)\n\ts_barrier" ::: "memory");
        if (MODE == 1 && i > 0) {
            const LAS int* fl = (const LAS int*)(lds + LDS_FLG) + ((i - 1) & 1) * 8;
            const int all_done = fl[0] & fl[1] & fl[2] & fl[3] & fl[4] & fl[5] & fl[6] & fl[7];
            if (__builtin_amdgcn_readfirstlane(all_done)) break;
        }
        if (VAR != 2) { if (MODE == 0) { if (i + 1 < NT) ATT_DMA(i + 1, i + 1); } else if (NT - 5 - i >= 0) ATT_DMA(NT - 5 - i, 0); }
        if (VAR == 1) continue;
        if (late && pend) { ATT_PV(pvslot); pend = false; }
        const int k0 = 64 * t;
        if (MODE == 0 ? (k0 > qw0 + 31) : (t < 0)) { if (MODE == 1 && lane == 0) ((LAS int*)(lds + LDS_FLG))[(i & 1) * 8 + wid] = 1; continue; }
        lcp kp = (lcp)(lds + ATT_KOFF(t, i)) + hi * 1024 + r32 * 16;
        const int qrel = qw0 + r32 - k0 - 4 * hi;
        f32x16 p0, p1;
        if (MODE == 0) {
            const bool nearb = (qw0 - k0) < 176;
            { bf16x8 kf[8];
#pragma unroll
              for (int j = 0; j < 8; ++j) kf[j] = *(LAS const bf16x8*)(kp + (j >> 1) * 2048 + (j & 1) * 512);
              __builtin_amdgcn_sched_barrier(0);
              { f32x16 z_; _Pragma("unroll") for (int r = 0; r < 16; ++r) z_[r] = 0.f; p0 = ATT_MFMA(kf[0], qr[0], z_); p1 = ATT_MFMA(kf[1], qr[0], z_); }
#pragma unroll
              for (int d0 = 1; d0 < 4; ++d0) { p0 = ATT_MFMA(kf[2 * d0], qr[d0], p0); p1 = ATT_MFMA(kf[2 * d0 + 1], qr[d0], p1); } }
            __builtin_amdgcn_sched_barrier(0);
            if (nearb) {
                unsigned lb_ = lds0 + (unsigned)LDS_LUT + 4u * (unsigned)(qrel + 5); asm volatile("" : "+v"(lb_));
                float bia[32];
#pragma unroll
                for (int r = 0; r < 16; ++r) { bia[r] = *(const LAS float*)(uintptr_t)(lb_ + 4u * (unsigned)(59 - ((r & 3) + 8 * (r >> 2)))); bia[16 + r] = *(const LAS float*)(uintptr_t)(lb_ + 4u * (unsigned)(27 - ((r & 3) + 8 * (r >> 2)))); }
                __builtin_amdgcn_sched_barrier(0);
#pragma unroll
                for (int r = 0; r < 16; ++r) { p0[r] += bia[r]; p1[r] += bia[16 + r]; }
                if (k0 + 63 > qw0) {
#pragma unroll
                    for (int r = 0; r < 16; ++r) { const int n0 = qrel - ((r & 3) + 8 * (r >> 2)), n1 = n0 - 32;
                        p0[r] = n0 >= 0 ? p0[r] : -INFINITY; p1[r] = n1 >= 0 ? p1[r] : -INFINITY; }
                }
            }
            if (anyref) {
#pragma unroll
                for (int r = 0; r < 16; ++r) { p0[r] -= mrun; p1[r] -= mrun; } }
            asm volatile("s_nop 15\n\ts_nop 7" : "+v"(p0), "+v"(p1));
            if (VAR != 3) {
            float rm;
            { float a = max3f(p0[0], p0[1], p1[0]), b = max3f(p0[2], p0[3], p1[1]); a = max3f(a, p1[2], p1[3]);
#pragma unroll
              for (int r = 4; r < 16; r += 4) { a = max3f(a, p0[r], p0[r + 1]); b = max3f(b, p0[r + 2], p0[r + 3]); a = max3f(a, p1[r], p1[r + 1]); b = max3f(b, p1[r + 2], p1[r + 3]); }
              rm = max2f(a, b);
              const auto rr = __builtin_amdgcn_permlane32_swap(__float_as_uint(rm), __float_as_uint(rm), false, false); rm = max2f(__uint_as_float(rr[0]), __uint_as_float(rr[1])); }
            if (__any(rm > 8.0f)) {
                const float dl = fmaxf(rm, 0.f); mrun += dl; const float f = __builtin_amdgcn_exp2f(-dl); lrun *= f;
                anyref = true;
#pragma unroll
                for (int r = 0; r < 16; ++r) { p0[r] -= dl; p1[r] -= dl; }
#pragma unroll
                for (int d = 0; d < NDQ; ++d)
#pragma unroll
                    for (int r = 0; r < 16; ++r) o[d][r] *= f;
            }
            float ls0 = 0.f, ls1 = 0.f;
#pragma unroll
            for (int r = 0; r < 16; ++r) { p0[r] = __builtin_amdgcn_exp2f(p0[r]); p1[r] = __builtin_amdgcn_exp2f(p1[r]); ls0 += p0[r]; ls1 += p1[r]; asm volatile("" : "+v"(ls0), "+v"(ls1)); }
            lrun += ls0 + ls1;
            } else lrun = 1.f;
        } else {
#pragma unroll
            for (int r = 0; r < 16; ++r) { p0[r] = 0.f; p1[r] = 0.f; }
            { bf16x8 kf[8];
#pragma unroll
              for (int j = 0; j < 8; ++j) kf[j] = *(LAS const bf16x8*)(kp + (j >> 1) * 2048 + (j & 1) * 512);
              __builtin_amdgcn_sched_barrier(0);
#pragma unroll
              for (int d0 = 0; d0 < 4; ++d0) { p0 = ATT_MFMA(kf[2 * d0], qr[d0], p0); p1 = ATT_MFMA(kf[2 * d0 + 1], qr[d0], p1); } }
            const bool diag = (k0 + 63 >= qw0);
            f32x16 a0v, a1v;
#pragma unroll
            for (int r = 0; r < 16; ++r) { const int n0 = qrel - ((r & 3) + 8 * (r >> 2)), n1 = n0 - 32;
                const float e0 = __builtin_amdgcn_exp2f(p0[r]), e1 = __builtin_amdgcn_exp2f(p1[r]);
                float x0 = __builtin_amdgcn_rcpf(1.0f + e0), x1 = __builtin_amdgcn_rcpf(1.0f + e1);
                if (diag) { if (n0 <= 0) x0 = 1.f; if (n1 <= 0) x1 = 1.f; }
                a0v[r] = x0; a1v[r] = x1; p0[r] = 1.0f - x0; p1[r] = 1.0f - x1; }
#define ATT_GRP(av, m) ((av[4 * (m)] * av[4 * (m) + 1]) * (av[4 * (m) + 2] * av[4 * (m) + 3]))
#define ATT_XCH(v, lo_, hi_) do { const auto rr_ = __builtin_amdgcn_permlane32_swap(__float_as_uint(v), __float_as_uint(v), false, false); lo_ = __uint_as_float(rr_[0]); hi_ = __uint_as_float(rr_[1]); } while (0)
#define ATT_INGRP(av, wv, m, P0_) do { float P_ = (P0_); wv[4 * (m) + 3] *= P_; P_ *= av[4 * (m) + 3]; wv[4 * (m) + 2] *= P_; P_ *= av[4 * (m) + 2]; wv[4 * (m) + 1] *= P_; P_ *= av[4 * (m) + 1]; wv[4 * (m)] *= P_; } while (0)
#define ATT_SCAN(av, wv, C, Tt) do { \
                const float l0_ = ATT_GRP(av, 0), l1_ = ATT_GRP(av, 1), l2_ = ATT_GRP(av, 2), l3_ = ATT_GRP(av, 3); \
                float G0_, G1_, G2_, G3_, G4_, G5_, G6_, G7_; ATT_XCH(l0_, G0_, G1_); ATT_XCH(l1_, G2_, G3_); ATT_XCH(l2_, G4_, G5_); ATT_XCH(l3_, G6_, G7_); \
                const float S7_ = (C), S6_ = S7_ * G7_, S5_ = S6_ * G6_, S4_ = S5_ * G5_, S3_ = S4_ * G4_, S2_ = S3_ * G3_, S1_ = S2_ * G2_, S0_ = S1_ * G1_; \
                Tt = S0_ * G0_; \
                ATT_INGRP(av, wv, 0, hi ? S1_ : S0_); ATT_INGRP(av, wv, 1, hi ? S3_ : S2_); ATT_INGRP(av, wv, 2, hi ? S5_ : S4_); ATT_INGRP(av, wv, 3, hi ? S7_ : S6_); } while (0)
            float T1, T0;
            ATT_SCAN(a1v, p1, Rrun, T1);
            ATT_SCAN(a0v, p0, T1, T0);
#undef ATT_SCAN
#undef ATT_GRP
#undef ATT_XCH
#undef ATT_INGRP
            Rrun = T0;
            { const int dn = __all(Rrun < 3.5527137e-15f) ? 1 : 0; if (lane == 0) ((LAS int*)(lds + LDS_FLG))[(i & 1) * 8 + wid] = dn; }
        }
        pw[0] = (u32x4){cvtpk(p0[0], p0[1]), cvtpk(p0[2], p0[3]), cvtpk(p0[4], p0[5]), cvtpk(p0[6], p0[7])};
        pw[1] = (u32x4){cvtpk(p0[8], p0[9]), cvtpk(p0[10], p0[11]), cvtpk(p0[12], p0[13]), cvtpk(p0[14], p0[15])};
        pw[2] = (u32x4){cvtpk(p1[0], p1[1]), cvtpk(p1[2], p1[3]), cvtpk(p1[4], p1[5]), cvtpk(p1[6], p1[7])};
        pw[3] = (u32x4){cvtpk(p1[8], p1[9]), cvtpk(p1[10], p1[11]), cvtpk(p1[12], p1[13]), cvtpk(p1[14], p1[15])};
        pvslot = ATT_VOFF(t, i);
        if (VAR != 4) { if (late) pend = true; else ATT_PV(pvslot); } else { asm volatile("" :: "v"(pw[0]), "v"(pw[1]), "v"(pw[2]), "v"(pw[3])); }
    }
    if (late && pend) ATT_PV(pvslot);
    bf16* Ow = Ob + (((rowbase + qw0 + r32) >> 4) * 128 + (vcol0 >> 3) + hi) * 128 + ((qw0 + r32) & 15) * 8;
#define ATT_OST(d, gg, w0, w1) do { const auto sx_ = __builtin_amdgcn_permlane32_swap((w0).x, (w1).x, false, false); const auto sy_ = __builtin_amdgcn_permlane32_swap((w0).y, (w1).y, false, false); \
        *(u32x4*)(Ow + (4 * (d) + 2 * (gg)) * 128) = (u32x4){sx_[0], sy_[0], sx_[1], sy_[1]}; } while (0)
    if (MODE == 0) {
        { const auto rr = __builtin_amdgcn_permlane32_swap(__float_as_uint(lrun), __float_as_uint(lrun), false, false); lrun = __uint_as_float(rr[0]) + __uint_as_float(rr[1]); }
        const float inv = 1.0f / lrun;
        LAS u32x2* stg = (LAS u32x2*)(lds + LDS_O1S + wid * 8192) + lane;
        if (cmap == 0) {
#pragma unroll
            for (int d = 0; d < NDQ; ++d)
#pragma unroll
                for (int g = 0; g < 4; ++g) { u32x2 w; w.x = cvtpk(o[d][4 * g] * inv, o[d][4 * g + 1] * inv); w.y = cvtpk(o[d][4 * g + 2] * inv, o[d][4 * g + 3] * inv); stg[(d * 4 + g) * 64] = w; }
        } else {
            float ss = 0.f;
#pragma unroll
            for (int d = 0; d < NDQ; ++d)
#pragma unroll
                for (int g = 0; g < 4; ++g) { const u32x2 w = stg[(d * 4 + g) * 64];
                    o[d][4 * g] = __uint_as_float(w.x << 16) - lam * (o[d][4 * g] * inv); o[d][4 * g + 1] = __uint_as_float(w.x & 0xffff0000u) - lam * (o[d][4 * g + 1] * inv);
                    o[d][4 * g + 2] = __uint_as_float(w.y << 16) - lam * (o[d][4 * g + 2] * inv); o[d][4 * g + 3] = __uint_as_float(w.y & 0xffff0000u) - lam * (o[d][4 * g + 3] * inv);
                    ss += (o[d][4 * g] * o[d][4 * g] + o[d][4 * g + 1] * o[d][4 * g + 1]) + (o[d][4 * g + 2] * o[d][4 * g + 2] + o[d][4 * g + 3] * o[d][4 * g + 3]); }
            { const auto rr = __builtin_amdgcn_permlane32_swap(__float_as_uint(ss), __float_as_uint(ss), false, false); ss = __uint_as_float(rr[0]) + __uint_as_float(rr[1]); }
            const float rs = (1.0f - LAM_INIT) / sqrtf(ss * (1.0f / 128.0f) + RMS_EPS);
#pragma unroll
            for (int d = 0; d < NDQ; ++d)
#pragma unroll
                for (int g2 = 0; g2 < 2; ++g2) { u32x2 w[2];
#pragma unroll
                    for (int gi = 0; gi < 2; ++gi) { const int g = 2 * g2 + gi; const f32x4 gg = *(const LAS f32x4*)((const LAS float*)(lds + LDS_GAIN) + 32 * d + 8 * g + 4 * hi);
                        w[gi].x = cvtpk(o[d][4 * g] * rs * gg[0], o[d][4 * g + 1] * rs * gg[1]); w[gi].y = cvtpk(o[d][4 * g + 2] * rs * gg[2], o[d][4 * g + 3] * rs * gg[3]); }
                    ATT_OST(d, g2, w[0], w[1]); }
        }
    } else {
#pragma unroll
        for (int d = 0; d < NDQ; ++d)
#pragma unroll
            for (int g2 = 0; g2 < 2; ++g2) { u32x2 w[2];
#pragma unroll
                for (int gi = 0; gi < 2; ++gi) { const int g = 2 * g2 + gi; w[gi].x = cvtpk(o[d][4 * g], o[d][4 * g + 1]); w[gi].y = cvtpk(o[d][4 * g + 2], o[d][4 * g + 3]); }
                ATT_OST(d, g2, w[0], w[1]); }
    }
#undef ATT_OST
#undef ATT_DMA
#undef ATT_KOFF
#undef ATT_VOFF
#undef ATT_PV
#undef ATT_VRD
#undef ATT_VMM
#undef ATT_BF
}
}
constexpr size_t MiB = 1u << 20;
constexpr size_t WS_CTL = 0, CTL_ZERO_BYTES = 1 * MiB;
constexpr size_t WS_TOK = 1 * MiB;
constexpr size_t TOK_E = WS_TOK, TOK_W = TOK_E + (size_t)T * 4, TOK_SLOT = TOK_W + (size_t)T * 8, BLKCNT = TOK_SLOT + (size_t)T * 8, EOFF = BLKCNT + (size_t)NCHUNK * 32 * 4, SLOT_TOK = EOFF + 256;
static_assert(SLOT_TOK + (size_t)SLOT_ROWS * 4 <= 2 * MiB, "router tables");
constexpr size_t WS_WQKV = 2 * MiB;
constexpr size_t WS_WO = 14 * MiB;
constexpr size_t WS_W13 = 18 * MiB;
constexpr size_t WS_W2 = 82 * MiB;
constexpr size_t WS_XB = 114 * MiB;
constexpr size_t WS_Q = 178 * MiB, WS_K = 242 * MiB, WS_V = 306 * MiB;
static_assert(WS_V - WS_K == WS_K - WS_Q, "Q | K | V at one stride");
constexpr size_t WS_O1 = 370 * MiB, WS_O2 = 434 * MiB;
constexpr size_t WS_XS = 178 * MiB;
constexpr size_t WS_H = 322 * MiB;
constexpr size_t WS_Y = 178 * MiB;
constexpr size_t WS_W13B = 434 * MiB, WS_W2B = 498 * MiB;
constexpr size_t WS_END = 538 * MiB;
static_assert(WS_Y + (size_t)SLOT_ROWS * 2048 <= WS_H && WS_H + (size_t)SLOT_ROWS * 1024 <= 434 * MiB && WS_W13B + 64 * MiB <= WS_W2B && WS_W2B + 32 * MiB <= WS_END && WS_O1 + 64 * MiB <= WS_W13B, "MoE overlay");
constexpr int CW_BAR = 4096;
constexpr int RING_BYTES = 131072;
constexpr int MISC_OFF = 147456;
constexpr int LDS_BYTES = MISC_OFF + 4096 + 256;
constexpr int MI_BAR = 0, MI_LAM = 12, MI_EOFF = 16, MI_CNT = 64, MI_TILE = 128, MI_LGT = 424, MI_PTR = 1000;
static_assert(MI_LGT >= MI_TILE + MAX_TILES && MI_PTR >= MI_LGT + 8 * 72 && (MI_PTR + 52) * 4 <= 4096 + 256 && MI_PTR % 2 == 0, "MISC map");
constexpr int NWAVES = 8;

#define XB_TMO      128
#define XB_XCNT(j)  (256  + 64 * (j))
#define XB_XSUB(j)  (1280 + 64 * (j))
#define XB_XGEN(j)  (2304 + 64 * (j))
#define XB_TOP      3328
#define XB_TOPGEN   3392
#define XCD_BAR_WORDS 3456
#define XB_SPIN_CAP (1u << 18)

__device__ __forceinline__ unsigned xb_ld(unsigned* p)              { return __hip_atomic_load(p, __ATOMIC_RELAXED, __HIP_MEMORY_SCOPE_AGENT); }
__device__ __forceinline__ unsigned xb_add(unsigned* p, unsigned v) { return __hip_atomic_fetch_add(p, v, __ATOMIC_RELAXED, __HIP_MEMORY_SCOPE_AGENT); }
__device__ __forceinline__ unsigned xb_xcc_id() { return (unsigned)__builtin_amdgcn_s_getreg((3 << 11) | 20) & 0xFu; }
#define XB_SPIN(cond, bar) do { unsigned _sp = 0; while (cond) { __builtin_amdgcn_s_sleep(1); \
    if ((++_sp & 255u) == 0u) { if (xb_ld(&(bar)[XB_TMO])) break; if (_sp > XB_SPIN_CAP) { atomicAdd(&(bar)[XB_TMO], 1u); break; } } } } while (0)

struct XcdBarrier {
    unsigned* bar; unsigned x;
    volatile LAS unsigned* st;
};

__device__ __forceinline__ XcdBarrier xcd_barrier_post(unsigned* bar, volatile LAS unsigned* st) {
    XcdBarrier b; b.bar = bar; b.x = xb_xcc_id(); b.st = st;
    if (threadIdx.x == 0) (void)xb_add(&bar[XB_XCNT(b.x)], 1u);
    return b;
}
__device__ __forceinline__ void xcd_barrier_complete(unsigned* bar, unsigned x, unsigned& nloc, unsigned& nx) {
    const unsigned G = gridDim.x * gridDim.y * gridDim.z;
    unsigned sum, cnt, mine, sp = 0u;
    for (;;) {
        sum = 0u; cnt = 0u; mine = 0u;
        unsigned cv[16];
        { const __attribute__((address_space(1))) unsigned* cb = (const __attribute__((address_space(1))) unsigned*)&bar[XB_XCNT(0)];
          asm volatile("global_load_dword %0, %16, off sc1\n\tglobal_load_dword %1, %16, off offset:256 sc1\n\tglobal_load_dword %2, %16, off offset:512 sc1\n\tglobal_load_dword %3, %16, off offset:768 sc1\n\t"
                       "global_load_dword %4, %16, off offset:1024 sc1\n\tglobal_load_dword %5, %16, off offset:1280 sc1\n\tglobal_load_dword %6, %16, off offset:1536 sc1\n\tglobal_load_dword %7, %16, off offset:1792 sc1\n\t"
                       "global_load_dword %8, %16, off offset:2048 sc1\n\tglobal_load_dword %9, %16, off offset:2304 sc1\n\tglobal_load_dword %10, %16, off offset:2560 sc1\n\tglobal_load_dword %11, %16, off offset:2816 sc1\n\t"
                       "global_load_dword %12, %16, off offset:3072 sc1\n\tglobal_load_dword %13, %16, off offset:3328 sc1\n\tglobal_load_dword %14, %16, off offset:3584 sc1\n\tglobal_load_dword %15, %16, off offset:3840 sc1\n\ts_waitcnt vmcnt(0)"
                       : "=&v"(cv[0]), "=&v"(cv[1]), "=&v"(cv[2]), "=&v"(cv[3]), "=&v"(cv[4]), "=&v"(cv[5]), "=&v"(cv[6]), "=&v"(cv[7]), "=&v"(cv[8]), "=&v"(cv[9]), "=&v"(cv[10]), "=&v"(cv[11]), "=&v"(cv[12]), "=&v"(cv[13]), "=&v"(cv[14]), "=&v"(cv[15])
                       : "v"(cb) : "memory"); }
#pragma unroll
        for (unsigned j = 0; j < 16; ++j) { const unsigned c = cv[j]; sum += c; cnt += (c > 0u) ? 1u : 0u; mine = (j == x) ? c : mine; }
        if (sum == G) break;
        __builtin_amdgcn_s_sleep(1);
        if ((++sp & 255u) == 0u) { if (xb_ld(&bar[XB_TMO])) break; if (sp > XB_SPIN_CAP) { atomicAdd(&bar[XB_TMO], 1u); break; } }
    }
    nloc = mine > 0u ? mine : 1u; nx = cnt > 0u ? cnt : 1u;
}

__device__ __forceinline__ void xcd_barrier(const XcdBarrier& b) {
    asm volatile("s_waitcnt vmcnt(0)" ::: "memory");
    __syncthreads();
    if (threadIdx.x == 0) {
        unsigned* bar = b.bar;
        __builtin_amdgcn_s_waitcnt(0);
        unsigned nloc = b.st[0], nx = b.st[1];
        if (nloc == 0u) { xcd_barrier_complete(bar, b.x, nloc, nx); b.st[0] = nloc; b.st[1] = nx; }
        const unsigned old = xb_add(&bar[XB_XSUB(b.x)], 1u);
        const unsigned gen = old / nloc;
        if (old + 1u == (gen + 1u) * nloc) {
            __builtin_amdgcn_fence(__ATOMIC_RELEASE, "agent");
            asm volatile("s_waitcnt vmcnt(0)" ::: "memory");
            const unsigned og = xb_add(&bar[XB_TOP], 1u);
            const unsigned tg = og / nx;
            if (og + 1u == (tg + 1u) * nx) xb_add(&bar[XB_TOPGEN], 1u);
            else XB_SPIN(xb_ld(&bar[XB_TOPGEN]) == tg, bar);
            __builtin_amdgcn_fence(__ATOMIC_ACQUIRE, "agent");
            xb_add(&bar[XB_XGEN(b.x)], 1u);
            asm volatile("s_waitcnt vmcnt(0)" ::: "memory");
        } else {
            XB_SPIN(xb_ld(&bar[XB_XGEN(b.x)]) == gen, bar);
            __builtin_amdgcn_fence(__ATOMIC_ACQUIRE, "agent");
            asm volatile("s_waitcnt vmcnt(0)" ::: "memory");
        }
    }
    __syncthreads();
}
#define RLX_AGENT __ATOMIC_RELAXED, __HIP_MEMORY_SCOPE_AGENT
#define LDS_WAIT() asm volatile("s_waitcnt lgkmcnt(0)" ::: "memory")
__device__ __forceinline__ unsigned f2bf(float f) { unsigned u = __builtin_bit_cast(unsigned, f); return (u + 0x7fffu + ((u >> 16) & 1u)) >> 16; }
__device__ __forceinline__ unsigned pk2(float lo, float hi) { return f2bf(lo) | (f2bf(hi) << 16); }
__device__ __forceinline__ float bflo(unsigned w) { return __uint_as_float(w << 16); }
__device__ __forceinline__ float bfhi(unsigned w) { return __uint_as_float(w & 0xffff0000u); }
template <int CTRL> __device__ __forceinline__ float dpp_f(float v) { return __builtin_bit_cast(float, __builtin_amdgcn_update_dpp(0, __builtin_bit_cast(int, v), CTRL, 0xf, 0xf, true)); }
__device__ __forceinline__ float row_sum16(float v) { v += dpp_f<0xB1>(v); v += dpp_f<0x4E>(v); v += dpp_f<0x141>(v); v += dpp_f<0x140>(v); return v; }
__device__ __forceinline__ float swap16_sum(float v) { const auto r = __builtin_amdgcn_permlane16_swap(__float_as_uint(v), __float_as_uint(v), false, false); return __uint_as_float(r[0]) + __uint_as_float(r[1]); }
__device__ __forceinline__ float swap32_sum(float v) { const auto r = __builtin_amdgcn_permlane32_swap(__float_as_uint(v), __float_as_uint(v), false, false); return __uint_as_float(r[0]) + __uint_as_float(r[1]); }
__device__ __forceinline__ float wave_sum(float v) { return swap32_sum(swap16_sum(row_sum16(v))); }
struct Frame {
    LAS unsigned char* lds; LAS int* MISC; unsigned char* ws;
    int tid, lane, wave, vcu, G, bx;
    float* out;
};
__device__ __forceinline__ Frame launder(const Frame& F0) {
    Frame F = F0;
    asm volatile("" : "+s"(F.ws), "+s"(F.out), "+s"(F.G), "+s"(F.vcu), "+s"(F.bx), "+v"(F.tid));
    F.lane = F.tid & 63; F.wave = __builtin_amdgcn_readfirstlane(F.tid >> 6);
    return F;
}
__device__ __forceinline__ const float* inp(const Frame& F, int k) {
    const unsigned long long v = ((const LAS unsigned long long*)(F.MISC + MI_PTR))[k];
    const unsigned lo = __builtin_amdgcn_readfirstlane((unsigned)v), hi = __builtin_amdgcn_readfirstlane((unsigned)(v >> 32));
    return (const float*)(((unsigned long long)hi << 32) | lo);
}

template <class RowMap>
__device__ __forceinline__ void transpose_item(const float* W, int K, int N, bf16* WT, const RowMap& rm, LAS float* scr, int item, int lane) {
    const int nblk = N / 32, kb = item / nblk, nb = item % nblk, k0 = 64 * kb, n0 = 32 * nb;
    float tv[32];
#pragma unroll
    for (int i = 0; i < 32; ++i) tv[i] = W[(size_t)(k0 + 2 * i + (lane >> 5)) * N + n0 + (lane & 31)];
#pragma unroll
    for (int i = 0; i < 32; ++i) scr[(2 * i + (lane >> 5)) * 33 + (lane & 31)] = tv[i];
    LDS_WAIT(); asm volatile("" ::: "memory");
    const int c = lane & 7;
#pragma unroll
    for (int j = 0; j < 4; ++j) { const int n = (lane >> 3) + 8 * j; const LAS float* s = scr + (8 * c) * 33 + n;
        u32x4 o; o.x = pk2(s[0 * 33], s[1 * 33]); o.y = pk2(s[2 * 33], s[3 * 33]); o.z = pk2(s[4 * 33], s[5 * 33]); o.w = pk2(s[6 * 33], s[7 * 33]);
        *(u32x4*)(WT + (size_t)rm(n0 + n) * K + k0 + 8 * c) = o; }
    LDS_WAIT(); asm volatile("" ::: "memory");
}
struct RowId { int off; __device__ __forceinline__ int operator()(int n) const { return off + n; } };
struct RowW13 { int type; __device__ __forceinline__ int operator()(int n) const { const int jh = n & 127; return 256 * (n >> 7) + 128 * ((jh >> 2) & 1) + 32 * (jh >> 5) + 8 * ((jh >> 3) & 3) + 4 * type + (jh & 3); } };

__device__ __forceinline__ void attn_weight_item(Frame& F, int it, LAS float* scr) {
    bf16* Wqkv = (bf16*)(F.ws + WS_WQKV); bf16* Wo = (bf16*)(F.ws + WS_WO);
    const int l = it >> 11, mtx = (it >> 9) & 3, r = it & 511;
    const int pk = (l == 0 ? 2 : 11) + mtx;
    const float* W = (const float*)((const LAS unsigned long long*)(F.MISC + MI_PTR))[pk];
    if (mtx < 3) transpose_item(W, 1024, 1024, Wqkv + (size_t)l * 3072 * 1024, RowId{mtx * 1024}, scr, r, F.lane);
    else transpose_item(W, 1024, 1024, Wo + (size_t)l * 1024 * 1024, RowId{0}, scr, r, F.lane);
}
__device__ __forceinline__ void phase_prologue(Frame& F) {
    LAS float* scr = (LAS float*)(F.lds + F.wave * 16384);
    const int gw = F.vcu * NWAVES + F.wave, NGW = F.G * NWAVES;
    bf16* Wqkv = (bf16*)(F.ws + WS_WQKV); bf16* Wo = (bf16*)(F.ws + WS_WO);
    for (int it = gw; it < 4 * 512; it += NGW) attn_weight_item(F, it, scr);
    const float* x = inp(F, 0); bf16* xb = (bf16*)(F.ws + WS_XB);
    { const size_t step = (size_t)F.G * 512 * 8;
      for (size_t i = (size_t)(F.bx * 512 + F.tid) * 8; i < (size_t)T * DM; i += 4 * step) {
        f32x4 a[4], b[4];
#pragma unroll
        for (int u = 0; u < 4; ++u) { a[u] = *(const f32x4*)(x + i + u * step); b[u] = *(const f32x4*)(x + i + u * step + 4); }
#pragma unroll
        for (int u = 0; u < 4; ++u) { u32x4 o; o.x = pk2(a[u][0], a[u][1]); o.y = pk2(a[u][2], a[u][3]); o.z = pk2(b[u][0], b[u][1]); o.w = pk2(b[u][2], b[u][3]); *(u32x4*)(xb + i + u * step) = o; } } }
    if (F.wave == 0) {
        const float s1 = wave_sum(inp(F, 6)[F.lane] * inp(F, 7)[F.lane]);
        const float s2 = wave_sum(inp(F, 8)[F.lane] * inp(F, 9)[F.lane]);
        if (F.lane == 0) F.MISC[MI_LAM] = __float_as_int(expf(s1) - expf(s2) + LAM_INIT); }
}
__device__ __forceinline__ void moe_weight_item(Frame& F, int layer, int it, LAS float* scr) {
    bf16* W13 = (bf16*)(F.ws + (layer == 0 ? WS_W13 : WS_W13B)); bf16* W2 = (bf16*)(F.ws + (layer == 0 ? WS_W2 : WS_W2B));
    const float* w1 = inp(F, 23) + (size_t)layer * NEXP * 1024 * 512; const float* w3 = inp(F, 24) + (size_t)layer * NEXP * 1024 * 512; const float* w2 = inp(F, 25) + (size_t)layer * NEXP * 512 * 1024;
    const int mtx = it >> 13, e = (it >> 8) & 31, r = it & 255;
    if (mtx == 0) transpose_item(w1 + (size_t)e * 1024 * 512, 1024, 512, W13 + (size_t)e * 1024 * 1024, RowW13{0}, scr, r, F.lane);
    else if (mtx == 1) transpose_item(w3 + (size_t)e * 1024 * 512, 1024, 512, W13 + (size_t)e * 1024 * 1024, RowW13{1}, scr, r, F.lane);
    else transpose_item(w2 + (size_t)e * 512 * 1024, 512, 1024, W2 + (size_t)e * 1024 * 512, RowId{0}, scr, r, F.lane);
}
constexpr int MW_ITEMS = 3 * NEXP * 256;
__device__ __forceinline__ void phase_moe_weights(Frame& F, int layer, int first = 0, int end = MW_ITEMS) {
    LAS float* scr = (LAS float*)(F.lds + F.wave * 16384);
    const int gw = F.vcu * NWAVES + F.wave, NGW = F.G * NWAVES;
    for (int it = first + gw; it < end; it += NGW) moe_weight_item(F, layer, it, scr);
}
constexpr int W2_FIRST = 2 * NEXP * 256, WIN1 = W2_FIRST - 3072, AW1_ITEMS = 4 * 512;
constexpr int WIN_ITEMS = MW_ITEMS + (W2_FIRST - WIN1) + AW1_ITEMS;
__device__ __forceinline__ void window_convert(Frame& F, int cw, int ncw) {
    LAS float* scr = (LAS float*)(F.lds + F.wave * 16384);
    for (int j = cw; j < WIN_ITEMS; j += ncw) { if (j < MW_ITEMS) moe_weight_item(F, 0, j, scr); else if (j < WIN_ITEMS - AW1_ITEMS) moe_weight_item(F, 1, j - MW_ITEMS + WIN1, scr); else attn_weight_item(F, 2048 + (j - (WIN_ITEMS - AW1_ITEMS)), scr); }
}
constexpr int UP_PER = 48, DN_PER = 24;
__device__ __forceinline__ int moe_idle_blocks(int ntiles, int G) { const int rem = (ntiles * 4) % G; return rem == 0 ? 0 : G - rem; }
__device__ __forceinline__ void moe_tail_items(Frame& F, int ntiles, int base, int per) {
    const int rem = (ntiles * 4) % F.G; if (rem == 0 || F.bx < rem) return;
    LAS float* scr = (LAS float*)(F.lds + F.wave * 16384);
    const int first = base + (F.bx - rem) * per;
    for (int it = first + F.wave; it < first + per && it < WIN1; it += NWAVES) moe_weight_item(F, 1, it, scr);
}
__device__ __forceinline__ void moe_tail_w2(Frame& F, int ntiles) {
    LAS float* scr = (LAS float*)(F.lds + F.wave * 16384);
    const int rem = (ntiles * 4) % F.G;
    if (rem == 0) { for (int it = W2_FIRST + F.bx * NWAVES + F.wave; it < MW_ITEMS; it += F.G * NWAVES) moe_weight_item(F, 1, it, scr); return; }
    if (F.bx < rem) return;
    const int idle = F.G - rem, per = (MW_ITEMS - W2_FIRST + idle - 1) / idle, first = W2_FIRST + (F.bx - rem) * per;
    for (int it = first + F.wave; it < first + per && it < MW_ITEMS; it += NWAVES) moe_weight_item(F, 1, it, scr);
}

template <int MODE, int VAR = 0, class PreFn>
__device__ __forceinline__ void phase_attention(Frame& F, PreFn pre) {
    const bf16* Q = (const bf16*)(F.ws + WS_Q); const bf16* K = (const bf16*)(F.ws + WS_K); const bf16* V = (const bf16*)(F.ws + WS_V);
    bf16* O1 = VAR ? (bf16*)F.out : (bf16*)(F.ws + WS_O1);
    const float* rel = inp(F, 1);
    if (MODE == 0) {
        const float lam = __int_as_float(F.MISC[MI_LAM]);
        const float* subg = inp(F, 10);
        if (F.tid < 256) ((LAS float*)(F.lds + att::LDS_REL))[F.tid] = rel[F.tid];
        if (F.tid < 128) ((LAS float*)(F.lds + att::LDS_GAIN))[F.tid] = subg[F.tid];
        pre();
        for (int P = F.vcu; P < 512; P += F.G) {
            const int bh = P >> 3, s = P & 7, b = bh >> 3, h = bh & 7;
#pragma unroll 1
            for (int k = 0; k < 4; ++k) {
                const int qb = k < 2 ? 15 - s : s, c = k & 1;
                att::attn_unit<0, VAR>(F.lds, Q, K, V, O1, b, 128 * h + 64 * c, 128 * h, qb, rel, h, c, lam, subg);
            }
        }
    } else {
        pre();
        for (int P = F.vcu; P < 1024; P += F.G) {
            const int bh = P >> 3, s = P & 7, b = bh >> 4, hh = bh & 15;
#pragma unroll 1
            for (int k = 0; k < 2; ++k) att::attn_unit<1, VAR>(F.lds, Q, K, V, O1, b, 64 * hh, 64 * hh, k == 0 ? 15 - s : s, rel, 0);
        }
    }
    asm volatile("s_waitcnt vmcnt(0) lgkmcnt(0)\n\ts_barrier" ::: "memory");
}
__device__ __forceinline__ void ln16(f32x4 (&v)[4], const f32x4 (&g)[4], const f32x4 (&bb)[4]) {
    float s = 0.f;
#pragma unroll
    for (int j = 0; j < 4; ++j) s += (v[j][0] + v[j][1]) + (v[j][2] + v[j][3]);
    const float mean = wave_sum(s) * (1.0f / DM); float s2 = 0.f;
#pragma unroll
    for (int j = 0; j < 4; ++j) { v[j] = v[j] - mean; s2 += (v[j][0] * v[j][0] + v[j][1] * v[j][1]) + (v[j][2] * v[j][2] + v[j][3] * v[j][3]); }
    const float rstd = 1.0f / sqrtf(wave_sum(s2) * (1.0f / DM) + LN_EPS);
#pragma unroll
    for (int j = 0; j < 4; ++j) v[j] = v[j] * rstd * g[j] + bb[j];
}
template <class PreFn>
__device__ __forceinline__ void phase_ln_router(Frame& F, int layer, PreFn pre) {
    constexpr int AROW = 2064, A_HI = 0, A_LO = 16 * AROW, RED = 2 * 16 * AROW, LGO = RED + 8 * 3 * 1024, RBIAS = LGO + 2304;
    const float* wg = inp(F, 19) + (size_t)layer * 1024 * 4; const float* we = inp(F, 21) + (size_t)layer * 1024 * 32;
    const int lane = F.lane, wave = F.wave, col = lane & 15, kq = lane >> 4;
    u32x4 bh[4][3], bl[4][3];
#pragma unroll
    for (int s = 0; s < 4; ++s)
#pragma unroll
        for (int blk = 0; blk < 3; ++blk) { const int o = 16 * blk + col; float w8[8];
#pragma unroll
            for (int j = 0; j < 8; ++j) { const int k = 128 * wave + 32 * s + 8 * kq + j; w8[j] = o < 4 ? wg[k * 4 + o] : (o < 36 ? we[k * 32 + o - 4] : 0.f); }
#pragma unroll
            for (int jp = 0; jp < 4; ++jp) { const unsigned wh = pk2(w8[2 * jp], w8[2 * jp + 1]); bh[s][blk][jp] = wh; bl[s][blk][jp] = pk2(w8[2 * jp] - bflo(wh), w8[2 * jp + 1] - bfhi(wh)); } }
    const float* bg = inp(F, 20) + layer * 4; const float* be = inp(F, 22) + layer * 32;
    const float* lg = inp(F, 15) + layer * 1024; const float* lb = inp(F, 16) + layer * 1024;
    LAS int* cnt = F.MISC + MI_CNT; const LAS float* lgv = (const LAS float*)(F.lds + LGO);
    int* tok_e = (int*)(F.ws + TOK_E); float* tok_w = (float*)(F.ws + TOK_W); int* blkcnt = (int*)(F.ws + BLKCNT);
    GAS bf16* xb = (GAS bf16*)(F.ws + WS_XB); const GAS bf16* tb = (const GAS bf16*)(F.ws + WS_Q);
    LAS float* rbL = (LAS float*)(F.lds + RBIAS);
    if (F.tid < 4) rbL[F.tid] = bg[F.tid]; else if (F.tid >= 32 && F.tid < 64) rbL[4 + F.tid - 32] = be[F.tid - 32];
    pre();
    for (int c = F.bx; c < NCHUNK; c += F.G) {
        if (F.tid < 32) cnt[F.tid] = 0;
        u32x2 ra[4], rb[4];
        { const GAS bf16* xr = tb + (size_t)(c * 128 + 2 * wave) * DM;
#pragma unroll
          for (int j = 0; j < 4; ++j) { ra[j] = *(const GAS u32x2*)(xr + 4 * lane + 256 * j); rb[j] = *(const GAS u32x2*)(xr + DM + 4 * lane + 256 * j); } }
        __syncthreads();
#pragma unroll 1
        for (int st = 0; st < 8; ++st) {
            const int tok = c * 128 + st * 16 + 2 * wave;
            f32x4 va[4], vb[4];
#pragma unroll
            for (int j = 0; j < 4; ++j) { va[j] = (f32x4){bflo(ra[j].x), bfhi(ra[j].x), bflo(ra[j].y), bfhi(ra[j].y)}; vb[j] = (f32x4){bflo(rb[j].x), bfhi(rb[j].x), bflo(rb[j].y), bfhi(rb[j].y)}; }
            { const GAS float* lgp = (const GAS float*)lg; const GAS float* lbp = (const GAS float*)lb; asm volatile("" : "+s"(lgp), "+s"(lbp));
              f32x4 gv[4], bv[4];
#pragma unroll
              for (int j = 0; j < 4; ++j) { gv[j] = *(const GAS f32x4*)(lgp + 4 * lane + 256 * j); bv[j] = *(const GAS f32x4*)(lbp + 4 * lane + 256 * j); }
              { const GAS bf16* xr = tb + (size_t)(st < 7 ? tok + 16 : tok) * DM;
#pragma unroll
                  for (int j = 0; j < 4; ++j) { ra[j] = *(const GAS u32x2*)(xr + 4 * lane + 256 * j); rb[j] = *(const GAS u32x2*)(xr + DM + 4 * lane + 256 * j); } }
              ln16(va, gv, bv); ln16(vb, gv, bv); }
#pragma unroll
            for (int j = 0; j < 4; ++j) {
                const unsigned ah0 = pk2(va[j][0], va[j][1]), ah1 = pk2(va[j][2], va[j][3]), bh0 = pk2(vb[j][0], vb[j][1]), bh1 = pk2(vb[j][2], vb[j][3]);
                *(GAS u32x2*)(xb + (size_t)tok * DM + 4 * lane + 256 * j) = (u32x2){ah0, ah1}; *(GAS u32x2*)(xb + (size_t)(tok + 1) * DM + 4 * lane + 256 * j) = (u32x2){bh0, bh1};
                const unsigned al0 = pk2(va[j][0] - bflo(ah0), va[j][1] - bfhi(ah0)), al1 = pk2(va[j][2] - bflo(ah1), va[j][3] - bfhi(ah1));
                const unsigned bl0 = pk2(vb[j][0] - bflo(bh0), vb[j][1] - bfhi(bh0)), bl1 = pk2(vb[j][2] - bflo(bh1), vb[j][3] - bfhi(bh1));
                const int ko = (4 * lane + 256 * j) * 2;
                *(LAS u32x2*)(F.lds + A_HI + (2 * wave) * AROW + ko) = (u32x2){ah0, ah1}; *(LAS u32x2*)(F.lds + A_LO + (2 * wave) * AROW + ko) = (u32x2){al0, al1};
                *(LAS u32x2*)(F.lds + A_HI + (2 * wave + 1) * AROW + ko) = (u32x2){bh0, bh1}; *(LAS u32x2*)(F.lds + A_LO + (2 * wave + 1) * AROW + ko) = (u32x2){bl0, bl1}; }
            __syncthreads();
            f32x4 acc[3];
#pragma unroll
            for (int blk = 0; blk < 3; ++blk) acc[blk] = (f32x4){0.f, 0.f, 0.f, 0.f};
#pragma unroll
            for (int s = 0; s < 4; ++s) { const int kb = (128 * wave + 32 * s + 8 * kq) * 2;
                const bf16x8 ah = *(const LAS bf16x8*)(F.lds + A_HI + col * AROW + kb), al = *(const LAS bf16x8*)(F.lds + A_LO + col * AROW + kb);
#pragma unroll
                for (int blk = 0; blk < 3; ++blk) {
                    acc[blk] = __builtin_amdgcn_mfma_f32_16x16x32_bf16(ah, __builtin_bit_cast(bf16x8, bh[s][blk]), acc[blk], 0, 0, 0);
                    acc[blk] = __builtin_amdgcn_mfma_f32_16x16x32_bf16(al, __builtin_bit_cast(bf16x8, bh[s][blk]), acc[blk], 0, 0, 0);
                    acc[blk] = __builtin_amdgcn_mfma_f32_16x16x32_bf16(ah, __builtin_bit_cast(bf16x8, bl[s][blk]), acc[blk], 0, 0, 0); } }
#pragma unroll
            for (int blk = 0; blk < 3; ++blk) *(LAS f32x4*)(F.lds + RED + ((wave * 3 + blk) * 64 + lane) * 16) = acc[blk];
            __syncthreads();
            { const int t = F.tid >> 5, oo = F.tid & 31;
              float s0 = 0.f, s1 = 0.f;
#pragma unroll
              for (int w = 0; w < 8; ++w) { s0 += *(const LAS float*)(F.lds + RED + ((w * 3 + (oo >> 4)) * 64 + (t >> 2) * 16 + (oo & 15)) * 16 + (t & 3) * 4);
                  if (oo < 4) s1 += *(const LAS float*)(F.lds + RED + ((w * 3 + 2) * 64 + (t >> 2) * 16 + oo) * 16 + (t & 3) * 4); }
              ((LAS float*)(F.lds + LGO))[t * 36 + oo] = s0; if (oo < 4) ((LAS float*)(F.lds + LGO))[t * 36 + 32 + oo] = s1; }
            __syncthreads();
            if (lane < 2) {
                const LAS float* L = lgv + 36 * (2 * wave + lane); const int mytok = tok + lane;
                float gl[4];
#pragma unroll
                for (int j = 0; j < 4; ++j) gl[j] = L[j] + rbL[j];
                int gi = 0; float gm = gl[0];
#pragma unroll
                for (int j = 1; j < 4; ++j) if (gl[j] > gm) { gm = gl[j]; gi = j; }
                float gs = 0.f;
#pragma unroll
                for (int j = 0; j < 4; ++j) gs += expf(gl[j] - gm);
                const float ggate = 1.0f / gs;
                float el[8];
#pragma unroll
                for (int j = 0; j < 8; ++j) el[j] = L[4 + 8 * gi + j] + rbL[4 + 8 * gi + j];
                int i1 = 0; float m1 = el[0];
#pragma unroll
                for (int j = 1; j < 8; ++j) if (el[j] > m1) { m1 = el[j]; i1 = j; }
                int i2 = -1; float m2 = -INFINITY;
#pragma unroll
                for (int j = 0; j < 8; ++j) if (j != i1 && el[j] > m2) { m2 = el[j]; i2 = j; }
                const float ex = expf(m2 - m1); const float wa = ggate / (1.0f + ex), wb = ggate * ex / (1.0f + ex);
                const int ea = gi * 8 + i1, eb = gi * 8 + i2;
                tok_e[mytok] = ea | (eb << 8); tok_w[2 * mytok] = wa; tok_w[2 * mytok + 1] = wb;
                __hip_atomic_fetch_add(cnt + ea, 1, __ATOMIC_RELAXED, __HIP_MEMORY_SCOPE_WORKGROUP); __hip_atomic_fetch_add(cnt + eb, 1, __ATOMIC_RELAXED, __HIP_MEMORY_SCOPE_WORKGROUP);
            }
        }
        __syncthreads();
        if (F.tid < 32) blkcnt[c * 32 + F.tid] = cnt[F.tid];
        __syncthreads();
    }
}
__device__ __forceinline__ void phase_slots(Frame& F) {
    LAS int* tab = (LAS int*)F.lds;
    const int* blkcnt = (const int*)(F.ws + BLKCNT);
    const int* tok_e = (const int*)(F.ws + TOK_E);
    const int te0 = (F.tid < 256 && F.bx < NCHUNK) ? tok_e[F.bx * 128 + (F.tid >> 1)] : 0;
    { int tv[16];
#pragma unroll
      for (int i = 0; i < 16; ++i) tv[i] = __hip_atomic_load(blkcnt + F.tid + 512 * i, RLX_AGENT);
#pragma unroll
      for (int i = 0; i < 16; ++i) tab[F.tid + 512 * i] = tv[i]; }
    __syncthreads();
    LAS int* eoff = F.MISC + MI_EOFF; LAS int* cur = F.MISC + MI_CNT;
    {
        const int e = F.tid & 31, g = F.tid >> 5; LAS int* gsum = F.MISC + MI_LGT;
        int v[16], acc = 0;
#pragma unroll
        for (int i = 0; i < 16; ++i) v[i] = tab[(16 * g + i) * 32 + e];
#pragma unroll
        for (int i = 0; i < 16; ++i) { const int t = v[i]; v[i] = acc; acc += t; }
        gsum[g * 32 + e] = acc;
        __syncthreads();
        int goff = 0;
#pragma unroll
        for (int gg = 0; gg < 16; ++gg) { const int t = gsum[gg * 32 + e]; goff += gg < g ? t : 0; }
#pragma unroll
        for (int i = 0; i < 16; ++i) tab[(16 * g + i) * 32 + e] = v[i] + goff;
        if (g == 15) cur[e] = goff + acc;
    }
    __syncthreads();
    if (F.tid < 33) {
        typedef int i32x4_ __attribute__((ext_vector_type(4))); i32x4_ cv[8];
#pragma unroll
        for (int q = 0; q < 8; ++q) cv[q] = ((const LAS i32x4_*)cur)[q];
        __builtin_amdgcn_sched_barrier(0);
        int o = 0;
#pragma unroll
        for (int q = 0; q < 8; ++q)
#pragma unroll
            for (int c4 = 0; c4 < 4; ++c4) o += (4 * q + c4 < F.tid) ? ((cv[q][c4] + 255) & ~255) : 0;
        eoff[F.tid] = o; }
    __syncthreads();
    { LAS int* tile_e = F.MISC + MI_TILE; int ntl = eoff[32] >> 8; ntl = ntl > MAX_TILES ? MAX_TILES : ntl;
      if (F.tid < ntl) { typedef int i32x4_ __attribute__((ext_vector_type(4))); i32x4_ ev[8];
#pragma unroll
          for (int q = 0; q < 8; ++q) ev[q] = ((const LAS i32x4_*)eoff)[q];
          __builtin_amdgcn_sched_barrier(0);
          int e = 0;
#pragma unroll
          for (int q = 0; q < 8; ++q)
#pragma unroll
              for (int c4 = 0; c4 < 4; ++c4) if (4 * q + c4 >= 1 && ev[q][c4] <= 256 * F.tid) e = 4 * q + c4;
          tile_e[F.tid] = e; } }
    int* slot_tok = (int*)(F.ws + SLOT_TOK);
    for (int e = F.bx; e < 32; e += F.G) for (int s = eoff[e] + cur[e] + F.tid; s < eoff[e + 1]; s += 512) slot_tok[s] = 0;
    int* tok_slot = (int*)(F.ws + TOK_SLOT);
    for (int c = F.bx; c < NCHUNK; c += F.G) {
        const int te = (c == F.bx) ? te0 : ((F.tid < 256) ? tok_e[c * 128 + (F.tid >> 1)] : 0);
        __syncthreads();
        if (F.tid < 32) cur[F.tid] = 0;
        __syncthreads();
        if (F.tid < 256) { const int tok = c * 128 + (F.tid >> 1), k = F.tid & 1; const int e = (te >> (8 * k)) & 255;
            const int pos = eoff[e] + tab[c * 32 + e] + __hip_atomic_fetch_add(cur + e, 1, __ATOMIC_RELAXED, __HIP_MEMORY_SCOPE_WORKGROUP);
            tok_slot[2 * tok + k] = pos; slot_tok[pos] = tok; }
    }
}
__device__ __forceinline__ int load_tiles(Frame& F) {
    LAS int* eoff = F.MISC + MI_EOFF;
    __syncthreads();
    int nt = eoff[32] >> 8; nt = nt > MAX_TILES ? MAX_TILES : nt;
    return __builtin_amdgcn_readfirstlane(nt);
}
template <class PreFn>
__device__ __forceinline__ void phase_moe_combine(Frame& F, int layer, PreFn pre) {
    const float* lg = inp(F, 17) + layer * 1024; const float* lb = inp(F, 18) + layer * 1024;
    f32x4 gv[4], bv[4];
#pragma unroll
    for (int j = 0; j < 4; ++j) { gv[j] = *(const f32x4*)(lg + 4 * F.lane + 256 * j); bv[j] = *(const f32x4*)(lb + 4 * F.lane + 256 * j); }
    pre();
    const float* tok_w = (const float*)(F.ws + TOK_W); const int* tok_slot = (const int*)(F.ws + TOK_SLOT);
    const bf16* Y = (const bf16*)(F.ws + WS_Y); bf16* xb = (bf16*)(F.ws + WS_XB);
    const int gw = F.vcu * NWAVES + F.wave, NGW = F.G * NWAVES;
    int slv = 0; float wvv = 0.f;
    if (2 * gw < T) { slv = __hip_atomic_load(tok_slot + 2 * (2 * gw) + (F.lane & 3), RLX_AGENT); wvv = __hip_atomic_load(tok_w + 2 * (2 * gw) + (F.lane & 3), RLX_AGENT); }
    for (int tok = 2 * gw; tok < T; tok += 2 * NGW) {
        const int ntok = tok + 2 * NGW < T ? tok + 2 * NGW : tok;
        const int nslv = __hip_atomic_load(tok_slot + 2 * ntok + (F.lane & 3), RLX_AGENT); const float nwvv = __hip_atomic_load(tok_w + 2 * ntok + (F.lane & 3), RLX_AGENT);
        const int sa0 = __builtin_amdgcn_readlane(slv, 0), sa1 = __builtin_amdgcn_readlane(slv, 1), sb0 = __builtin_amdgcn_readlane(slv, 2), sb1 = __builtin_amdgcn_readlane(slv, 3);
        float wv[4];
#pragma unroll
        for (int i = 0; i < 4; ++i) wv[i] = __uint_as_float(__builtin_amdgcn_readlane(__float_as_uint(wvv), i));
        bf16* xbr = xb + (size_t)tok * DM;
        f32x4 va[4], vb[4]; u32x2 xa[4], xc[4], ya0[4], ya1[4], yb0[4], yb1[4];
#pragma unroll
        for (int j = 0; j < 4; ++j) { const int o = 4 * F.lane + 256 * j;
            xa[j] = *(const u32x2*)(xbr + o); xc[j] = *(const u32x2*)(xbr + DM + o);
            ya0[j] = *(const u32x2*)(Y + (size_t)sa0 * DM + o); ya1[j] = *(const u32x2*)(Y + (size_t)sa1 * DM + o);
            yb0[j] = *(const u32x2*)(Y + (size_t)sb0 * DM + o); yb1[j] = *(const u32x2*)(Y + (size_t)sb1 * DM + o); }
#pragma unroll
        for (int j = 0; j < 4; ++j) {
            va[j][0] = ALPHA * bflo(xa[j].x) + (wv[0] * bflo(ya0[j].x) + wv[1] * bflo(ya1[j].x)); va[j][1] = ALPHA * bfhi(xa[j].x) + (wv[0] * bfhi(ya0[j].x) + wv[1] * bfhi(ya1[j].x));
            va[j][2] = ALPHA * bflo(xa[j].y) + (wv[0] * bflo(ya0[j].y) + wv[1] * bflo(ya1[j].y)); va[j][3] = ALPHA * bfhi(xa[j].y) + (wv[0] * bfhi(ya0[j].y) + wv[1] * bfhi(ya1[j].y));
            vb[j][0] = ALPHA * bflo(xc[j].x) + (wv[2] * bflo(yb0[j].x) + wv[3] * bflo(yb1[j].x)); vb[j][1] = ALPHA * bfhi(xc[j].x) + (wv[2] * bfhi(yb0[j].x) + wv[3] * bfhi(yb1[j].x));
            vb[j][2] = ALPHA * bflo(xc[j].y) + (wv[2] * bflo(yb0[j].y) + wv[3] * bflo(yb1[j].y)); vb[j][3] = ALPHA * bfhi(xc[j].y) + (wv[2] * bfhi(yb0[j].y) + wv[3] * bfhi(yb1[j].y)); }
        ln16(va, gv, bv); ln16(vb, gv, bv);
#pragma unroll
        for (int j = 0; j < 4; ++j) { const int o = 4 * F.lane + 256 * j;
            if (layer == 0) { u32x2 w; w.x = pk2(va[j][0], va[j][1]); w.y = pk2(va[j][2], va[j][3]); *(u32x2*)(xbr + o) = w;
                w.x = pk2(vb[j][0], vb[j][1]); w.y = pk2(vb[j][2], vb[j][3]); *(u32x2*)(xbr + DM + o) = w; }
            else { float* xr = F.out + (size_t)tok * DM; *(f32x4*)(xr + o) = va[j]; *(f32x4*)(xr + DM + o) = vb[j]; } }
        slv = nslv; wvv = nwvv;
    }
}
constexpr int NPH = 19;
#ifndef PROBE_QKV
#define PROBE_QKV 0
#endif
#ifndef NCVG
#define NCVG 8
#endif
#ifndef REP_QKV
#define REP_QKV 1
#endif
#ifndef PROBE_DA
#define PROBE_DA 0
#endif
#ifndef REP_SB
#define REP_SB 1
#endif
#ifndef REP_UP
#define REP_UP 1
#endif
#ifndef REP_DOWN
#define REP_DOWN 1
#endif
#ifndef REP_PRO
#define REP_PRO 1
#endif
#ifndef REP_WO
#define REP_WO 1
#endif
#ifndef REP_LNR
#define REP_LNR 1
#endif
#ifndef REP_SLOTS
#define REP_SLOTS 1
#endif
#ifndef REP_COMB1
#define REP_COMB1 1
#endif
#ifndef REP_MW1
#define REP_MW1 1
#endif
#ifndef MK_SPLIT
#define MK_SPLIT 0
#endif
struct Args { const float* in[26]; float* out; unsigned char* ws; int ph_lo, ph_hi, li, pad; };
__global__ void __launch_bounds__(NWAVES * 64, 2) fwd(Args args) {
    extern __shared__ __attribute__((aligned(16))) unsigned char lds_raw[];
    Frame F;
    F.lds = (LAS unsigned char*)lds_raw; F.MISC = (LAS int*)(F.lds + MISC_OFF); F.ws = args.ws; F.out = args.out;
    F.tid = threadIdx.x; F.lane = F.tid & 63; F.wave = __builtin_amdgcn_readfirstlane(F.tid >> 6);
    F.G = gridDim.x; F.bx = blockIdx.x; F.vcu = (F.G % 8 == 0) ? (F.bx % 8) * (F.G / 8) + F.bx / 8 : F.bx;
    if (F.tid < 64) F.MISC[F.tid] = 0;
    if (F.tid == 0) {
#pragma unroll
        for (int i = 0; i < 26; ++i) ((LAS unsigned long long*)(F.MISC + MI_PTR))[i] = (unsigned long long)args.in[i];
    }
    __syncthreads();
    XcdBarrier bar = xcd_barrier_post((unsigned*)(F.ws + WS_CTL) + CW_BAR + args.li * XCD_BAR_WORDS, (volatile LAS unsigned*)(F.MISC + MI_BAR));
    const int lo = args.ph_lo, hi = args.ph_hi;
#define IN(k) (lo <= (k) && (k) < hi)
#ifndef SKEW_SLEEP
#define SKEW_SLEEP 0
#endif
#define PHASE_SKEW(P) do { if (SKEW_SLEEP) { const int g_ = ((P).bx >> 3) & 7; for (int i_ = 0; i_ < g_; ++i_) __builtin_amdgcn_s_sleep(SKEW_SLEEP); } } while (0)
#define SEAM(k) do { if ((k) + 1 < hi) { XcdBarrier b_ = bar; asm volatile("" : "+s"(b_.bar), "+s"(b_.x)); xcd_barrier(b_); } } while (0)
    if (IN(0)) { Frame P = launder(F); for (int rep = 0; rep < REP_PRO; ++rep) { phase_prologue(P); } SEAM(0); }
#pragma unroll 1
    for (int l = 0; l < 2; ++l) {
        const int pb = 1 + 9 * l;
        if (IN(pb + 0)) { Frame P = launder(F);
            pg8::Gemm g{(const bf16*)(P.ws + WS_XB), (const bf16*)(P.ws + WS_WQKV) + (size_t)l * 3072 * 1024, T, 3072, 1024, nullptr}; pg8::StaticOrder S;
            bool conv = false; { int G2 = P.G, c2 = P.bx;
              if (l == 0) { const int ng = P.G >> 3, ncvg = ((P.G & 7) == 0 && ng >= 2 * NCVG) ? NCVG : 0;
                if (ncvg == 0) window_convert(P, P.bx * NWAVES + P.wave, P.G * NWAVES);
                else { const int grp = P.bx >> 3, ncb = grp * ncvg / ng; conv = ((grp + 1) * ncvg / ng) != ncb; G2 = P.G - 8 * ncvg; c2 = (grp - ncb) * 8 + (P.bx & 7);
                       if (conv) window_convert(P, (ncb * 8 + (P.bx & 7)) * NWAVES + P.wave, 8 * ncvg * NWAVES); } }
              S.init(T, 3072, G2, c2); }
            pg8::EpiQKV E{(bf16*)(P.ws + WS_Q), (size_t)(WS_K - WS_Q) / 2, C2};
            if (PROBE_QKV) { pg8::EpiQKV_<PROBE_QKV> E2{(bf16*)(P.ws + WS_Q), (size_t)(WS_K - WS_Q) / 2, C2}; if (PROBE_QKV != 4 || (P.bx & 1) == 0) pg8::gemm_phase<pg8::EpiQKV_<PROBE_QKV>, pg8::StaticOrder, true, true>(P.lds, g, S, E2); }
            PHASE_SKEW(P);
            if (!conv) for (int rep = 0; rep < REP_QKV; ++rep) pg8::gemm_phase<pg8::EpiQKV, pg8::StaticOrder, true, true, false, false, true>(P.lds, g, S, E);
            if (!IN(pb + 1)) SEAM(pb + 0);
        }
        if (IN(pb + 1)) { Frame P = launder(F);
            const bool seam0 = IN(pb + 0); auto pre0 = [&]() { if (seam0) SEAM(pb + 0); };
            if (l == 0) phase_attention<0, 0>(P, pre0); else phase_attention<1, 0>(P, pre0);
            SEAM(pb + 1);
        }
        if (IN(pb + 3)) { Frame P = launder(F);
            pg8::Gemm g{(const bf16*)(P.ws + WS_O1), (const bf16*)(P.ws + WS_WO) + (size_t)l * 1024 * 1024, T, 1024, 1024, nullptr}; pg8::StaticOrder S; S.init(T, 1024, P.G, P.bx);
            pg8::EpiRes E{(const bf16*)(P.ws + WS_XB), (bf16*)(P.ws + WS_Q), ALPHA};
            PHASE_SKEW(P);
            for (int rep = 0; rep < REP_WO; ++rep) pg8::gemm_phase<pg8::EpiRes, pg8::StaticOrder, true, true, false, true, true>(P.lds, g, S, E);
            if (!IN(pb + 4)) SEAM(pb + 3);
        }
        if (IN(pb + 4)) { Frame P = launder(F); const bool seam3 = IN(pb + 3); phase_ln_router(P, l, [&]() { if (seam3) SEAM(pb + 3); }); SEAM(pb + 4); }
        if (IN(pb + 5)) { Frame P = launder(F); for (int rep = 0; rep < REP_SLOTS; ++rep) phase_slots(P); SEAM(pb + 5); }
        if (IN(pb + 6)) { Frame P = launder(F);
            const int nt = load_tiles(P);
            pg8::Gemm g{(const bf16*)(P.ws + WS_XB), (const bf16*)(P.ws + (l == 0 ? WS_W13 : WS_W13B)), SLOT_ROWS, 1024, 1024, (const int*)(P.ws + SLOT_TOK)};     pg8::GroupedOrder S{P.MISC + MI_TILE, nt, P.G, P.bx};
            pg8::EpiSwiGLU E{(bf16*)(P.ws + WS_H)};
            PHASE_SKEW(P);
            for (int rep = 0; rep < REP_UP; ++rep) pg8::gemm_phase<pg8::EpiSwiGLU, pg8::GroupedOrder, true, true, true>(P.lds, g, S, E);
            if (l == 0) moe_tail_items(P, nt, 0, UP_PER); else moe_tail_w2(P, nt);
            SEAM(pb + 6);
        }
        if (IN(pb + 7)) { Frame P = launder(F);
            const int nt = load_tiles(P);
            pg8::Gemm g{(const bf16*)(P.ws + WS_H), (const bf16*)(P.ws + (l == 0 ? WS_W2 : WS_W2B)), SLOT_ROWS, 1024, 512, nullptr}; pg8::GroupedOrder S{P.MISC + MI_TILE, nt, P.G, P.bx};
            pg8::EpiY E{(bf16*)(P.ws + WS_Y)};
            PHASE_SKEW(P);
            for (int rep = 0; rep < REP_DOWN; ++rep) pg8::gemm_phase<pg8::EpiY, pg8::GroupedOrder, true, true, false, true, true>(P.lds, g, S, E);
            if (l == 0) moe_tail_items(P, nt, moe_idle_blocks(nt, P.G) * UP_PER, DN_PER);
            if (!IN(pb + 8)) SEAM(pb + 7);
        }
        if (IN(pb + 8)) { Frame P = launder(F); const bool seam7 = IN(pb + 7); phase_moe_combine(P, l, [&]() { if (seam7) SEAM(pb + 7); }); if (l == 0) { const int nt = load_tiles(P); for (int rep = 0; rep < REP_MW1; ++rep) phase_moe_weights(P, 1, moe_idle_blocks(nt, P.G) * (UP_PER + DN_PER), WIN1); } SEAM(pb + 8); }
    }
#undef IN
#undef SEAM
}

extern "C" void kernel_launch(void* const* d_in, const int* in_sizes, int n_in, void* d_out, int out_size, void* d_ws, size_t ws_size, hipStream_t stream) {
    static int grid = 0;
    if (grid == 0) {
        if (n_in != 26 || in_sizes[0] != T * DM || out_size != T * DM || ws_size < WS_END) { fprintf(stderr, "kernel_launch: unexpected shapes / workspace (n_in %d, ws %zu); nothing launched\n", n_in, ws_size); grid = -1; return; }
        int dev = 0, cus = 0, per_cu = 0;
        if (hipGetDevice(&dev) != hipSuccess || hipDeviceGetAttribute(&cus, hipDeviceAttributeMultiprocessorCount, dev) != hipSuccess) { grid = -1; return; }
        if (hipFuncSetAttribute((const void*)fwd, hipFuncAttributeMaxDynamicSharedMemorySize, LDS_BYTES) != hipSuccess) { fprintf(stderr, "kernel_launch: hipFuncSetAttribute failed\n"); grid = -1; return; }
        if (hipOccupancyMaxActiveBlocksPerMultiprocessor(&per_cu, (const void*)fwd, NWAVES * 64, LDS_BYTES) != hipSuccess || per_cu < 1) { fprintf(stderr, "kernel_launch: occupancy query says %d\n", per_cu); }
        (void)hipGetLastError();
        grid = cus;
    }
    if (grid < 0) return;
    if (hipMemsetAsync((char*)d_ws + WS_CTL + (size_t)CW_BAR * 4, 0, (size_t)(MK_SPLIT ? NPH : 1) * XCD_BAR_WORDS * 4, stream) != hipSuccess) return;
    Args a{};
    for (int i = 0; i < 26; ++i) a.in[i] = (const float*)d_in[i];
    a.out = (float*)d_out; a.ws = (unsigned char*)d_ws; a.pad = 0;
#if MK_SPLIT
    int li = 0;
    for (int p = 0; p < NPH; ++p) { if (p == 1 + 9 + 2) continue; a.ph_lo = p; a.ph_hi = p + 1; a.li = li++; hipLaunchKernelGGL(fwd, dim3(grid), dim3(NWAVES * 64), LDS_BYTES, stream, a); }
#else
    a.ph_lo = 0; a.ph_hi = NPH; a.li = 0;
    hipLaunchKernelGGL(fwd, dim3(grid), dim3(NWAVES * 64), LDS_BYTES, stream, a);
#endif
}
```

```cpp
#include <hip/hip_runtime.h>
#include <cstdio>
#include <cstdint>
namespace pg8 {
#define PG8_LAS __attribute__((address_space(3)))
typedef unsigned short bf16_t;
typedef short bf16x8 __attribute__((ext_vector_type(8)));
typedef float f32x4 __attribute__((ext_vector_type(4)));
typedef unsigned u32x4 __attribute__((ext_vector_type(4)));
constexpr int BM = 256, BK = 64, HALF = 128, HTB = HALF * BK * 2  , STAGE_BYTES = 8 * HTB, NXCD = 8, WGM = 8;

__host__ __device__ __forceinline__ int lds_byte(int r, int c) { const int st = (r >> 4) * 2 + (c >> 5), rr = r & 15, cc = c & 31, ob = rr * 64 + cc * 2; return st * 1024 + (ob ^ (((ob >> 9) & 1) << 5)); }
__host__ __device__ __forceinline__ void stage_rc(int b, int& R, int& C) { const int st = b / 1024, sb = b % 1024, swz = sb ^ (((sb >> 9) & 1) << 5); R = (st >> 1) * 16 + swz / 64; C = (st & 1) * 32 + (swz % 64) / 2; }
__host__ __device__ __forceinline__ int perm32(int rho) { const int n = rho >> 4, i = rho & 15; return 8 * (i >> 2) + 4 * n + (i & 3); }

struct Unit { int pm, pn; };
struct Gemm { const bf16_t* A; const bf16_t* Bt; int M, N, K; const int* rowidx; };

struct StaticOrder {
    int nM, nN, nwg, G, c;
    __host__ __device__ void init(int M, int N, int G_, int c_) { nM = M / BM; nN = N / BM; nwg = nM * nN; G = G_; c = c_; }
    __host__ __device__ bool next(int i, Unit& u) const {
        const long L = (long)i * G + c; if (L >= nwg) return false;
        int wgid = (int)L; { const int q = nwg / NXCD, r = nwg % NXCD, xcd = wgid % NXCD, off = wgid / NXCD; wgid = (xcd < r ? xcd * (q + 1) : r * (q + 1) + (xcd - r) * q) + off; }
        const int nig = WGM * nN, gid = wgid / nig, fm = gid * WGM, gsz = (nM - fm) < WGM ? (nM - fm) : WGM;
        u.pm = fm + ((wgid % nig) % gsz); u.pn = (wgid % nig) / gsz; return true;
    }
    __device__ __forceinline__ void a_ready(const Unit&) const {}
    __device__ __forceinline__ void done(const Unit&) const {}
};

__device__ __forceinline__ unsigned cvt_pk_bf16(float lo, float hi) { unsigned r; asm volatile("v_cvt_pk_bf16_f32 %0, %1, %2" : "=v"(r) : "v"(lo), "v"(hi)); return r; }
typedef float f32x2 __attribute__((ext_vector_type(2)));
typedef unsigned u32x2 __attribute__((ext_vector_type(2)));
__device__ __forceinline__ void st16_wt(void* p, u32x4 v) { asm volatile("global_store_dwordx4 %0, %1, off sc1\n\ts_nop 1" :: "v"(p), "v"(v) : "memory"); }
template <int PROBE = 0> struct EpiQKV_ {
    static constexpr bool PERM = true, AFTER_DRAIN = false, COLMAP2 = false; static constexpr int VMOPS = 16;
    bf16_t* Q; size_t kv_stride; float scale0;
    __device__ __forceinline__ void operator()(const f32x4 (&acc)[2][2][4][2], const Unit& u, int wr, int wc, int fr, int fq) const {
        if (PROBE == 2) { asm volatile("" :: "v"(acc[0][0][0][0]), "v"(acc[1][1][3][1])); return; }
        const int t = u.pn >> 2; const float sc = t == 0 ? scale0 : 1.f;
        const int Rw0 = u.pm * BM + wr * 64, cw0 = (u.pn & 3) * BM + wc * 32;
        const int lane_off = t == 0 ? fr * 8 + fq * 128 : t == 1 ? fr * 8 + fq * 512 : fr * 32 + 8 * fq;
        bf16_t* base = Q + (size_t)t * kv_stride + lane_off;
#pragma unroll
        for (int ai = 0; ai < 2; ++ai)
#pragma unroll
            for (int m = 0; m < 4; ++m) { const int Rw = Rw0 + ai * HALF + m * 16, bb = Rw >> 12, s = Rw & 4095;
                const size_t ro = t == 0 ? (size_t)bb * 4194304 + (size_t)((s >> 4) * 1024) : t == 1 ? (size_t)bb * 4194304 + (size_t)((s >> 6) * 4096 + (s & 63) * 8) : (size_t)bb * 4194304 + (size_t)((s >> 6) * 2048 + ((s >> 4) & 3) * 512);
#pragma unroll
                for (int bj = 0; bj < 2; ++bj) { const f32x4 v0 = acc[ai][bj][m][0] * sc, v1 = acc[ai][bj][m][1] * sc; const int cw = cw0 + bj * HALF;
                    const size_t co = t == 0 ? (size_t)((cw >> 6) * 262144 + ((cw >> 5) & 1) * 512) : t == 1 ? (size_t)((cw >> 6) * 262144 + ((cw >> 5) & 1) * 2048) : (size_t)((cw >> 5) * 131072);
                    u32x4 w; w.x = cvt_pk_bf16(v0[0], v0[1]); w.y = cvt_pk_bf16(v0[2], v0[3]); w.z = cvt_pk_bf16(v1[0], v1[1]); w.w = cvt_pk_bf16(v1[2], v1[3]);
                    if (PROBE == 0 || PROBE == 4) *(u32x4*)(base + ro + co) = w; else if (PROBE == 3) *(u32x4*)(Q + ((size_t)(blockIdx.x * 512 + threadIdx.x) * 8)) = w; else asm volatile("" :: "v"(w)); } }
    }
};
typedef EpiQKV_<0> EpiQKV;
struct EpiRes {
    static constexpr bool PERM = true, AFTER_DRAIN = false, COLMAP2 = false; static constexpr int VMOPS = 16;
    const bf16_t* __restrict__ xprev; bf16_t* __restrict__ out; float alpha;
    __device__ __forceinline__ void operator()(const f32x4 (&acc)[2][2][4][2], const Unit& u, int wr, int wc, int fr, int fq) const {
        const int row0 = u.pm * BM + wr * 64 + fr; const int col0 = u.pn * BM + wc * 32 + 8 * fq;
#pragma unroll
        for (int ai = 0; ai < 2; ++ai) {
            u32x4 xw[4][2];
#pragma unroll
            for (int m = 0; m < 4; ++m)
#pragma unroll
                for (int bj = 0; bj < 2; ++bj) xw[m][bj] = *(const u32x4*)(xprev + (size_t)(row0 + ai * HALF + m * 16) * 1024 + col0 + bj * HALF);
#pragma unroll
            for (int m = 0; m < 4; ++m)
#pragma unroll
                for (int bj = 0; bj < 2; ++bj) { const u32x4 w = xw[m][bj]; const f32x4 a0 = acc[ai][bj][m][0], a1 = acc[ai][bj][m][1];
                    u32x4 o;
                    o.x = cvt_pk_bf16(__uint_as_float(w.x << 16) * alpha + a0[0], __uint_as_float(w.x & 0xffff0000u) * alpha + a0[1]);
                    o.y = cvt_pk_bf16(__uint_as_float(w.y << 16) * alpha + a0[2], __uint_as_float(w.y & 0xffff0000u) * alpha + a0[3]);
                    o.z = cvt_pk_bf16(__uint_as_float(w.z << 16) * alpha + a1[0], __uint_as_float(w.z & 0xffff0000u) * alpha + a1[1]);
                    o.w = cvt_pk_bf16(__uint_as_float(w.w << 16) * alpha + a1[2], __uint_as_float(w.w & 0xffff0000u) * alpha + a1[3]);
                    *(u32x4*)(out + (size_t)(row0 + ai * HALF + m * 16) * 1024 + col0 + bj * HALF) = o; }
        }
    }
};
struct EpiSwiGLU {
    static constexpr bool PERM = true, AFTER_DRAIN = false, COLMAP2 = false; static constexpr int VMOPS = 8;
    bf16_t* H;
    __device__ __forceinline__ void operator()(const f32x4 (&acc)[2][2][4][2], const Unit& u, int wr, int wc, int fr, int fq) const {
        const int Rw0 = u.pm * BM + wr * 64, chw = (u.pn & 3) * 16 + wc * 4;
        bf16_t* base = H + fq * 128 + fr * 8;
#pragma unroll
        for (int ai = 0; ai < 2; ++ai)
#pragma unroll
            for (int m = 0; m < 4; ++m) { const int Rw = Rw0 + ai * HALF + m * 16; u32x4 w;
#pragma unroll
                for (int bj = 0; bj < 2; ++bj) { const f32x4 a = acc[ai][bj][m][0], b = acc[ai][bj][m][1]; f32x4 hv;
#pragma unroll
                    for (int i = 0; i < 4; ++i) { const float e = __builtin_amdgcn_exp2f(a[i] * -1.4426950408889634f); hv[i] = a[i] * __builtin_amdgcn_rcpf(1.0f + e) * b[i]; }
                    w[2 * bj] = cvt_pk_bf16(hv[0], hv[1]); w[2 * bj + 1] = cvt_pk_bf16(hv[2], hv[3]); }
                *(u32x4*)(base + (size_t)((Rw >> 4) * 64 + chw) * 128) = w; }
    }
};
struct EpiY {
    static constexpr bool PERM = true, AFTER_DRAIN = false, COLMAP2 = true; static constexpr int VMOPS = 16;
    bf16_t* Y;
    __device__ __forceinline__ void operator()(const f32x4 (&acc)[2][2][4][2], const Unit& u, int wr, int wc, int fr, int fq) const {
        const bool lo = fr < 8;
        bf16_t* base = Y + (size_t)(u.pm * BM + wr * 64 + (fr & 7)) * 1024 + (u.pn & 3) * BM + wc * 64 + (fr >> 3) * 32 + 8 * fq;
#pragma unroll
        for (int ai = 0; ai < 2; ++ai)
#pragma unroll
            for (int m = 0; m < 4; ++m) { u32x4 p[2];
#pragma unroll
                for (int bj = 0; bj < 2; ++bj) { const f32x4 v0 = acc[ai][bj][m][0], v1 = acc[ai][bj][m][1];
                    p[bj].x = cvt_pk_bf16(v0[0], v0[1]); p[bj].y = cvt_pk_bf16(v0[2], v0[3]); p[bj].z = cvt_pk_bf16(v1[0], v1[1]); p[bj].w = cvt_pk_bf16(v1[2], v1[3]); }
                u32x4 s1, s2;
#pragma unroll
                for (int c = 0; c < 4; ++c) { const unsigned send = lo ? p[1][c] : p[0][c];
                    const unsigned x = (unsigned)__builtin_amdgcn_update_dpp(0, (int)send, 0x128, 0xf, 0xf, false);
                    s1[c] = lo ? p[0][c] : x; s2[c] = lo ? x : p[1][c]; }
                bf16_t* rp = base + (size_t)(ai * HALF + m * 16) * 1024;
                *(u32x4*)rp = s1; *(u32x4*)(rp + 8 * 1024) = s2; }
    }
};
struct GroupedOrder {
    const PG8_LAS int* tile_e; int ntiles, G, c;
    __device__ __forceinline__ bool next(int i, Unit& u) const {
        const int L = i * G + c; if (L >= ntiles * 4) return false;
        const int pm = L >> 2; u.pm = pm; u.pn = __builtin_amdgcn_readfirstlane(tile_e[pm]) * 4 + (L & 3); return true;
    }
    __device__ __forceinline__ void a_ready(const Unit&) const {}
    __device__ __forceinline__ void done(const Unit&) const {}
};

template <class Epi, class Sched, bool ALIGN_EPI = false, bool SP2 = false, bool GATHER = false, bool AIMG = false, bool PEEL = false>
__device__ __forceinline__ void gemm_phase(PG8_LAS unsigned char* lds, const Gemm g, const Sched& S, const Epi& E) {
    int tid_ = threadIdx.x; asm volatile("" : "+v"(tid_));
    const int tid = tid_, wid = __builtin_amdgcn_readfirstlane(tid >> 6), lane = tid & 63, wr = wid >> 2, wc = wid & 3, fr = lane & 15, fq = lane >> 4;
    const int K = g.K, nt = K / BK;
    static_assert(!GATHER || SP2, "GATHER is written for the SP2 loop");
    unsigned voffA[2], voffB[2], voffA1[2], nvoA[2], nvoA1[2]; int gR[2]; unsigned gC2[2];
#pragma unroll
    for (int i = 0; i < 2; ++i) { int R, C; stage_rc(tid * 16 + i * 8192, R, C); const int Rb = Epi::COLMAP2 ? (64 * (R >> 5) + perm32(R & 31)) : Epi::PERM ? ((R & ~31) + perm32(R & 31)) : R;
        voffA[i] = AIMG ? (unsigned)(((R >> 4) * (K >> 3) + (C >> 3)) * 256 + (R & 15) * 16) : (unsigned)(R * K + C) * 2u; voffB[i] = (unsigned)(Rb * K + C) * 2u; gR[i] = R; gC2[i] = (unsigned)C * 2u; voffA1[i] = voffA[i]; nvoA[i] = voffA[i]; nvoA1[i] = voffA[i]; }
    const size_t kstep = (size_t)(BK * 2);
    const size_t kstepA = AIMG ? (size_t)2048 : kstep;
    const size_t hstep = (size_t)HALF * K * 2;
    const size_t tstep = 2 * hstep;
    const size_t hstepB = Epi::COLMAP2 ? (size_t)32 * K * 2 : hstep;
    const size_t hstepA = GATHER ? (size_t)0 : hstep;
    const unsigned ldsw = (unsigned)wid * 1024u;
    const int aoff = lds_byte(wr * 64 + fr, fq * 8), boff = lds_byte(wc * 32 + fr, fq * 8);
#define PG8_SA(b, h) (((b) * 2 + (h)) * HTB)
#define PG8_SB(b, h) ((4 + (b) * 2 + (h)) * HTB)
#define PG8_STAGE(bufoff, gbase, voff) do { _Pragma("unroll") for (int _i = 0; _i < 2; ++_i) \
        { unsigned vo_ = (voff)[_i]; asm volatile("" : "+v"(vo_));     \
        __builtin_amdgcn_global_load_lds((const unsigned*)((const char*)(gbase) + vo_), (PG8_LAS unsigned*)(lds + (bufoff) + ldsw + _i * 8192), 16, 0, 0); } } while (0)
#define PG8_LDA(dst, b, h) do { _Pragma("unroll") for (int m = 0; m < 4; ++m) _Pragma("unroll") for (int k = 0; k < 2; ++k) dst[m][k] = *(const PG8_LAS bf16x8*)(lds + PG8_SA(b, h) + aoff + m * 2048 + k * 1024); } while (0)
#define PG8_LDB(dst, b, h) do { _Pragma("unroll") for (int n = 0; n < 2; ++n) _Pragma("unroll") for (int k = 0; k < 2; ++k) dst[n][k] = *(const PG8_LAS bf16x8*)(lds + PG8_SB(b, h) + boff + n * 2048 + k * 1024); } while (0)
#define PG8_MMA(ai, bj, At, Bt) do { __builtin_amdgcn_s_setprio(1); _Pragma("unroll") for (int m = 0; m < 4; ++m) _Pragma("unroll") for (int n = 0; n < 2; ++n) _Pragma("unroll") for (int k = 0; k < 2; ++k) \
        acc[ai][bj][m][n] = __builtin_amdgcn_mfma_f32_16x16x32_bf16(Bt[n][k], At[m][k], acc[ai][bj][m][n], 0, 0, 0); __builtin_amdgcn_s_setprio(0); } while (0)
#define PG8_WAIT_V(n) asm volatile("s_waitcnt vmcnt(" #n ")" ::: "memory")
#define PG8_WAIT_VX(n) asm volatile("s_waitcnt vmcnt(%0)" :: "n"(n) : "memory")
#define PG8_WAIT_L(n) asm volatile("s_waitcnt lgkmcnt(" #n ")" ::: "memory")
#define PG8_BAR __builtin_amdgcn_s_barrier()
#define PG8_SCHED __builtin_amdgcn_sched_barrier(0)
    Unit cur, nxt; int ui = 0;
    if (!S.next(0, cur)) return;
    f32x4 acc[2][2][4][2];
#pragma unroll
    for (int a = 0; a < 2; ++a)
#pragma unroll
        for (int b = 0; b < 2; ++b)
#pragma unroll
            for (int m = 0; m < 4; ++m)
#pragma unroll
                for (int n = 0; n < 2; ++n) acc[a][b][m][n] = (f32x4){0.f, 0.f, 0.f, 0.f};
    bf16x8 At[4][2], B0[2][2], B1[2][2];
    const char* cA = GATHER ? (const char*)g.A : (const char*)g.A + (size_t)cur.pm * tstep; const char* cB = (const char*)g.Bt + (size_t)cur.pn * tstep;
    if constexpr (GATHER) {
        typedef const __attribute__((address_space(1))) int* gip_; const gip_ rix = (gip_)g.rowidx + cur.pm * BM;
        const int r0_ = rix[gR[0]], r1_ = rix[gR[1]], r2_ = rix[HALF + gR[0]], r3_ = rix[HALF + gR[1]];
        __builtin_amdgcn_sched_barrier(0);
        voffA[0] = (unsigned)r0_ * (unsigned)(K * 2) + gC2[0]; voffA[1] = (unsigned)r1_ * (unsigned)(K * 2) + gC2[1]; voffA1[0] = (unsigned)r2_ * (unsigned)(K * 2) + gC2[0]; voffA1[1] = (unsigned)r3_ * (unsigned)(K * 2) + gC2[1];
#pragma unroll
        for (int i = 0; i < 2; ++i) { nvoA[i] = voffA[i]; nvoA1[i] = voffA1[i]; } }
    S.a_ready(cur);
    if constexpr (SP2) {
        PG8_STAGE(PG8_SB(0, 0), cB, voffB); PG8_STAGE(PG8_SB(0, 1), cB + hstepB, voffB); PG8_STAGE(PG8_SA(0, 0), cA, voffA); PG8_STAGE(PG8_SA(0, 1), cA + hstepA, voffA1);
        if (wr == 1) PG8_BAR;
        PG8_WAIT_V(2); PG8_BAR;
        PG8_STAGE(PG8_SB(1, 0), cB + kstep, voffB); PG8_STAGE(PG8_SA(1, 0), cA + kstepA, voffA); PG8_STAGE(PG8_SB(1, 1), cB + hstepB + kstep, voffB);
        PG8_WAIT_V(6); PG8_BAR;
    } else {
        PG8_STAGE(PG8_SB(0, 0), cB, voffB); PG8_STAGE(PG8_SA(0, 0), cA, voffA); PG8_STAGE(PG8_SB(0, 1), cB + hstepB, voffB); PG8_STAGE(PG8_SA(0, 1), cA + hstep, voffA);
        if (wr == 1) PG8_BAR;
        PG8_WAIT_V(4); PG8_BAR;
        PG8_STAGE(PG8_SB(1, 0), cB + kstep, voffB); PG8_STAGE(PG8_SA(1, 0), cA + kstepA, voffA); PG8_STAGE(PG8_SB(1, 1), cB + hstepB + kstep, voffB);
        PG8_WAIT_V(6); PG8_BAR;
    }
    for (;;) {
        const bool has_next = S.next(ui + 1, nxt);
        const char* nA = GATHER ? (const char*)g.A : (has_next ? (const char*)g.A + (size_t)nxt.pm * tstep : cA); const char* nB = has_next ? (const char*)g.Bt + (size_t)nxt.pn * tstep : cB;
        if constexpr (GATHER) {
            if (has_next) { typedef const __attribute__((address_space(1))) int* gip_; const gip_ rix = (gip_)g.rowidx + nxt.pm * BM;
                const int r0_ = rix[gR[0]], r1_ = rix[gR[1]], r2_ = rix[HALF + gR[0]], r3_ = rix[HALF + gR[1]];
                __builtin_amdgcn_sched_barrier(0);
                nvoA[0] = (unsigned)r0_ * (unsigned)(K * 2) + gC2[0]; nvoA[1] = (unsigned)r1_ * (unsigned)(K * 2) + gC2[1]; nvoA1[0] = (unsigned)r2_ * (unsigned)(K * 2) + gC2[0]; nvoA1[1] = (unsigned)r3_ * (unsigned)(K * 2) + gC2[1]; } }
#define PG8_TRIP(WX_) do { \
            const bool last = (t == nt - 2); \
            const bool relax = (ui > 0) && (t == 0); \
            const char* a1 = cA + (size_t)(t + 1) * kstepA; \
            const char* a2 = last ? nA : cA + (size_t)(t + 2) * kstepA; const char* b2 = last ? nB : cB + (size_t)(t + 2) * kstep; \
            const char* a3 = a2 + kstepA; const char* b3 = b2 + kstep; \
            if (last && has_next) S.a_ready(nxt); \
            unsigned so0[2], so1[2]; \
_Pragma("unroll") \
            for (int i = 0; i < 2; ++i) { so0[i] = (GATHER && last) ? nvoA[i] : voffA[i]; so1[i] = (GATHER && last) ? nvoA1[i] : voffA1[i]; } \
            if constexpr (SP2) { \
            PG8_LDB(B0, 0, 0); PG8_LDB(B1, 0, 1); PG8_SCHED; PG8_LDA(At, 0, 0); PG8_STAGE(PG8_SA(1, 1), a1 + hstepA, voffA1); \
            WX_; PG8_WAIT_L(0); PG8_BAR; PG8_MMA(0, 0, At, B0); PG8_MMA(0, 1, At, B1); PG8_BAR; PG8_SCHED; \
            PG8_LDA(At, 0, 1); PG8_STAGE(PG8_SB(0, 0), b2, voffB); PG8_STAGE(PG8_SB(0, 1), b2 + hstepB, voffB); PG8_STAGE(PG8_SA(0, 0), a2, so0); \
            WX_; PG8_WAIT_L(0); PG8_BAR; PG8_MMA(1, 0, At, B0); PG8_MMA(1, 1, At, B1); PG8_BAR; PG8_SCHED; \
            PG8_LDB(B0, 1, 0); PG8_LDB(B1, 1, 1); PG8_SCHED; PG8_LDA(At, 1, 0); PG8_STAGE(PG8_SA(0, 1), a2 + hstepA, so1); \
            PG8_WAIT_V(8); PG8_WAIT_L(0); PG8_BAR; PG8_MMA(0, 0, At, B0); PG8_MMA(0, 1, At, B1); PG8_BAR; PG8_SCHED; \
            PG8_LDA(At, 1, 1); PG8_STAGE(PG8_SB(1, 0), b3, voffB); PG8_STAGE(PG8_SB(1, 1), b3 + hstepB, voffB); PG8_STAGE(PG8_SA(1, 0), a3, so0); \
            PG8_WAIT_V(8); PG8_WAIT_L(0); PG8_BAR; PG8_MMA(1, 0, At, B0); PG8_MMA(1, 1, At, B1); PG8_BAR; PG8_SCHED; \
            } else { \
            PG8_LDB(B0, 0, 0); PG8_SCHED; PG8_LDA(At, 0, 0); PG8_STAGE(PG8_SA(1, 1), a1 + hstep, voffA); \
            PG8_WAIT_L(8); PG8_BAR; PG8_WAIT_L(0); PG8_MMA(0, 0, At, B0); PG8_BAR; PG8_SCHED; \
            PG8_LDB(B1, 0, 1); PG8_STAGE(PG8_SB(0, 0), b2, voffB); \
            PG8_BAR; PG8_WAIT_L(0); PG8_MMA(0, 1, At, B1); PG8_BAR; \
            PG8_LDA(At, 0, 1); PG8_STAGE(PG8_SA(0, 0), a2, voffA); \
            PG8_BAR; PG8_WAIT_L(0); PG8_MMA(1, 0, At, B0); PG8_BAR; PG8_SCHED; \
            PG8_STAGE(PG8_SB(0, 1), b2 + hstepB, voffB); \
            PG8_WAIT_V(6); PG8_BAR; PG8_MMA(1, 1, At, B1); PG8_BAR; \
            PG8_LDB(B0, 1, 0); PG8_SCHED; PG8_LDA(At, 1, 0); PG8_STAGE(PG8_SA(0, 1), a2 + hstep, voffA); \
            PG8_WAIT_L(8); PG8_BAR; PG8_WAIT_L(0); PG8_MMA(0, 0, At, B0); PG8_BAR; PG8_SCHED; \
            PG8_LDB(B1, 1, 1); PG8_STAGE(PG8_SB(1, 0), b3, voffB); \
            PG8_BAR; PG8_WAIT_L(0); PG8_MMA(0, 1, At, B1); PG8_BAR; \
            PG8_LDA(At, 1, 1); PG8_STAGE(PG8_SA(1, 0), a3, voffA); \
            PG8_BAR; PG8_WAIT_L(0); PG8_MMA(1, 0, At, B0); PG8_BAR; PG8_SCHED; \
            PG8_STAGE(PG8_SB(1, 1), b3 + hstepB, voffB); \
            PG8_WAIT_V(6); PG8_BAR; PG8_MMA(1, 1, At, B1); PG8_BAR; \
            } \
        } while (0)
        int t = 0;
        if constexpr (PEEL) { if (SP2 && ui > 0) { PG8_TRIP(PG8_WAIT_VX(8 + Epi::VMOPS)); t = 2; } }
        for (; t < nt; t += 2) { PG8_TRIP(PG8_WAIT_V(8)); }
#undef PG8_TRIP
        if constexpr (ALIGN_EPI) { if (wr == 0) PG8_BAR; }
        if constexpr (!Epi::AFTER_DRAIN) { int t2_ = threadIdx.x; asm volatile("" : "+v"(t2_)); E(acc, cur, wr, wc, t2_ & 15, (t2_ & 63) >> 4); S.done(cur); }
        if (!has_next) break;
#pragma unroll
        for (int a = 0; a < 2; ++a)
#pragma unroll
            for (int b = 0; b < 2; ++b)
#pragma unroll
                for (int m = 0; m < 4; ++m)
#pragma unroll
                    for (int n = 0; n < 2; ++n) acc[a][b][m][n] = (f32x4){0.f, 0.f, 0.f, 0.f};
        cur = nxt; cA = nA; cB = nB; ++ui;
        if constexpr (GATHER) {
#pragma unroll
            for (int i = 0; i < 2; ++i) { voffA[i] = nvoA[i]; voffA1[i] = nvoA1[i]; } }
        if constexpr (ALIGN_EPI) { if (wr == 1) PG8_BAR; }
    }
    PG8_WAIT_V(0);
    if constexpr (!ALIGN_EPI) { if (wr == 0) PG8_BAR; }
    PG8_BAR;
    if constexpr (Epi::AFTER_DRAIN) { E.fused(acc, cur, wr, wc, fr, fq, lds, wid, lane); S.done(cur); }
#undef PG8_SA
#undef PG8_SB
#undef PG8_STAGE
#undef PG8_LDA
#undef PG8_LDB
#undef PG8_MMA
#undef PG8_WAIT_V
#undef PG8_WAIT_VX
#undef PG8_WAIT_L
#undef PG8_BAR
#undef PG8_SCHED
}
}
#define GAS __attribute__((address_space(1)))
#define LAS __attribute__((address_space(3)))
typedef unsigned short bf16;
typedef short bf16x8 __attribute__((ext_vector_type(8)));
typedef short s16x4 __attribute__((ext_vector_type(4)));
typedef short v4i16_t __attribute__((ext_vector_type(4)));
typedef float f32x4 __attribute__((ext_vector_type(4)));
typedef float f32x16 __attribute__((ext_vector_type(16)));
typedef unsigned u32x4 __attribute__((ext_vector_type(4)));
typedef unsigned u32x2 __attribute__((ext_vector_type(2)));
typedef GAS unsigned gu32;
constexpr int NB = 8, SEQ = 4096, DM = 1024, T = NB * SEQ;
constexpr int NEXP = 32, HID = 512, SLOT_ROWS = 73728, MAX_TILES = SLOT_ROWS / 256;
constexpr int NCHUNK = T / 128;
constexpr float LOG2E = 1.4426950408889634f;
constexpr float C2 = 0.125f * LOG2E;
constexpr float ALPHA = 1.4142135623730951f;
constexpr float LN_EPS = 1e-5f, RMS_EPS = 1e-6f;
constexpr float LAM_INIT = 0.2f;

namespace att {
constexpr int KSLOT = 8192, VSLOT = 16384, LDS_V = 2 * KSLOT, SBSLOT = 16384, SBRING = 6, LDS_O1S = 65536, LDS_LUT = 131072, LDS_FLG = LDS_LUT + 1280, ATT_LDS = LDS_FLG + 64, LDS_GAIN = ATT_LDS, LDS_REL = LDS_GAIN + 512;
typedef LAS const unsigned char* lcp;
__device__ __forceinline__ void glds16(const void* sbase, unsigned voff, unsigned lds_dst) { unsigned keep;
    asm volatile("s_mov_b32 %0, m0\n\ts_mov_b32 m0, %2\n\ts_nop 0\n\tglobal_load_lds_dwordx4 %1, %3\n\ts_mov_b32 m0, %0" : "=&s"(keep) : "v"(voff), "s"(lds_dst), "s"(sbase) : "memory"); }
typedef float f32x2_t __attribute__((ext_vector_type(2))); typedef __bf16 bf16x2_t __attribute__((ext_vector_type(2)));
__device__ __forceinline__ unsigned cvtpk(float lo, float hi) { f32x2_t v = {lo, hi}; bf16x2_t b = __builtin_convertvector(v, bf16x2_t); return __builtin_bit_cast(unsigned, b); }
__device__ __forceinline__ s16x4 vtr(lcp p) { return __builtin_bit_cast(s16x4, __builtin_amdgcn_ds_read_tr16_b64_v4i16((LAS v4i16_t*)p)); }
#define ATT_MFMA(a, b, c) __builtin_amdgcn_mfma_f32_32x32x16_bf16((a), (b), (c), 0, 0, 0)
__device__ __forceinline__ float max3f(float a, float b, float c) { float r; asm("v_max3_f32 %0, %1, %2, %3" : "=v"(r) : "v"(a), "v"(b), "v"(c)); return r; }
__device__ __forceinline__ float max2f(float a, float b) { float r; asm("v_max_f32_e32 %0, %1, %2" : "=v"(r) : "v"(a), "v"(b)); return r; }
__device__ __forceinline__ float fadd_s(float a, float b) { float r; asm("v_add_f32_e32 %0, %1, %2" : "=v"(r) : "v"(a), "v"(b)); return r; }

template <int MODE, int VAR = 0>
__device__ __forceinline__ void attn_unit(LAS unsigned char* lds, const bf16* Qb, const bf16* Kb, const bf16* Vb, bf16* Ob,
                                          int b, int qcol0, int vcol0, int qb, const float* rel_table, int h, int cmap = 0, float lam = 0.f, const float* subg = nullptr) {
    constexpr int NDQ = MODE == 0 ? 4 : 2;
    int tid_ = threadIdx.x; asm volatile("" : "+v"(tid_));
    const int tid = tid_, lane = tid & 63, r32 = lane & 31, hi = lane >> 5;
    const int wid = __builtin_amdgcn_readfirstlane(tid >> 6);
    const long rowbase = (long)b * SEQ; const int q0 = qb * 256, qw0 = q0 + wid * 32;
    const unsigned lds0 = (unsigned)(uintptr_t)lds;
    asm volatile("s_waitcnt vmcnt(0) lgkmcnt(0)\n\ts_barrier" ::: "memory");
    if (MODE == 1 && tid < 16) ((LAS int*)(lds + LDS_FLG))[tid] = 0;
    if (MODE == 0) {
        if (tid < 320) {
            const int n = tid < 64 ? 0 : tid - 64; int bk = n;
            if (n >= 16) { const float v = __logf((float)n * 0.0625f) / 2.0794415416798357f * 16.0f; bk = 16 + (int)v; bk = bk > 31 ? 31 : bk; }
            { const LAS float* relL = (const LAS float*)(lds + LDS_REL);
              ((LAS float*)(lds + LDS_LUT))[tid] = (relL[bk * 8 + h] - relL[31 * 8 + h]) * LOG2E; }
        }
    }
    const bf16* ksrc = Kb + (((long)b * 16 + (qcol0 >> 6)) * 64) * 4096 + wid * 512;
    const bf16* vsrc = Vb + (((long)b * 32 + (vcol0 >> 5) + (wid >> 2)) * 64) * 2048 + (wid & 3) * 512;
    const unsigned lane16 = (unsigned)lane * 16u;
#define ATT_KOFF(t, ii) (MODE == 0 ? ((ii) & 1) * KSLOT : ((t) % SBRING) * SBSLOT)
#define ATT_VOFF(t, ii) (MODE == 0 ? LDS_V + ((ii) % 3) * VSLOT : ((t) % SBRING) * SBSLOT + 8192)
#define ATT_DMA(t, ii) do { const long ko_ = (long)(t) * 4096, vo_ = (long)(t) * 2048; const unsigned kb_ = lds0 + (unsigned)ATT_KOFF(t, ii) + (unsigned)wid * 1024u, vb_ = lds0 + (unsigned)ATT_VOFF(t, ii) + (unsigned)wid * 1024u; \
        glds16(ksrc + ko_, lane16, (unsigned)__builtin_amdgcn_readfirstlane(kb_)); glds16(vsrc + vo_, lane16, (unsigned)__builtin_amdgcn_readfirstlane(vb_)); \
        if (MODE == 0) glds16(vsrc + vo_ + 2 * 64 * 2048, lane16, (unsigned)__builtin_amdgcn_readfirstlane(vb_ + 8192u)); } while (0)
    const int NT = 4 * qb + 4;
    const int dg = 4 * qb + (wid >> 1);
    if (VAR != 2) { if (MODE == 0) ATT_DMA(0, 0); else { ATT_DMA(NT - 1, 0); ATT_DMA(NT - 2, 0); ATT_DMA(NT - 3, 0); ATT_DMA(NT - 4, 0); } }
    bf16x8 qr[4];
    { const int sq = qw0 + r32; const bf16* Qw = Qb + ((((long)b * 16 + (qcol0 >> 6)) * 256 + (sq >> 4)) * 1024 + (sq & 15) * 8 + hi * 128);
#pragma unroll
      for (int d0 = 0; d0 < 4; ++d0) qr[d0] = *(const bf16x8*)(Qw + d0 * 256); }
    asm volatile("" : "+v"(qr[0]), "+v"(qr[1]), "+v"(qr[2]), "+v"(qr[3]));
    f32x16 o[NDQ];
#pragma unroll
    for (int d = 0; d < NDQ; ++d)
#pragma unroll
        for (int r = 0; r < 16; ++r) o[d][r] = 0.f;
    float mrun = 0.f, lrun = 0.f, Rrun = MODE == 1 ? 1.f : 0.f;
    bool anyref = false;
    const int vlane = ((lane >> 4) & 1) * 32 + (lane & 3) * 8 + (4 * hi + ((lane & 15) >> 2)) * 64;
    u32x4 pw[4]; int pvslot = LDS_V; bool pend = false; const bool late = wid >= 4;
#define ATT_VRD(buf, d) do { _Pragma("unroll") for (int ks = 0; ks < 4; ++ks) { buf[2 * ks] = vtr(vp_ + (d) * 4096 + ks * 1024); buf[2 * ks + 1] = vtr(vp_ + (d) * 4096 + ks * 1024 + 512); } } while (0)
#define ATT_VMM(buf, d) do { _Pragma("unroll") for (int ks = 0; ks < 4; ++ks) { const bf16x8 vf_ = (bf16x8){buf[2 * ks][0], buf[2 * ks][1], buf[2 * ks][2], buf[2 * ks][3], buf[2 * ks + 1][0], buf[2 * ks + 1][1], buf[2 * ks + 1][2], buf[2 * ks + 1][3]}; \
        o[d] = ATT_MFMA(vf_, __builtin_bit_cast(bf16x8, pw[ks]), o[d]); } } while (0)
#define ATT_PV(vs) do { lcp vp_ = (lcp)(lds + (vs)) + vlane; s16x4 va_[8], vb_[8]; \
        ATT_VRD(va_, 0); ATT_VRD(vb_, 1); __builtin_amdgcn_sched_barrier(0); ATT_VMM(va_, 0); \
        if (NDQ == 4) { ATT_VRD(va_, 2); __builtin_amdgcn_sched_barrier(0); ATT_VMM(vb_, 1); ATT_VRD(vb_, 3); __builtin_amdgcn_sched_barrier(0); ATT_VMM(va_, 2); __builtin_amdgcn_sched_barrier(0); ATT_VMM(vb_, NDQ - 1); } \
        else { __builtin_amdgcn_sched_barrier(0); ATT_VMM(vb_, 1); } } while (0)
    for (int i = 0; i < NT; ++i) {
        const int t = MODE == 0 ? i : dg - i;
        asm volatile("s_waitcnt vmcnt(0) lgkmcnt(0)\n\ts_barrier" ::: "memory");
        if (MODE == 1 && i > 0) {
            const LAS int* fl = (const LAS int*)(lds + LDS_FLG) + ((i - 1) & 1) * 8;
            const int all_done = fl[0] & fl[1] & fl[2] & fl[3] & fl[4] & fl[5] & fl[6] & fl[7];
            if (__builtin_amdgcn_readfirstlane(all_done)) break;
        }
        if (VAR != 2) { if (MODE == 0) { if (i + 1 < NT) ATT_DMA(i + 1, i + 1); } else if (NT - 5 - i >= 0) ATT_DMA(NT - 5 - i, 0); }
        if (VAR == 1) continue;
        if (late && pend) { ATT_PV(pvslot); pend = false; }
        const int k0 = 64 * t;
        if (MODE == 0 ? (k0 > qw0 + 31) : (t < 0)) { if (MODE == 1 && lane == 0) ((LAS int*)(lds + LDS_FLG))[(i & 1) * 8 + wid] = 1; continue; }
        lcp kp = (lcp)(lds + ATT_KOFF(t, i)) + hi * 1024 + r32 * 16;
        const int qrel = qw0 + r32 - k0 - 4 * hi;
        f32x16 p0, p1;
        if (MODE == 0) {
            const bool nearb = (qw0 - k0) < 176;
            { bf16x8 kf[8];
#pragma unroll
              for (int j = 0; j < 8; ++j) kf[j] = *(LAS const bf16x8*)(kp + (j >> 1) * 2048 + (j & 1) * 512);
              __builtin_amdgcn_sched_barrier(0);
              { f32x16 z_; _Pragma("unroll") for (int r = 0; r < 16; ++r) z_[r] = 0.f; p0 = ATT_MFMA(kf[0], qr[0], z_); p1 = ATT_MFMA(kf[1], qr[0], z_); }
#pragma unroll
              for (int d0 = 1; d0 < 4; ++d0) { p0 = ATT_MFMA(kf[2 * d0], qr[d0], p0); p1 = ATT_MFMA(kf[2 * d0 + 1], qr[d0], p1); } }
            __builtin_amdgcn_sched_barrier(0);
            if (nearb) {
                unsigned lb_ = lds0 + (unsigned)LDS_LUT + 4u * (unsigned)(qrel + 5); asm volatile("" : "+v"(lb_));
                float bia[32];
#pragma unroll
                for (int r = 0; r < 16; ++r) { bia[r] = *(const LAS float*)(uintptr_t)(lb_ + 4u * (unsigned)(59 - ((r & 3) + 8 * (r >> 2)))); bia[16 + r] = *(const LAS float*)(uintptr_t)(lb_ + 4u * (unsigned)(27 - ((r & 3) + 8 * (r >> 2)))); }
                __builtin_amdgcn_sched_barrier(0);
#pragma unroll
                for (int r = 0; r < 16; ++r) { p0[r] += bia[r]; p1[r] += bia[16 + r]; }
                if (k0 + 63 > qw0) {
#pragma unroll
                    for (int r = 0; r < 16; ++r) { const int n0 = qrel - ((r & 3) + 8 * (r >> 2)), n1 = n0 - 32;
                        p0[r] = n0 >= 0 ? p0[r] : -INFINITY; p1[r] = n1 >= 0 ? p1[r] : -INFINITY; }
                }
            }
            if (anyref) {
#pragma unroll
                for (int r = 0; r < 16; ++r) { p0[r] -= mrun; p1[r] -= mrun; } }
            asm volatile("s_nop 15\n\ts_nop 7" : "+v"(p0), "+v"(p1));
            if (VAR != 3) {
            float rm;
            { float a = max3f(p0[0], p0[1], p1[0]), b = max3f(p0[2], p0[3], p1[1]); a = max3f(a, p1[2], p1[3]);
#pragma unroll
              for (int r = 4; r < 16; r += 4) { a = max3f(a, p0[r], p0[r + 1]); b = max3f(b, p0[r + 2], p0[r + 3]); a = max3f(a, p1[r], p1[r + 1]); b = max3f(b, p1[r + 2], p1[r + 3]); }
              rm = max2f(a, b);
              const auto rr = __builtin_amdgcn_permlane32_swap(__float_as_uint(rm), __float_as_uint(rm), false, false); rm = max2f(__uint_as_float(rr[0]), __uint_as_float(rr[1])); }
            if (__any(rm > 8.0f)) {
                const float dl = fmaxf(rm, 0.f); mrun += dl; const float f = __builtin_amdgcn_exp2f(-dl); lrun *= f;
                anyref = true;
#pragma unroll
                for (int r = 0; r < 16; ++r) { p0[r] -= dl; p1[r] -= dl; }
#pragma unroll
                for (int d = 0; d < NDQ; ++d)
#pragma unroll
                    for (int r = 0; r < 16; ++r) o[d][r] *= f;
            }
            float ls0 = 0.f, ls1 = 0.f;
#pragma unroll
            for (int r = 0; r < 16; ++r) { p0[r] = __builtin_amdgcn_exp2f(p0[r]); p1[r] = __builtin_amdgcn_exp2f(p1[r]); ls0 += p0[r]; ls1 += p1[r]; asm volatile("" : "+v"(ls0), "+v"(ls1)); }
            lrun += ls0 + ls1;
            } else lrun = 1.f;
        } else {
#pragma unroll
            for (int r = 0; r < 16; ++r) { p0[r] = 0.f; p1[r] = 0.f; }
            { bf16x8 kf[8];
#pragma unroll
              for (int j = 0; j < 8; ++j) kf[j] = *(LAS const bf16x8*)(kp + (j >> 1) * 2048 + (j & 1) * 512);
              __builtin_amdgcn_sched_barrier(0);
#pragma unroll
              for (int d0 = 0; d0 < 4; ++d0) { p0 = ATT_MFMA(kf[2 * d0], qr[d0], p0); p1 = ATT_MFMA(kf[2 * d0 + 1], qr[d0], p1); } }
            const bool diag = (k0 + 63 >= qw0);
            f32x16 a0v, a1v;
#pragma unroll
            for (int r = 0; r < 16; ++r) { const int n0 = qrel - ((r & 3) + 8 * (r >> 2)), n1 = n0 - 32;
                const float e0 = __builtin_amdgcn_exp2f(p0[r]), e1 = __builtin_amdgcn_exp2f(p1[r]);
                float x0 = __builtin_amdgcn_rcpf(1.0f + e0), x1 = __builtin_amdgcn_rcpf(1.0f + e1);
                if (diag) { if (n0 <= 0) x0 = 1.f; if (n1 <= 0) x1 = 1.f; }
                a0v[r] = x0; a1v[r] = x1; p0[r] = 1.0f - x0; p1[r] = 1.0f - x1; }
#define ATT_GRP(av, m) ((av[4 * (m)] * av[4 * (m) + 1]) * (av[4 * (m) + 2] * av[4 * (m) + 3]))
#define ATT_XCH(v, lo_, hi_) do { const auto rr_ = __builtin_amdgcn_permlane32_swap(__float_as_uint(v), __float_as_uint(v), false, false); lo_ = __uint_as_float(rr_[0]); hi_ = __uint_as_float(rr_[1]); } while (0)
#define ATT_INGRP(av, wv, m, P0_) do { float P_ = (P0_); wv[4 * (m) + 3] *= P_; P_ *= av[4 * (m) + 3]; wv[4 * (m) + 2] *= P_; P_ *= av[4 * (m) + 2]; wv[4 * (m) + 1] *= P_; P_ *= av[4 * (m) + 1]; wv[4 * (m)] *= P_; } while (0)
#define ATT_SCAN(av, wv, C, Tt) do { \
                const float l0_ = ATT_GRP(av, 0), l1_ = ATT_GRP(av, 1), l2_ = ATT_GRP(av, 2), l3_ = ATT_GRP(av, 3); \
                float G0_, G1_, G2_, G3_, G4_, G5_, G6_, G7_; ATT_XCH(l0_, G0_, G1_); ATT_XCH(l1_, G2_, G3_); ATT_XCH(l2_, G4_, G5_); ATT_XCH(l3_, G6_, G7_); \
                const float S7_ = (C), S6_ = S7_ * G7_, S5_ = S6_ * G6_, S4_ = S5_ * G5_, S3_ = S4_ * G4_, S2_ = S3_ * G3_, S1_ = S2_ * G2_, S0_ = S1_ * G1_; \
                Tt = S0_ * G0_; \
                ATT_INGRP(av, wv, 0, hi ? S1_ : S0_); ATT_INGRP(av, wv, 1, hi ? S3_ : S2_); ATT_INGRP(av, wv, 2, hi ? S5_ : S4_); ATT_INGRP(av, wv, 3, hi ? S7_ : S6_); } while (0)
            float T1, T0;
            ATT_SCAN(a1v, p1, Rrun, T1);
            ATT_SCAN(a0v, p0, T1, T0);
#undef ATT_SCAN
#undef ATT_GRP
#undef ATT_XCH
#undef ATT_INGRP
            Rrun = T0;
            { const int dn = __all(Rrun < 3.5527137e-15f) ? 1 : 0; if (lane == 0) ((LAS int*)(lds + LDS_FLG))[(i & 1) * 8 + wid] = dn; }
        }
        pw[0] = (u32x4){cvtpk(p0[0], p0[1]), cvtpk(p0[2], p0[3]), cvtpk(p0[4], p0[5]), cvtpk(p0[6], p0[7])};
        pw[1] = (u32x4){cvtpk(p0[8], p0[9]), cvtpk(p0[10], p0[11]), cvtpk(p0[12], p0[13]), cvtpk(p0[14], p0[15])};
        pw[2] = (u32x4){cvtpk(p1[0], p1[1]), cvtpk(p1[2], p1[3]), cvtpk(p1[4], p1[5]), cvtpk(p1[6], p1[7])};
        pw[3] = (u32x4){cvtpk(p1[8], p1[9]), cvtpk(p1[10], p1[11]), cvtpk(p1[12], p1[13]), cvtpk(p1[14], p1[15])};
        pvslot = ATT_VOFF(t, i);
        if (VAR != 4) { if (late) pend = true; else ATT_PV(pvslot); } else { asm volatile("" :: "v"(pw[0]), "v"(pw[1]), "v"(pw[2]), "v"(pw[3])); }
    }
    if (late && pend) ATT_PV(pvslot);
    bf16* Ow = Ob + (((rowbase + qw0 + r32) >> 4) * 128 + (vcol0 >> 3) + hi) * 128 + ((qw0 + r32) & 15) * 8;
#define ATT_OST(d, gg, w0, w1) do { const auto sx_ = __builtin_amdgcn_permlane32_swap((w0).x, (w1).x, false, false); const auto sy_ = __builtin_amdgcn_permlane32_swap((w0).y, (w1).y, false, false); \
        *(u32x4*)(Ow + (4 * (d) + 2 * (gg)) * 128) = (u32x4){sx_[0], sy_[0], sx_[1], sy_[1]}; } while (0)
    if (MODE == 0) {
        { const auto rr = __builtin_amdgcn_permlane32_swap(__float_as_uint(lrun), __float_as_uint(lrun), false, false); lrun = __uint_as_float(rr[0]) + __uint_as_float(rr[1]); }
        const float inv = 1.0f / lrun;
        LAS u32x2* stg = (LAS u32x2*)(lds + LDS_O1S + wid * 8192) + lane;
        if (cmap == 0) {
#pragma unroll
            for (int d = 0; d < NDQ; ++d)
#pragma unroll
                for (int g = 0; g < 4; ++g) { u32x2 w; w.x = cvtpk(o[d][4 * g] * inv, o[d][4 * g + 1] * inv); w.y = cvtpk(o[d][4 * g + 2] * inv, o[d][4 * g + 3] * inv); stg[(d * 4 + g) * 64] = w; }
        } else {
            float ss = 0.f;
#pragma unroll
            for (int d = 0; d < NDQ; ++d)
#pragma unroll
                for (int g = 0; g < 4; ++g) { const u32x2 w = stg[(d * 4 + g) * 64];
                    o[d][4 * g] = __uint_as_float(w.x << 16) - lam * (o[d][4 * g] * inv); o[d][4 * g + 1] = __uint_as_float(w.x & 0xffff0000u) - lam * (o[d][4 * g + 1] * inv);
                    o[d][4 * g + 2] = __uint_as_float(w.y << 16) - lam * (o[d][4 * g + 2] * inv); o[d][4 * g + 3] = __uint_as_float(w.y & 0xffff0000u) - lam * (o[d][4 * g + 3] * inv);
                    ss += (o[d][4 * g] * o[d][4 * g] + o[d][4 * g + 1] * o[d][4 * g + 1]) + (o[d][4 * g + 2] * o[d][4 * g + 2] + o[d][4 * g + 3] * o[d][4 * g + 3]); }
            { const auto rr = __builtin_amdgcn_permlane32_swap(__float_as_uint(ss), __float_as_uint(ss), false, false); ss = __uint_as_float(rr[0]) + __uint_as_float(rr[1]); }
            const float rs = (1.0f - LAM_INIT) / sqrtf(ss * (1.0f / 128.0f) + RMS_EPS);
#pragma unroll
            for (int d = 0; d < NDQ; ++d)
#pragma unroll
                for (int g2 = 0; g2 < 2; ++g2) { u32x2 w[2];
#pragma unroll
                    for (int gi = 0; gi < 2; ++gi) { const int g = 2 * g2 + gi; const f32x4 gg = *(const LAS f32x4*)((const LAS float*)(lds + LDS_GAIN) + 32 * d + 8 * g + 4 * hi);
                        w[gi].x = cvtpk(o[d][4 * g] * rs * gg[0], o[d][4 * g + 1] * rs * gg[1]); w[gi].y = cvtpk(o[d][4 * g + 2] * rs * gg[2], o[d][4 * g + 3] * rs * gg[3]); }
                    ATT_OST(d, g2, w[0], w[1]); }
        }
    } else {
#pragma unroll
        for (int d = 0; d < NDQ; ++d)
#pragma unroll
            for (int g2 = 0; g2 < 2; ++g2) { u32x2 w[2];
#pragma unroll
                for (int gi = 0; gi < 2; ++gi) { const int g = 2 * g2 + gi; w[gi].x = cvtpk(o[d][4 * g], o[d][4 * g + 1]); w[gi].y = cvtpk(o[d][4 * g + 2], o[d][4 * g + 3]); }
                ATT_OST(d, g2, w[0], w[1]); }
    }
#undef ATT_OST
#undef ATT_DMA
#undef ATT_KOFF
#undef ATT_VOFF
#undef ATT_PV
#undef ATT_VRD
#undef ATT_VMM
#undef ATT_BF
}
}
constexpr size_t MiB = 1u << 20;
constexpr size_t WS_CTL = 0, CTL_ZERO_BYTES = 1 * MiB;
constexpr size_t WS_TOK = 1 * MiB;
constexpr size_t TOK_E = WS_TOK, TOK_W = TOK_E + (size_t)T * 4, TOK_SLOT = TOK_W + (size_t)T * 8, BLKCNT = TOK_SLOT + (size_t)T * 8, EOFF = BLKCNT + (size_t)NCHUNK * 32 * 4, SLOT_TOK = EOFF + 256;
static_assert(SLOT_TOK + (size_t)SLOT_ROWS * 4 <= 2 * MiB, "router tables");
constexpr size_t WS_WQKV = 2 * MiB;
constexpr size_t WS_WO = 14 * MiB;
constexpr size_t WS_W13 = 18 * MiB;
constexpr size_t WS_W2 = 82 * MiB;
constexpr size_t WS_XB = 114 * MiB;
constexpr size_t WS_Q = 178 * MiB, WS_K = 242 * MiB, WS_V = 306 * MiB;
static_assert(WS_V - WS_K == WS_K - WS_Q, "Q | K | V at one stride");
constexpr size_t WS_O1 = 370 * MiB, WS_O2 = 434 * MiB;
constexpr size_t WS_XS = 178 * MiB;
constexpr size_t WS_H = 322 * MiB;
constexpr size_t WS_Y = 178 * MiB;
constexpr size_t WS_W13B = 434 * MiB, WS_W2B = 498 * MiB;
constexpr size_t WS_END = 538 * MiB;
static_assert(WS_Y + (size_t)SLOT_ROWS * 2048 <= WS_H && WS_H + (size_t)SLOT_ROWS * 1024 <= 434 * MiB && WS_W13B + 64 * MiB <= WS_W2B && WS_W2B + 32 * MiB <= WS_END && WS_O1 + 64 * MiB <= WS_W13B, "MoE overlay");
constexpr int CW_BAR = 4096;
constexpr int RING_BYTES = 131072;
constexpr int MISC_OFF = 147456;
constexpr int LDS_BYTES = MISC_OFF + 4096 + 256;
constexpr int MI_BAR = 0, MI_LAM = 12, MI_EOFF = 16, MI_CNT = 64, MI_TILE = 128, MI_LGT = 424, MI_PTR = 1000;
static_assert(MI_LGT >= MI_TILE + MAX_TILES && MI_PTR >= MI_LGT + 8 * 72 && (MI_PTR + 52) * 4 <= 4096 + 256 && MI_PTR % 2 == 0, "MISC map");
constexpr int NWAVES = 8;

#define XB_TMO      128
#define XB_XCNT(j)  (256  + 64 * (j))
#define XB_XSUB(j)  (1280 + 64 * (j))
#define XB_XGEN(j)  (2304 + 64 * (j))
#define XB_TOP      3328
#define XB_TOPGEN   3392
#define XCD_BAR_WORDS 3456
#define XB_SPIN_CAP (1u << 18)

__device__ __forceinline__ unsigned xb_ld(unsigned* p)              { return __hip_atomic_load(p, __ATOMIC_RELAXED, __HIP_MEMORY_SCOPE_AGENT); }
__device__ __forceinline__ unsigned xb_add(unsigned* p, unsigned v) { return __hip_atomic_fetch_add(p, v, __ATOMIC_RELAXED, __HIP_MEMORY_SCOPE_AGENT); }
__device__ __forceinline__ unsigned xb_xcc_id() { return (unsigned)__builtin_amdgcn_s_getreg((3 << 11) | 20) & 0xFu; }
#define XB_SPIN(cond, bar) do { unsigned _sp = 0; while (cond) { __builtin_amdgcn_s_sleep(1); \
    if ((++_sp & 255u) == 0u) { if (xb_ld(&(bar)[XB_TMO])) break; if (_sp > XB_SPIN_CAP) { atomicAdd(&(bar)[XB_TMO], 1u); break; } } } } while (0)

struct XcdBarrier {
    unsigned* bar; unsigned x;
    volatile LAS unsigned* st;
};

__device__ __forceinline__ XcdBarrier xcd_barrier_post(unsigned* bar, volatile LAS unsigned* st) {
    XcdBarrier b; b.bar = bar; b.x = xb_xcc_id(); b.st = st;
    if (threadIdx.x == 0) (void)xb_add(&bar[XB_XCNT(b.x)], 1u);
    return b;
}
__device__ __forceinline__ void xcd_barrier_complete(unsigned* bar, unsigned x, unsigned& nloc, unsigned& nx) {
    const unsigned G = gridDim.x * gridDim.y * gridDim.z;
    unsigned sum, cnt, mine, sp = 0u;
    for (;;) {
        sum = 0u; cnt = 0u; mine = 0u;
        unsigned cv[16];
        { const __attribute__((address_space(1))) unsigned* cb = (const __attribute__((address_space(1))) unsigned*)&bar[XB_XCNT(0)];
          asm volatile("global_load_dword %0, %16, off sc1\n\tglobal_load_dword %1, %16, off offset:256 sc1\n\tglobal_load_dword %2, %16, off offset:512 sc1\n\tglobal_load_dword %3, %16, off offset:768 sc1\n\t"
                       "global_load_dword %4, %16, off offset:1024 sc1\n\tglobal_load_dword %5, %16, off offset:1280 sc1\n\tglobal_load_dword %6, %16, off offset:1536 sc1\n\tglobal_load_dword %7, %16, off offset:1792 sc1\n\t"
                       "global_load_dword %8, %16, off offset:2048 sc1\n\tglobal_load_dword %9, %16, off offset:2304 sc1\n\tglobal_load_dword %10, %16, off offset:2560 sc1\n\tglobal_load_dword %11, %16, off offset:2816 sc1\n\t"
                       "global_load_dword %12, %16, off offset:3072 sc1\n\tglobal_load_dword %13, %16, off offset:3328 sc1\n\tglobal_load_dword %14, %16, off offset:3584 sc1\n\tglobal_load_dword %15, %16, off offset:3840 sc1\n\ts_waitcnt vmcnt(0)"
                       : "=&v"(cv[0]), "=&v"(cv[1]), "=&v"(cv[2]), "=&v"(cv[3]), "=&v"(cv[4]), "=&v"(cv[5]), "=&v"(cv[6]), "=&v"(cv[7]), "=&v"(cv[8]), "=&v"(cv[9]), "=&v"(cv[10]), "=&v"(cv[11]), "=&v"(cv[12]), "=&v"(cv[13]), "=&v"(cv[14]), "=&v"(cv[15])
                       : "v"(cb) : "memory"); }
#pragma unroll
        for (unsigned j = 0; j < 16; ++j) { const unsigned c = cv[j]; sum += c; cnt += (c > 0u) ? 1u : 0u; mine = (j == x) ? c : mine; }
        if (sum == G) break;
        __builtin_amdgcn_s_sleep(1);
        if ((++sp & 255u) == 0u) { if (xb_ld(&bar[XB_TMO])) break; if (sp > XB_SPIN_CAP) { atomicAdd(&bar[XB_TMO], 1u); break; } }
    }
    nloc = mine > 0u ? mine : 1u; nx = cnt > 0u ? cnt : 1u;
}

__device__ __forceinline__ void xcd_barrier(const XcdBarrier& b) {
    asm volatile("s_waitcnt vmcnt(0)" ::: "memory");
    __syncthreads();
    if (threadIdx.x == 0) {
        unsigned* bar = b.bar;
        __builtin_amdgcn_s_waitcnt(0);
        unsigned nloc = b.st[0], nx = b.st[1];
        if (nloc == 0u) { xcd_barrier_complete(bar, b.x, nloc, nx); b.st[0] = nloc; b.st[1] = nx; }
        const unsigned old = xb_add(&bar[XB_XSUB(b.x)], 1u);
        const unsigned gen = old / nloc;
        if (old + 1u == (gen + 1u) * nloc) {
            __builtin_amdgcn_fence(__ATOMIC_RELEASE, "agent");
            asm volatile("s_waitcnt vmcnt(0)" ::: "memory");
            const unsigned og = xb_add(&bar[XB_TOP], 1u);
            const unsigned tg = og / nx;
            if (og + 1u == (tg + 1u) * nx) xb_add(&bar[XB_TOPGEN], 1u);
            else XB_SPIN(xb_ld(&bar[XB_TOPGEN]) == tg, bar);
            __builtin_amdgcn_fence(__ATOMIC_ACQUIRE, "agent");
            xb_add(&bar[XB_XGEN(b.x)], 1u);
            asm volatile("s_waitcnt vmcnt(0)" ::: "memory");
        } else {
            XB_SPIN(xb_ld(&bar[XB_XGEN(b.x)]) == gen, bar);
            __builtin_amdgcn_fence(__ATOMIC_ACQUIRE, "agent");
            asm volatile("s_waitcnt vmcnt(0)" ::: "memory");
        }
    }
    __syncthreads();
}
#define RLX_AGENT __ATOMIC_RELAXED, __HIP_MEMORY_SCOPE_AGENT
#define LDS_WAIT() asm volatile("s_waitcnt lgkmcnt(0)" ::: "memory")
__device__ __forceinline__ unsigned f2bf(float f) { unsigned u = __builtin_bit_cast(unsigned, f); return (u + 0x7fffu + ((u >> 16) & 1u)) >> 16; }
__device__ __forceinline__ unsigned pk2(float lo, float hi) { return f2bf(lo) | (f2bf(hi) << 16); }
__device__ __forceinline__ float bflo(unsigned w) { return __uint_as_float(w << 16); }
__device__ __forceinline__ float bfhi(unsigned w) { return __uint_as_float(w & 0xffff0000u); }
template <int CTRL> __device__ __forceinline__ float dpp_f(float v) { return __builtin_bit_cast(float, __builtin_amdgcn_update_dpp(0, __builtin_bit_cast(int, v), CTRL, 0xf, 0xf, true)); }
__device__ __forceinline__ float row_sum16(float v) { v += dpp_f<0xB1>(v); v += dpp_f<0x4E>(v); v += dpp_f<0x141>(v); v += dpp_f<0x140>(v); return v; }
__device__ __forceinline__ float swap16_sum(float v) { const auto r = __builtin_amdgcn_permlane16_swap(__float_as_uint(v), __float_as_uint(v), false, false); return __uint_as_float(r[0]) + __uint_as_float(r[1]); }
__device__ __forceinline__ float swap32_sum(float v) { const auto r = __builtin_amdgcn_permlane32_swap(__float_as_uint(v), __float_as_uint(v), false, false); return __uint_as_float(r[0]) + __uint_as_float(r[1]); }
__device__ __forceinline__ float wave_sum(float v) { return swap32_sum(swap16_sum(row_sum16(v))); }
struct Frame {
    LAS unsigned char* lds; LAS int* MISC; unsigned char* ws;
    int tid, lane, wave, vcu, G, bx;
    float* out;
};
__device__ __forceinline__ Frame launder(const Frame& F0) {
    Frame F = F0;
    asm volatile("" : "+s"(F.ws), "+s"(F.out), "+s"(F.G), "+s"(F.vcu), "+s"(F.bx), "+v"(F.tid));
    F.lane = F.tid & 63; F.wave = __builtin_amdgcn_readfirstlane(F.tid >> 6);
    return F;
}
__device__ __forceinline__ const float* inp(const Frame& F, int k) {
    const unsigned long long v = ((const LAS unsigned long long*)(F.MISC + MI_PTR))[k];
    const unsigned lo = __builtin_amdgcn_readfirstlane((unsigned)v), hi = __builtin_amdgcn_readfirstlane((unsigned)(v >> 32));
    return (const float*)(((unsigned long long)hi << 32) | lo);
}

template <class RowMap>
__device__ __forceinline__ void transpose_item(const float* W, int K, int N, bf16* WT, const RowMap& rm, LAS float* scr, int item, int lane) {
    const int nblk = N / 32, kb = item / nblk, nb = item % nblk, k0 = 64 * kb, n0 = 32 * nb;
    float tv[32];
#pragma unroll
    for (int i = 0; i < 32; ++i) tv[i] = W[(size_t)(k0 + 2 * i + (lane >> 5)) * N + n0 + (lane & 31)];
#pragma unroll
    for (int i = 0; i < 32; ++i) scr[(2 * i + (lane >> 5)) * 33 + (lane & 31)] = tv[i];
    LDS_WAIT(); asm volatile("" ::: "memory");
    const int c = lane & 7;
#pragma unroll
    for (int j = 0; j < 4; ++j) { const int n = (lane >> 3) + 8 * j; const LAS float* s = scr + (8 * c) * 33 + n;
        u32x4 o; o.x = pk2(s[0 * 33], s[1 * 33]); o.y = pk2(s[2 * 33], s[3 * 33]); o.z = pk2(s[4 * 33], s[5 * 33]); o.w = pk2(s[6 * 33], s[7 * 33]);
        *(u32x4*)(WT + (size_t)rm(n0 + n) * K + k0 + 8 * c) = o; }
    LDS_WAIT(); asm volatile("" ::: "memory");
}
struct RowId { int off; __device__ __forceinline__ int operator()(int n) const { return off + n; } };
struct RowW13 { int type; __device__ __forceinline__ int operator()(int n) const { const int jh = n & 127; return 256 * (n >> 7) + 128 * ((jh >> 2) & 1) + 32 * (jh >> 5) + 8 * ((jh >> 3) & 3) + 4 * type + (jh & 3); } };

__device__ __forceinline__ void attn_weight_item(Frame& F, int it, LAS float* scr) {
    bf16* Wqkv = (bf16*)(F.ws + WS_WQKV); bf16* Wo = (bf16*)(F.ws + WS_WO);
    const int l = it >> 11, mtx = (it >> 9) & 3, r = it & 511;
    const int pk = (l == 0 ? 2 : 11) + mtx;
    const float* W = (const float*)((const LAS unsigned long long*)(F.MISC + MI_PTR))[pk];
    if (mtx < 3) transpose_item(W, 1024, 1024, Wqkv + (size_t)l * 3072 * 1024, RowId{mtx * 1024}, scr, r, F.lane);
    else transpose_item(W, 1024, 1024, Wo + (size_t)l * 1024 * 1024, RowId{0}, scr, r, F.lane);
}
__device__ __forceinline__ void phase_prologue(Frame& F) {
    LAS float* scr = (LAS float*)(F.lds + F.wave * 16384);
    const int gw = F.vcu * NWAVES + F.wave, NGW = F.G * NWAVES;
    bf16* Wqkv = (bf16*)(F.ws + WS_WQKV); bf16* Wo = (bf16*)(F.ws + WS_WO);
    for (int it = gw; it < 4 * 512; it += NGW) attn_weight_item(F, it, scr);
    const float* x = inp(F, 0); bf16* xb = (bf16*)(F.ws + WS_XB);
    { const size_t step = (size_t)F.G * 512 * 8;
      for (size_t i = (size_t)(F.bx * 512 + F.tid) * 8; i < (size_t)T * DM; i += 4 * step) {
        f32x4 a[4], b[4];
#pragma unroll
        for (int u = 0; u < 4; ++u) { a[u] = *(const f32x4*)(x + i + u * step); b[u] = *(const f32x4*)(x + i + u * step + 4); }
#pragma unroll
        for (int u = 0; u < 4; ++u) { u32x4 o; o.x = pk2(a[u][0], a[u][1]); o.y = pk2(a[u][2], a[u][3]); o.z = pk2(b[u][0], b[u][1]); o.w = pk2(b[u][2], b[u][3]); *(u32x4*)(xb + i + u * step) = o; } } }
    if (F.wave == 0) {
        const float s1 = wave_sum(inp(F, 6)[F.lane] * inp(F, 7)[F.lane]);
        const float s2 = wave_sum(inp(F, 8)[F.lane] * inp(F, 9)[F.lane]);
        if (F.lane == 0) F.MISC[MI_LAM] = __float_as_int(expf(s1) - expf(s2) + LAM_INIT); }
}
__device__ __forceinline__ void moe_weight_item(Frame& F, int layer, int it, LAS float* scr) {
    bf16* W13 = (bf16*)(F.ws + (layer == 0 ? WS_W13 : WS_W13B)); bf16* W2 = (bf16*)(F.ws + (layer == 0 ? WS_W2 : WS_W2B));
    const float* w1 = inp(F, 23) + (size_t)layer * NEXP * 1024 * 512; const float* w3 = inp(F, 24) + (size_t)layer * NEXP * 1024 * 512; const float* w2 = inp(F, 25) + (size_t)layer * NEXP * 512 * 1024;
    const int mtx = it >> 13, e = (it >> 8) & 31, r = it & 255;
    if (mtx == 0) transpose_item(w1 + (size_t)e * 1024 * 512, 1024, 512, W13 + (size_t)e * 1024 * 1024, RowW13{0}, scr, r, F.lane);
    else if (mtx == 1) transpose_item(w3 + (size_t)e * 1024 * 512, 1024, 512, W13 + (size_t)e * 1024 * 1024, RowW13{1}, scr, r, F.lane);
    else transpose_item(w2 + (size_t)e * 512 * 1024, 512, 1024, W2 + (size_t)e * 1024 * 512, RowId{0}, scr, r, F.lane);
}
constexpr int MW_ITEMS = 3 * NEXP * 256;
__device__ __forceinline__ void phase_moe_weights(Frame& F, int layer, int first = 0, int end = MW_ITEMS) {
    LAS float* scr = (LAS float*)(F.lds + F.wave * 16384);
    const int gw = F.vcu * NWAVES + F.wave, NGW = F.G * NWAVES;
    for (int it = first + gw; it < end; it += NGW) moe_weight_item(F, layer, it, scr);
}
constexpr int W2_FIRST = 2 * NEXP * 256, WIN1 = W2_FIRST - 3072, AW1_ITEMS = 4 * 512;
constexpr int WIN_ITEMS = MW_ITEMS + (W2_FIRST - WIN1) + AW1_ITEMS;
__device__ __forceinline__ void window_convert(Frame& F, int cw, int ncw) {
    LAS float* scr = (LAS float*)(F.lds + F.wave * 16384);
    for (int j = cw; j < WIN_ITEMS; j += ncw) { if (j < MW_ITEMS) moe_weight_item(F, 0, j, scr); else if (j < WIN_ITEMS - AW1_ITEMS) moe_weight_item(F, 1, j - MW_ITEMS + WIN1, scr); else attn_weight_item(F, 2048 + (j - (WIN_ITEMS - AW1_ITEMS)), scr); }
}
constexpr int UP_PER = 48, DN_PER = 24;
__device__ __forceinline__ int moe_idle_blocks(int ntiles, int G) { const int rem = (ntiles * 4) % G; return rem == 0 ? 0 : G - rem; }
__device__ __forceinline__ void moe_tail_items(Frame& F, int ntiles, int base, int per) {
    const int rem = (ntiles * 4) % F.G; if (rem == 0 || F.bx < rem) return;
    LAS float* scr = (LAS float*)(F.lds + F.wave * 16384);
    const int first = base + (F.bx - rem) * per;
    for (int it = first + F.wave; it < first + per && it < WIN1; it += NWAVES) moe_weight_item(F, 1, it, scr);
}
__device__ __forceinline__ void moe_tail_w2(Frame& F, int ntiles) {
    LAS float* scr = (LAS float*)(F.lds + F.wave * 16384);
    const int rem = (ntiles * 4) % F.G;
    if (rem == 0) { for (int it = W2_FIRST + F.bx * NWAVES + F.wave; it < MW_ITEMS; it += F.G * NWAVES) moe_weight_item(F, 1, it, scr); return; }
    if (F.bx < rem) return;
    const int idle = F.G - rem, per = (MW_ITEMS - W2_FIRST + idle - 1) / idle, first = W2_FIRST + (F.bx - rem) * per;
    for (int it = first + F.wave; it < first + per && it < MW_ITEMS; it += NWAVES) moe_weight_item(F, 1, it, scr);
}

template <int MODE, int VAR = 0, class PreFn>
__device__ __forceinline__ void phase_attention(Frame& F, PreFn pre) {
    const bf16* Q = (const bf16*)(F.ws + WS_Q); const bf16* K = (const bf16*)(F.ws + WS_K); const bf16* V = (const bf16*)(F.ws + WS_V);
    bf16* O1 = VAR ? (bf16*)F.out : (bf16*)(F.ws + WS_O1);
    const float* rel = inp(F, 1);
    if (MODE == 0) {
        const float lam = __int_as_float(F.MISC[MI_LAM]);
        const float* subg = inp(F, 10);
        if (F.tid < 256) ((LAS float*)(F.lds + att::LDS_REL))[F.tid] = rel[F.tid];
        if (F.tid < 128) ((LAS float*)(F.lds + att::LDS_GAIN))[F.tid] = subg[F.tid];
        pre();
        for (int P = F.vcu; P < 512; P += F.G) {
            const int bh = P >> 3, s = P & 7, b = bh >> 3, h = bh & 7;
#pragma unroll 1
            for (int k = 0; k < 4; ++k) {
                const int qb = k < 2 ? 15 - s : s, c = k & 1;
                att::attn_unit<0, VAR>(F.lds, Q, K, V, O1, b, 128 * h + 64 * c, 128 * h, qb, rel, h, c, lam, subg);
            }
        }
    } else {
        pre();
        for (int P = F.vcu; P < 1024; P += F.G) {
            const int bh = P >> 3, s = P & 7, b = bh >> 4, hh = bh & 15;
#pragma unroll 1
            for (int k = 0; k < 2; ++k) att::attn_unit<1, VAR>(F.lds, Q, K, V, O1, b, 64 * hh, 64 * hh, k == 0 ? 15 - s : s, rel, 0);
        }
    }
    asm volatile("s_waitcnt vmcnt(0) lgkmcnt(0)\n\ts_barrier" ::: "memory");
}
__device__ __forceinline__ void ln16(f32x4 (&v)[4], const f32x4 (&g)[4], const f32x4 (&bb)[4]) {
    float s = 0.f;
#pragma unroll
    for (int j = 0; j < 4; ++j) s += (v[j][0] + v[j][1]) + (v[j][2] + v[j][3]);
    const float mean = wave_sum(s) * (1.0f / DM); float s2 = 0.f;
#pragma unroll
    for (int j = 0; j < 4; ++j) { v[j] = v[j] - mean; s2 += (v[j][0] * v[j][0] + v[j][1] * v[j][1]) + (v[j][2] * v[j][2] + v[j][3] * v[j][3]); }
    const float rstd = 1.0f / sqrtf(wave_sum(s2) * (1.0f / DM) + LN_EPS);
#pragma unroll
    for (int j = 0; j < 4; ++j) v[j] = v[j] * rstd * g[j] + bb[j];
}
template <class PreFn>
__device__ __forceinline__ void phase_ln_router(Frame& F, int layer, PreFn pre) {
    constexpr int AROW = 2064, A_HI = 0, A_LO = 16 * AROW, RED = 2 * 16 * AROW, LGO = RED + 8 * 3 * 1024, RBIAS = LGO + 2304;
    const float* wg = inp(F, 19) + (size_t)layer * 1024 * 4; const float* we = inp(F, 21) + (size_t)layer * 1024 * 32;
    const int lane = F.lane, wave = F.wave, col = lane & 15, kq = lane >> 4;
    u32x4 bh[4][3], bl[4][3];
#pragma unroll
    for (int s = 0; s < 4; ++s)
#pragma unroll
        for (int blk = 0; blk < 3; ++blk) { const int o = 16 * blk + col; float w8[8];
#pragma unroll
            for (int j = 0; j < 8; ++j) { const int k = 128 * wave + 32 * s + 8 * kq + j; w8[j] = o < 4 ? wg[k * 4 + o] : (o < 36 ? we[k * 32 + o - 4] : 0.f); }
#pragma unroll
            for (int jp = 0; jp < 4; ++jp) { const unsigned wh = pk2(w8[2 * jp], w8[2 * jp + 1]); bh[s][blk][jp] = wh; bl[s][blk][jp] = pk2(w8[2 * jp] - bflo(wh), w8[2 * jp + 1] - bfhi(wh)); } }
    const float* bg = inp(F, 20) + layer * 4; const float* be = inp(F, 22) + layer * 32;
    const float* lg = inp(F, 15) + layer * 1024; const float* lb = inp(F, 16) + layer * 1024;
    LAS int* cnt = F.MISC + MI_CNT; const LAS float* lgv = (const LAS float*)(F.lds + LGO);
    int* tok_e = (int*)(F.ws + TOK_E); float* tok_w = (float*)(F.ws + TOK_W); int* blkcnt = (int*)(F.ws + BLKCNT);
    GAS bf16* xb = (GAS bf16*)(F.ws + WS_XB); const GAS bf16* tb = (const GAS bf16*)(F.ws + WS_Q);
    LAS float* rbL = (LAS float*)(F.lds + RBIAS);
    if (F.tid < 4) rbL[F.tid] = bg[F.tid]; else if (F.tid >= 32 && F.tid < 64) rbL[4 + F.tid - 32] = be[F.tid - 32];
    pre();
    for (int c = F.bx; c < NCHUNK; c += F.G) {
        if (F.tid < 32) cnt[F.tid] = 0;
        u32x2 ra[4], rb[4];
        { const GAS bf16* xr = tb + (size_t)(c * 128 + 2 * wave) * DM;
#pragma unroll
          for (int j = 0; j < 4; ++j) { ra[j] = *(const GAS u32x2*)(xr + 4 * lane + 256 * j); rb[j] = *(const GAS u32x2*)(xr + DM + 4 * lane + 256 * j); } }
        __syncthreads();
#pragma unroll 1
        for (int st = 0; st < 8; ++st) {
            const int tok = c * 128 + st * 16 + 2 * wave;
            f32x4 va[4], vb[4];
#pragma unroll
            for (int j = 0; j < 4; ++j) { va[j] = (f32x4){bflo(ra[j].x), bfhi(ra[j].x), bflo(ra[j].y), bfhi(ra[j].y)}; vb[j] = (f32x4){bflo(rb[j].x), bfhi(rb[j].x), bflo(rb[j].y), bfhi(rb[j].y)}; }
            { const GAS float* lgp = (const GAS float*)lg; const GAS float* lbp = (const GAS float*)lb; asm volatile("" : "+s"(lgp), "+s"(lbp));
              f32x4 gv[4], bv[4];
#pragma unroll
              for (int j = 0; j < 4; ++j) { gv[j] = *(const GAS f32x4*)(lgp + 4 * lane + 256 * j); bv[j] = *(const GAS f32x4*)(lbp + 4 * lane + 256 * j); }
              { const GAS bf16* xr = tb + (size_t)(st < 7 ? tok + 16 : tok) * DM;
#pragma unroll
                  for (int j = 0; j < 4; ++j) { ra[j] = *(const GAS u32x2*)(xr + 4 * lane + 256 * j); rb[j] = *(const GAS u32x2*)(xr + DM + 4 * lane + 256 * j); } }
              ln16(va, gv, bv); ln16(vb, gv, bv); }
#pragma unroll
            for (int j = 0; j < 4; ++j) {
                const unsigned ah0 = pk2(va[j][0], va[j][1]), ah1 = pk2(va[j][2], va[j][3]), bh0 = pk2(vb[j][0], vb[j][1]), bh1 = pk2(vb[j][2], vb[j][3]);
                *(GAS u32x2*)(xb + (size_t)tok * DM + 4 * lane + 256 * j) = (u32x2){ah0, ah1}; *(GAS u32x2*)(xb + (size_t)(tok + 1) * DM + 4 * lane + 256 * j) = (u32x2){bh0, bh1};
                const unsigned al0 = pk2(va[j][0] - bflo(ah0), va[j][1] - bfhi(ah0)), al1 = pk2(va[j][2] - bflo(ah1), va[j][3] - bfhi(ah1));
                const unsigned bl0 = pk2(vb[j][0] - bflo(bh0), vb[j][1] - bfhi(bh0)), bl1 = pk2(vb[j][2] - bflo(bh1), vb[j][3] - bfhi(bh1));
                const int ko = (4 * lane + 256 * j) * 2;
                *(LAS u32x2*)(F.lds + A_HI + (2 * wave) * AROW + ko) = (u32x2){ah0, ah1}; *(LAS u32x2*)(F.lds + A_LO + (2 * wave) * AROW + ko) = (u32x2){al0, al1};
                *(LAS u32x2*)(F.lds + A_HI + (2 * wave + 1) * AROW + ko) = (u32x2){bh0, bh1}; *(LAS u32x2*)(F.lds + A_LO + (2 * wave + 1) * AROW + ko) = (u32x2){bl0, bl1}; }
            __syncthreads();
            f32x4 acc[3];
#pragma unroll
            for (int blk = 0; blk < 3; ++blk) acc[blk] = (f32x4){0.f, 0.f, 0.f, 0.f};
#pragma unroll
            for (int s = 0; s < 4; ++s) { const int kb = (128 * wave + 32 * s + 8 * kq) * 2;
                const bf16x8 ah = *(const LAS bf16x8*)(F.lds + A_HI + col * AROW + kb), al = *(const LAS bf16x8*)(F.lds + A_LO + col * AROW + kb);
#pragma unroll
                for (int blk = 0; blk < 3; ++blk) {
                    acc[blk] = __builtin_amdgcn_mfma_f32_16x16x32_bf16(ah, __builtin_bit_cast(bf16x8, bh[s][blk]), acc[blk], 0, 0, 0);
                    acc[blk] = __builtin_amdgcn_mfma_f32_16x16x32_bf16(al, __builtin_bit_cast(bf16x8, bh[s][blk]), acc[blk], 0, 0, 0);
                    acc[blk] = __builtin_amdgcn_mfma_f32_16x16x32_bf16(ah, __builtin_bit_cast(bf16x8, bl[s][blk]), acc[blk], 0, 0, 0); } }
#pragma unroll
            for (int blk = 0; blk < 3; ++blk) *(LAS f32x4*)(F.lds + RED + ((wave * 3 + blk) * 64 + lane) * 16) = acc[blk];
            __syncthreads();
            { const int t = F.tid >> 5, oo = F.tid & 31;
              float s0 = 0.f, s1 = 0.f;
#pragma unroll
              for (int w = 0; w < 8; ++w) { s0 += *(const LAS float*)(F.lds + RED + ((w * 3 + (oo >> 4)) * 64 + (t >> 2) * 16 + (oo & 15)) * 16 + (t & 3) * 4);
                  if (oo < 4) s1 += *(const LAS float*)(F.lds + RED + ((w * 3 + 2) * 64 + (t >> 2) * 16 + oo) * 16 + (t & 3) * 4); }
              ((LAS float*)(F.lds + LGO))[t * 36 + oo] = s0; if (oo < 4) ((LAS float*)(F.lds + LGO))[t * 36 + 32 + oo] = s1; }
            __syncthreads();
            if (lane < 2) {
                const LAS float* L = lgv + 36 * (2 * wave + lane); const int mytok = tok + lane;
                float gl[4];
#pragma unroll
                for (int j = 0; j < 4; ++j) gl[j] = L[j] + rbL[j];
                int gi = 0; float gm = gl[0];
#pragma unroll
                for (int j = 1; j < 4; ++j) if (gl[j] > gm) { gm = gl[j]; gi = j; }
                float gs = 0.f;
#pragma unroll
                for (int j = 0; j < 4; ++j) gs += expf(gl[j] - gm);
                const float ggate = 1.0f / gs;
                float el[8];
#pragma unroll
                for (int j = 0; j < 8; ++j) el[j] = L[4 + 8 * gi + j] + rbL[4 + 8 * gi + j];
                int i1 = 0; float m1 = el[0];
#pragma unroll
                for (int j = 1; j < 8; ++j) if (el[j] > m1) { m1 = el[j]; i1 = j; }
                int i2 = -1; float m2 = -INFINITY;
#pragma unroll
                for (int j = 0; j < 8; ++j) if (j != i1 && el[j] > m2) { m2 = el[j]; i2 = j; }
                const float ex = expf(m2 - m1); const float wa = ggate / (1.0f + ex), wb = ggate * ex / (1.0f + ex);
                const int ea = gi * 8 + i1, eb = gi * 8 + i2;
                tok_e[mytok] = ea | (eb << 8); tok_w[2 * mytok] = wa; tok_w[2 * mytok + 1] = wb;
                __hip_atomic_fetch_add(cnt + ea, 1, __ATOMIC_RELAXED, __HIP_MEMORY_SCOPE_WORKGROUP); __hip_atomic_fetch_add(cnt + eb, 1, __ATOMIC_RELAXED, __HIP_MEMORY_SCOPE_WORKGROUP);
            }
        }
        __syncthreads();
        if (F.tid < 32) blkcnt[c * 32 + F.tid] = cnt[F.tid];
        __syncthreads();
    }
}
__device__ __forceinline__ void phase_slots(Frame& F) {
    LAS int* tab = (LAS int*)F.lds;
    const int* blkcnt = (const int*)(F.ws + BLKCNT);
    const int* tok_e = (const int*)(F.ws + TOK_E);
    const int te0 = (F.tid < 256 && F.bx < NCHUNK) ? tok_e[F.bx * 128 + (F.tid >> 1)] : 0;
    { int tv[16];
#pragma unroll
      for (int i = 0; i < 16; ++i) tv[i] = __hip_atomic_load(blkcnt + F.tid + 512 * i, RLX_AGENT);
#pragma unroll
      for (int i = 0; i < 16; ++i) tab[F.tid + 512 * i] = tv[i]; }
    __syncthreads();
    LAS int* eoff = F.MISC + MI_EOFF; LAS int* cur = F.MISC + MI_CNT;
    {
        const int e = F.tid & 31, g = F.tid >> 5; LAS int* gsum = F.MISC + MI_LGT;
        int v[16], acc = 0;
#pragma unroll
        for (int i = 0; i < 16; ++i) v[i] = tab[(16 * g + i) * 32 + e];
#pragma unroll
        for (int i = 0; i < 16; ++i) { const int t = v[i]; v[i] = acc; acc += t; }
        gsum[g * 32 + e] = acc;
        __syncthreads();
        int goff = 0;
#pragma unroll
        for (int gg = 0; gg < 16; ++gg) { const int t = gsum[gg * 32 + e]; goff += gg < g ? t : 0; }
#pragma unroll
        for (int i = 0; i < 16; ++i) tab[(16 * g + i) * 32 + e] = v[i] + goff;
        if (g == 15) cur[e] = goff + acc;
    }
    __syncthreads();
    if (F.tid < 33) {
        typedef int i32x4_ __attribute__((ext_vector_type(4))); i32x4_ cv[8];
#pragma unroll
        for (int q = 0; q < 8; ++q) cv[q] = ((const LAS i32x4_*)cur)[q];
        __builtin_amdgcn_sched_barrier(0);
        int o = 0;
#pragma unroll
        for (int q = 0; q < 8; ++q)
#pragma unroll
            for (int c4 = 0; c4 < 4; ++c4) o += (4 * q + c4 < F.tid) ? ((cv[q][c4] + 255) & ~255) : 0;
        eoff[F.tid] = o; }
    __syncthreads();
    { LAS int* tile_e = F.MISC + MI_TILE; int ntl = eoff[32] >> 8; ntl = ntl > MAX_TILES ? MAX_TILES : ntl;
      if (F.tid < ntl) { typedef int i32x4_ __attribute__((ext_vector_type(4))); i32x4_ ev[8];
#pragma unroll
          for (int q = 0; q < 8; ++q) ev[q] = ((const LAS i32x4_*)eoff)[q];
          __builtin_amdgcn_sched_barrier(0);
          int e = 0;
#pragma unroll
          for (int q = 0; q < 8; ++q)
#pragma unroll
              for (int c4 = 0; c4 < 4; ++c4) if (4 * q + c4 >= 1 && ev[q][c4] <= 256 * F.tid) e = 4 * q + c4;
          tile_e[F.tid] = e; } }
    int* slot_tok = (int*)(F.ws + SLOT_TOK);
    for (int e = F.bx; e < 32; e += F.G) for (int s = eoff[e] + cur[e] + F.tid; s < eoff[e + 1]; s += 512) slot_tok[s] = 0;
    int* tok_slot = (int*)(F.ws + TOK_SLOT);
    for (int c = F.bx; c < NCHUNK; c += F.G) {
        const int te = (c == F.bx) ? te0 : ((F.tid < 256) ? tok_e[c * 128 + (F.tid >> 1)] : 0);
        __syncthreads();
        if (F.tid < 32) cur[F.tid] = 0;
        __syncthreads();
        if (F.tid < 256) { const int tok = c * 128 + (F.tid >> 1), k = F.tid & 1; const int e = (te >> (8 * k)) & 255;
            const int pos = eoff[e] + tab[c * 32 + e] + __hip_atomic_fetch_add(cur + e, 1, __ATOMIC_RELAXED, __HIP_MEMORY_SCOPE_WORKGROUP);
            tok_slot[2 * tok + k] = pos; slot_tok[pos] = tok; }
    }
}
__device__ __forceinline__ int load_tiles(Frame& F) {
    LAS int* eoff = F.MISC + MI_EOFF;
    __syncthreads();
    int nt = eoff[32] >> 8; nt = nt > MAX_TILES ? MAX_TILES : nt;
    return __builtin_amdgcn_readfirstlane(nt);
}
template <class PreFn>
__device__ __forceinline__ void phase_moe_combine(Frame& F, int layer, PreFn pre) {
    const float* lg = inp(F, 17) + layer * 1024; const float* lb = inp(F, 18) + layer * 1024;
    f32x4 gv[4], bv[4];
#pragma unroll
    for (int j = 0; j < 4; ++j) { gv[j] = *(const f32x4*)(lg + 4 * F.lane + 256 * j); bv[j] = *(const f32x4*)(lb + 4 * F.lane + 256 * j); }
    pre();
    const float* tok_w = (const float*)(F.ws + TOK_W); const int* tok_slot = (const int*)(F.ws + TOK_SLOT);
    const bf16* Y = (const bf16*)(F.ws + WS_Y); bf16* xb = (bf16*)(F.ws + WS_XB);
    const int gw = F.vcu * NWAVES + F.wave, NGW = F.G * NWAVES;
    int slv = 0; float wvv = 0.f;
    if (2 * gw < T) { slv = __hip_atomic_load(tok_slot + 2 * (2 * gw) + (F.lane & 3), RLX_AGENT); wvv = __hip_atomic_load(tok_w + 2 * (2 * gw) + (F.lane & 3), RLX_AGENT); }
    for (int tok = 2 * gw; tok < T; tok += 2 * NGW) {
        const int ntok = tok + 2 * NGW < T ? tok + 2 * NGW : tok;
        const int nslv = __hip_atomic_load(tok_slot + 2 * ntok + (F.lane & 3), RLX_AGENT); const float nwvv = __hip_atomic_load(tok_w + 2 * ntok + (F.lane & 3), RLX_AGENT);
        const int sa0 = __builtin_amdgcn_readlane(slv, 0), sa1 = __builtin_amdgcn_readlane(slv, 1), sb0 = __builtin_amdgcn_readlane(slv, 2), sb1 = __builtin_amdgcn_readlane(slv, 3);
        float wv[4];
#pragma unroll
        for (int i = 0; i < 4; ++i) wv[i] = __uint_as_float(__builtin_amdgcn_readlane(__float_as_uint(wvv), i));
        bf16* xbr = xb + (size_t)tok * DM;
        f32x4 va[4], vb[4]; u32x2 xa[4], xc[4], ya0[4], ya1[4], yb0[4], yb1[4];
#pragma unroll
        for (int j = 0; j < 4; ++j) { const int o = 4 * F.lane + 256 * j;
            xa[j] = *(const u32x2*)(xbr + o); xc[j] = *(const u32x2*)(xbr + DM + o);
            ya0[j] = *(const u32x2*)(Y + (size_t)sa0 * DM + o); ya1[j] = *(const u32x2*)(Y + (size_t)sa1 * DM + o);
            yb0[j] = *(const u32x2*)(Y + (size_t)sb0 * DM + o); yb1[j] = *(const u32x2*)(Y + (size_t)sb1 * DM + o); }
#pragma unroll
        for (int j = 0; j < 4; ++j) {
            va[j][0] = ALPHA * bflo(xa[j].x) + (wv[0] * bflo(ya0[j].x) + wv[1] * bflo(ya1[j].x)); va[j][1] = ALPHA * bfhi(xa[j].x) + (wv[0] * bfhi(ya0[j].x) + wv[1] * bfhi(ya1[j].x));
            va[j][2] = ALPHA * bflo(xa[j].y) + (wv[0] * bflo(ya0[j].y) + wv[1] * bflo(ya1[j].y)); va[j][3] = ALPHA * bfhi(xa[j].y) + (wv[0] * bfhi(ya0[j].y) + wv[1] * bfhi(ya1[j].y));
            vb[j][0] = ALPHA * bflo(xc[j].x) + (wv[2] * bflo(yb0[j].x) + wv[3] * bflo(yb1[j].x)); vb[j][1] = ALPHA * bfhi(xc[j].x) + (wv[2] * bfhi(yb0[j].x) + wv[3] * bfhi(yb1[j].x));
            vb[j][2] = ALPHA * bflo(xc[j].y) + (wv[2] * bflo(yb0[j].y) + wv[3] * bflo(yb1[j].y)); vb[j][3] = ALPHA * bfhi(xc[j].y) + (wv[2] * bfhi(yb0[j].y) + wv[3] * bfhi(yb1[j].y)); }
        ln16(va, gv, bv); ln16(vb, gv, bv);
#pragma unroll
        for (int j = 0; j < 4; ++j) { const int o = 4 * F.lane + 256 * j;
            if (layer == 0) { u32x2 w; w.x = pk2(va[j][0], va[j][1]); w.y = pk2(va[j][2], va[j][3]); *(u32x2*)(xbr + o) = w;
                w.x = pk2(vb[j][0], vb[j][1]); w.y = pk2(vb[j][2], vb[j][3]); *(u32x2*)(xbr + DM + o) = w; }
            else { float* xr = F.out + (size_t)tok * DM; *(f32x4*)(xr + o) = va[j]; *(f32x4*)(xr + DM + o) = vb[j]; } }
        slv = nslv; wvv = nwvv;
    }
}
constexpr int NPH = 19;
#ifndef PROBE_QKV
#define PROBE_QKV 0
#endif
#ifndef NCVG
#define NCVG 8
#endif
#ifndef REP_QKV
#define REP_QKV 1
#endif
#ifndef PROBE_DA
#define PROBE_DA 0
#endif
#ifndef REP_SB
#define REP_SB 1
#endif
#ifndef REP_UP
#define REP_UP 1
#endif
#ifndef REP_DOWN
#define REP_DOWN 1
#endif
#ifndef REP_PRO
#define REP_PRO 1
#endif
#ifndef REP_WO
#define REP_WO 1
#endif
#ifndef REP_LNR
#define REP_LNR 1
#endif
#ifndef REP_SLOTS
#define REP_SLOTS 1
#endif
#ifndef REP_COMB1
#define REP_COMB1 1
#endif
#ifndef REP_MW1
#define REP_MW1 1
#endif
#ifndef MK_SPLIT
#define MK_SPLIT 0
#endif
struct Args { const float* in[26]; float* out; unsigned char* ws; int ph_lo, ph_hi, li, pad; };
__global__ void __launch_bounds__(NWAVES * 64, 2) fwd(Args args) {
    extern __shared__ __attribute__((aligned(16))) unsigned char lds_raw[];
    Frame F;
    F.lds = (LAS unsigned char*)lds_raw; F.MISC = (LAS int*)(F.lds + MISC_OFF); F.ws = args.ws; F.out = args.out;
    F.tid = threadIdx.x; F.lane = F.tid & 63; F.wave = __builtin_amdgcn_readfirstlane(F.tid >> 6);
    F.G = gridDim.x; F.bx = blockIdx.x; F.vcu = (F.G % 8 == 0) ? (F.bx % 8) * (F.G / 8) + F.bx / 8 : F.bx;
    if (F.tid < 64) F.MISC[F.tid] = 0;
    if (F.tid == 0) {
#pragma unroll
        for (int i = 0; i < 26; ++i) ((LAS unsigned long long*)(F.MISC + MI_PTR))[i] = (unsigned long long)args.in[i];
    }
    __syncthreads();
    XcdBarrier bar = xcd_barrier_post((unsigned*)(F.ws + WS_CTL) + CW_BAR + args.li * XCD_BAR_WORDS, (volatile LAS unsigned*)(F.MISC + MI_BAR));
    const int lo = args.ph_lo, hi = args.ph_hi;
#define IN(k) (lo <= (k) && (k) < hi)
#ifndef SKEW_SLEEP
#define SKEW_SLEEP 0
#endif
#define PHASE_SKEW(P) do { if (SKEW_SLEEP) { const int g_ = ((P).bx >> 3) & 7; for (int i_ = 0; i_ < g_; ++i_) __builtin_amdgcn_s_sleep(SKEW_SLEEP); } } while (0)
#define SEAM(k) do { if ((k) + 1 < hi) { XcdBarrier b_ = bar; asm volatile("" : "+s"(b_.bar), "+s"(b_.x)); xcd_barrier(b_); } } while (0)
    if (IN(0)) { Frame P = launder(F); for (int rep = 0; rep < REP_PRO; ++rep) { phase_prologue(P); } SEAM(0); }
#pragma unroll 1
    for (int l = 0; l < 2; ++l) {
        const int pb = 1 + 9 * l;
        if (IN(pb + 0)) { Frame P = launder(F);
            pg8::Gemm g{(const bf16*)(P.ws + WS_XB), (const bf16*)(P.ws + WS_WQKV) + (size_t)l * 3072 * 1024, T, 3072, 1024, nullptr}; pg8::StaticOrder S;
            bool conv = false; { int G2 = P.G, c2 = P.bx;
              if (l == 0) { const int ng = P.G >> 3, ncvg = ((P.G & 7) == 0 && ng >= 2 * NCVG) ? NCVG : 0;
                if (ncvg == 0) window_convert(P, P.bx * NWAVES + P.wave, P.G * NWAVES);
                else { const int grp = P.bx >> 3, ncb = grp * ncvg / ng; conv = ((grp + 1) * ncvg / ng) != ncb; G2 = P.G - 8 * ncvg; c2 = (grp - ncb) * 8 + (P.bx & 7);
                       if (conv) window_convert(P, (ncb * 8 + (P.bx & 7)) * NWAVES + P.wave, 8 * ncvg * NWAVES); } }
              S.init(T, 3072, G2, c2); }
            pg8::EpiQKV E{(bf16*)(P.ws + WS_Q), (size_t)(WS_K - WS_Q) / 2, C2};
            if (PROBE_QKV) { pg8::EpiQKV_<PROBE_QKV> E2{(bf16*)(P.ws + WS_Q), (size_t)(WS_K - WS_Q) / 2, C2}; if (PROBE_QKV != 4 || (P.bx & 1) == 0) pg8::gemm_phase<pg8::EpiQKV_<PROBE_QKV>, pg8::StaticOrder, true, true>(P.lds, g, S, E2); }
            PHASE_SKEW(P);
            if (!conv) for (int rep = 0; rep < REP_QKV; ++rep) pg8::gemm_phase<pg8::EpiQKV, pg8::StaticOrder, true, true, false, false, true>(P.lds, g, S, E);
            if (!IN(pb + 1)) SEAM(pb + 0);
        }
        if (IN(pb + 1)) { Frame P = launder(F);
            const bool seam0 = IN(pb + 0); auto pre0 = [&]() { if (seam0) SEAM(pb + 0); };
            if (l == 0) phase_attention<0, 0>(P, pre0); else phase_attention<1, 0>(P, pre0);
            SEAM(pb + 1);
        }
        if (IN(pb + 3)) { Frame P = launder(F);
            pg8::Gemm g{(const bf16*)(P.ws + WS_O1), (const bf16*)(P.ws + WS_WO) + (size_t)l * 1024 * 1024, T, 1024, 1024, nullptr}; pg8::StaticOrder S; S.init(T, 1024, P.G, P.bx);
            pg8::EpiRes E{(const bf16*)(P.ws + WS_XB), (bf16*)(P.ws + WS_Q), ALPHA};
            PHASE_SKEW(P);
            for (int rep = 0; rep < REP_WO; ++rep) pg8::gemm_phase<pg8::EpiRes, pg8::StaticOrder, true, true, false, true, true>(P.lds, g, S, E);
            if (!IN(pb + 4)) SEAM(pb + 3);
        }
        if (IN(pb + 4)) { Frame P = launder(F); const bool seam3 = IN(pb + 3); phase_ln_router(P, l, [&]() { if (seam3) SEAM(pb + 3); }); SEAM(pb + 4); }
        if (IN(pb + 5)) { Frame P = launder(F); for (int rep = 0; rep < REP_SLOTS; ++rep) phase_slots(P); SEAM(pb + 5); }
        if (IN(pb + 6)) { Frame P = launder(F);
            const int nt = load_tiles(P);
            pg8::Gemm g{(const bf16*)(P.ws + WS_XB), (const bf16*)(P.ws + (l == 0 ? WS_W13 : WS_W13B)), SLOT_ROWS, 1024, 1024, (const int*)(P.ws + SLOT_TOK)};     pg8::GroupedOrder S{P.MISC + MI_TILE, nt, P.G, P.bx};
            pg8::EpiSwiGLU E{(bf16*)(P.ws + WS_H)};
            PHASE_SKEW(P);
            for (int rep = 0; rep < REP_UP; ++rep) pg8::gemm_phase<pg8::EpiSwiGLU, pg8::GroupedOrder, true, true, true>(P.lds, g, S, E);
            if (l == 0) moe_tail_items(P, nt, 0, UP_PER); else moe_tail_w2(P, nt);
            SEAM(pb + 6);
        }
        if (IN(pb + 7)) { Frame P = launder(F);
            const int nt = load_tiles(P);
            pg8::Gemm g{(const bf16*)(P.ws + WS_H), (const bf16*)(P.ws + (l == 0 ? WS_W2 : WS_W2B)), SLOT_ROWS, 1024, 512, nullptr}; pg8::GroupedOrder S{P.MISC + MI_TILE, nt, P.G, P.bx};
            pg8::EpiY E{(bf16*)(P.ws + WS_Y)};
            PHASE_SKEW(P);
            for (int rep = 0; rep < REP_DOWN; ++rep) pg8::gemm_phase<pg8::EpiY, pg8::GroupedOrder, true, true, false, true, true>(P.lds, g, S, E);
            if (l == 0) moe_tail_items(P, nt, moe_idle_blocks(nt, P.G) * UP_PER, DN_PER);
            if (!IN(pb + 8)) SEAM(pb + 7);
        }
        if (IN(pb + 8)) { Frame P = launder(F); const bool seam7 = IN(pb + 7); phase_moe_combine(P, l, [&]() { if (seam7) SEAM(pb + 7); }); if (l == 0) { const int nt = load_tiles(P); for (int rep = 0; rep < REP_MW1; ++rep) phase_moe_weights(P, 1, moe_idle_blocks(nt, P.G) * (UP_PER + DN_PER), WIN1); } SEAM(pb + 8); }
    }
#undef IN
#undef SEAM
}

extern "C" void kernel_launch(void* const* d_in, const int* in_sizes, int n_in, void* d_out, int out_size, void* d_ws, size_t ws_size, hipStream_t stream) {
    static int grid = 0;
    if (grid == 0) {
        if (n_in != 26 || in_sizes[0] != T * DM || out_size != T * DM || ws_size < WS_END) { fprintf(stderr, "kernel_launch: unexpected shapes / workspace (n_in %d, ws %zu); nothing launched\n", n_in, ws_size); grid = -1; return; }
        int dev = 0, cus = 0, per_cu = 0;
        if (hipGetDevice(&dev) != hipSuccess || hipDeviceGetAttribute(&cus, hipDeviceAttributeMultiprocessorCount, dev) != hipSuccess) { grid = -1; return; }
        if (hipFuncSetAttribute((const void*)fwd, hipFuncAttributeMaxDynamicSharedMemorySize, LDS_BYTES) != hipSuccess) { fprintf(stderr, "kernel_launch: hipFuncSetAttribute failed\n"); grid = -1; return; }
        if (hipOccupancyMaxActiveBlocksPerMultiprocessor(&per_cu, (const void*)fwd, NWAVES * 64, LDS_BYTES) != hipSuccess || per_cu < 1) { fprintf(stderr, "kernel_launch: occupancy query says %d\n", per_cu); }
        (void)hipGetLastError();
        grid = cus;
    }
    if (grid < 0) return;
    if (hipMemsetAsync((char*)d_ws + WS_CTL + (size_t)CW_BAR * 4, 0, (size_t)(MK_SPLIT ? NPH : 1) * XCD_BAR_WORDS * 4, stream) != hipSuccess) return;
    Args a{};
    for (int i = 0; i < 26; ++i) a.in[i] = (const float*)d_in[i];
    a.out = (float*)d_out; a.ws = (unsigned char*)d_ws; a.pad = 0;
#if MK_SPLIT
    int li = 0;
    for (int p = 0; p < NPH; ++p) { if (p == 1 + 9 + 2) continue; a.ph_lo = p; a.ph_hi = p + 1; a.li = li++; hipLaunchKernelGGL(fwd, dim3(grid), dim3(NWAVES * 64), LDS_BYTES, stream, a); }
#else
    a.ph_lo = 0; a.ph_hi = NPH; a.li = 0;
    hipLaunchKernelGGL(fwd, dim3(grid), dim3(NWAVES * 64), LDS_BYTES, stream, a);
#endif
}
```

```cpp
#include <hip/hip_runtime.h>
#include <cstdio>
#include <cstdint>
namespace pg8 {
#define PG8_LAS __attribute__((address_space(3)))
typedef unsigned short bf16_t;
typedef short bf16x8 __attribute__((ext_vector_type(8)));
typedef float f32x4 __attribute__((ext_vector_type(4)));
typedef unsigned u32x4 __attribute__((ext_vector_type(4)));
constexpr int BM = 256, BK = 64, HALF = 128, HTB = HALF * BK * 2  , STAGE_BYTES = 8 * HTB, NXCD = 8, WGM = 8;

__host__ __device__ __forceinline__ int lds_byte(int r, int c) { const int st = (r >> 4) * 2 + (c >> 5), rr = r & 15, cc = c & 31, ob = rr * 64 + cc * 2; return st * 1024 + (ob ^ (((ob >> 9) & 1) << 5)); }
__host__ __device__ __forceinline__ void stage_rc(int b, int& R, int& C) { const int st = b / 1024, sb = b % 1024, swz = sb ^ (((sb >> 9) & 1) << 5); R = (st >> 1) * 16 + swz / 64; C = (st & 1) * 32 + (swz % 64) / 2; }
__host__ __device__ __forceinline__ int perm32(int rho) { const int n = rho >> 4, i = rho & 15; return 8 * (i >> 2) + 4 * n + (i & 3); }

struct Unit { int pm, pn; };
struct Gemm { const bf16_t* A; const bf16_t* Bt; int M, N, K; const int* rowidx; };

struct StaticOrder {
    int nM, nN, nwg, G, c;
    __host__ __device__ void init(int M, int N, int G_, int c_) { nM = M / BM; nN = N / BM; nwg = nM * nN; G = G_; c = c_; }
    __host__ __device__ bool next(int i, Unit& u) const {
        const long L = (long)i * G + c; if (L >= nwg) return false;
        int wgid = (int)L; { const int q = nwg / NXCD, r = nwg % NXCD, xcd = wgid % NXCD, off = wgid / NXCD; wgid = (xcd < r ? xcd * (q + 1) : r * (q + 1) + (xcd - r) * q) + off; }
        const int nig = WGM * nN, gid = wgid / nig, fm = gid * WGM, gsz = (nM - fm) < WGM ? (nM - fm) : WGM;
        u.pm = fm + ((wgid % nig) % gsz); u.pn = (wgid % nig) / gsz; return true;
    }
    __device__ __forceinline__ void a_ready(const Unit&) const {}
    __device__ __forceinline__ void done(const Unit&) const {}
};

__device__ __forceinline__ unsigned cvt_pk_bf16(float lo, float hi) { unsigned r; asm volatile("v_cvt_pk_bf16_f32 %0, %1, %2" : "=v"(r) : "v"(lo), "v"(hi)); return r; }
typedef float f32x2 __attribute__((ext_vector_type(2)));
typedef unsigned u32x2 __attribute__((ext_vector_type(2)));
__device__ __forceinline__ void st16_wt(void* p, u32x4 v) { asm volatile("global_store_dwordx4 %0, %1, off sc1\n\ts_nop 1" :: "v"(p), "v"(v) : "memory"); }
template <int PROBE = 0> struct EpiQKV_ {
    static constexpr bool PERM = true, AFTER_DRAIN = false, COLMAP2 = false; static constexpr int VMOPS = 16;
    bf16_t* Q; size_t kv_stride; float scale0;
    __device__ __forceinline__ void operator()(const f32x4 (&acc)[2][2][4][2], const Unit& u, int wr, int wc, int fr, int fq) const {
        if (PROBE == 2) { asm volatile("" :: "v"(acc[0][0][0][0]), "v"(acc[1][1][3][1])); return; }
        const int t = u.pn >> 2; const float sc = t == 0 ? scale0 : 1.f;
        const int Rw0 = u.pm * BM + wr * 64, cw0 = (u.pn & 3) * BM + wc * 32;
        const int lane_off = t == 0 ? fr * 8 + fq * 128 : t == 1 ? fr * 8 + fq * 512 : fr * 32 + 8 * fq;
        bf16_t* base = Q + (size_t)t * kv_stride + lane_off;
#pragma unroll
        for (int ai = 0; ai < 2; ++ai)
#pragma unroll
            for (int m = 0; m < 4; ++m) { const int Rw = Rw0 + ai * HALF + m * 16, bb = Rw >> 12, s = Rw & 4095;
                const size_t ro = t == 0 ? (size_t)bb * 4194304 + (size_t)((s >> 4) * 1024) : t == 1 ? (size_t)bb * 4194304 + (size_t)((s >> 6) * 4096 + (s & 63) * 8) : (size_t)bb * 4194304 + (size_t)((s >> 6) * 2048 + ((s >> 4) & 3) * 512);
#pragma unroll
                for (int bj = 0; bj < 2; ++bj) { const f32x4 v0 = acc[ai][bj][m][0] * sc, v1 = acc[ai][bj][m][1] * sc; const int cw = cw0 + bj * HALF;
                    const size_t co = t == 0 ? (size_t)((cw >> 6) * 262144 + ((cw >> 5) & 1) * 512) : t == 1 ? (size_t)((cw >> 6) * 262144 + ((cw >> 5) & 1) * 2048) : (size_t)((cw >> 5) * 131072);
                    u32x4 w; w.x = cvt_pk_bf16(v0[0], v0[1]); w.y = cvt_pk_bf16(v0[2], v0[3]); w.z = cvt_pk_bf16(v1[0], v1[1]); w.w = cvt_pk_bf16(v1[2], v1[3]);
                    if (PROBE == 0 || PROBE == 4) *(u32x4*)(base + ro + co) = w; else if (PROBE == 3) *(u32x4*)(Q + ((size_t)(blockIdx.x * 512 + threadIdx.x) * 8)) = w; else asm volatile("" :: "v"(w)); } }
    }
};
typedef EpiQKV_<0> EpiQKV;
struct EpiRes {
    static constexpr bool PERM = true, AFTER_DRAIN = false, COLMAP2 = false; static constexpr int VMOPS = 16;
    const bf16_t* __restrict__ xprev; bf16_t* __restrict__ out; float alpha;
    __device__ __forceinline__ void operator()(const f32x4 (&acc)[2][2][4][2], const Unit& u, int wr, int wc, int fr, int fq) const {
        const int row0 = u.pm * BM + wr * 64 + fr; const int col0 = u.pn * BM + wc * 32 + 8 * fq;
#pragma unroll
        for (int ai = 0; ai < 2; ++ai) {
            u32x4 xw[4][2];
#pragma unroll
            for (int m = 0; m < 4; ++m)
#pragma unroll
                for (int bj = 0; bj < 2; ++bj) xw[m][bj] = *(const u32x4*)(xprev + (size_t)(row0 + ai * HALF + m * 16) * 1024 + col0 + bj * HALF);
#pragma unroll
            for (int m = 0; m < 4; ++m)
#pragma unroll
                for (int bj = 0; bj < 2; ++bj) { const u32x4 w = xw[m][bj]; const f32x4 a0 = acc[ai][bj][m][0], a1 = acc[ai][bj][m][1];
                    u32x4 o;
                    o.x = cvt_pk_bf16(__uint_as_float(w.x << 16) * alpha + a0[0], __uint_as_float(w.x & 0xffff0000u) * alpha + a0[1]);
                    o.y = cvt_pk_bf16(__uint_as_float(w.y << 16) * alpha + a0[2], __uint_as_float(w.y & 0xffff0000u) * alpha + a0[3]);
                    o.z = cvt_pk_bf16(__uint_as_float(w.z << 16) * alpha + a1[0], __uint_as_float(w.z & 0xffff0000u) * alpha + a1[1]);
                    o.w = cvt_pk_bf16(__uint_as_float(w.w << 16) * alpha + a1[2], __uint_as_float(w.w & 0xffff0000u) * alpha + a1[3]);
                    *(u32x4*)(out + (size_t)(row0 + ai * HALF + m * 16) * 1024 + col0 + bj * HALF) = o; }
        }
    }
};
struct EpiSwiGLU {
    static constexpr bool PERM = true, AFTER_DRAIN = false, COLMAP2 = false; static constexpr int VMOPS = 8;
    bf16_t* H;
    __device__ __forceinline__ void operator()(const f32x4 (&acc)[2][2][4][2], const Unit& u, int wr, int wc, int fr, int fq) const {
        const int Rw0 = u.pm * BM + wr * 64, chw = (u.pn & 3) * 16 + wc * 4;
        bf16_t* base = H + fq * 128 + fr * 8;
#pragma unroll
        for (int ai = 0; ai < 2; ++ai)
#pragma unroll
            for (int m = 0; m < 4; ++m) { const int Rw = Rw0 + ai * HALF + m * 16; u32x4 w;
#pragma unroll
                for (int bj = 0; bj < 2; ++bj) { const f32x4 a = acc[ai][bj][m][0], b = acc[ai][bj][m][1]; f32x4 hv;
#pragma unroll
                    for (int i = 0; i < 4; ++i) { const float e = __builtin_amdgcn_exp2f(a[i] * -1.4426950408889634f); hv[i] = a[i] * __builtin_amdgcn_rcpf(1.0f + e) * b[i]; }
                    w[2 * bj] = cvt_pk_bf16(hv[0], hv[1]); w[2 * bj + 1] = cvt_pk_bf16(hv[2], hv[3]); }
                *(u32x4*)(base + (size_t)((Rw >> 4) * 64 + chw) * 128) = w; }
    }
};
struct EpiY {
    static constexpr bool PERM = true, AFTER_DRAIN = false, COLMAP2 = true; static constexpr int VMOPS = 16;
    bf16_t* Y;
    __device__ __forceinline__ void operator()(const f32x4 (&acc)[2][2][4][2], const Unit& u, int wr, int wc, int fr, int fq) const {
        const bool lo = fr < 8;
        bf16_t* base = Y + (size_t)(u.pm * BM + wr * 64 + (fr & 7)) * 1024 + (u.pn & 3) * BM + wc * 64 + (fr >> 3) * 32 + 8 * fq;
#pragma unroll
        for (int ai = 0; ai < 2; ++ai)
#pragma unroll
            for (int m = 0; m < 4; ++m) { u32x4 p[2];
#pragma unroll
                for (int bj = 0; bj < 2; ++bj) { const f32x4 v0 = acc[ai][bj][m][0], v1 = acc[ai][bj][m][1];
                    p[bj].x = cvt_pk_bf16(v0[0], v0[1]); p[bj].y = cvt_pk_bf16(v0[2], v0[3]); p[bj].z = cvt_pk_bf16(v1[0], v1[1]); p[bj].w = cvt_pk_bf16(v1[2], v1[3]); }
                u32x4 s1, s2;
#pragma unroll
                for (int c = 0; c < 4; ++c) { const unsigned send = lo ? p[1][c] : p[0][c];
                    const unsigned x = (unsigned)__builtin_amdgcn_update_dpp(0, (int)send, 0x128, 0xf, 0xf, false);
                    s1[c] = lo ? p[0][c] : x; s2[c] = lo ? x : p[1][c]; }
                bf16_t* rp = base + (size_t)(ai * HALF + m * 16) * 1024;
                *(u32x4*)rp = s1; *(u32x4*)(rp + 8 * 1024) = s2; }
    }
};
struct GroupedOrder {
    const PG8_LAS int* tile_e; int ntiles, G, c;
    __device__ __forceinline__ bool next(int i, Unit& u) const {
        const int L = i * G + c; if (L >= ntiles * 4) return false;
        const int pm = L >> 2; u.pm = pm; u.pn = __builtin_amdgcn_readfirstlane(tile_e[pm]) * 4 + (L & 3); return true;
    }
    __device__ __forceinline__ void a_ready(const Unit&) const {}
    __device__ __forceinline__ void done(const Unit&) const {}
};

template <class Epi, class Sched, bool ALIGN_EPI = false, bool SP2 = false, bool GATHER = false, bool AIMG = false, bool PEEL = false>
__device__ __forceinline__ void gemm_phase(PG8_LAS unsigned char* lds, const Gemm g, const Sched& S, const Epi& E) {
    int tid_ = threadIdx.x; asm volatile("" : "+v"(tid_));
    const int tid = tid_, wid = __builtin_amdgcn_readfirstlane(tid >> 6), lane = tid & 63, wr = wid >> 2, wc = wid & 3, fr = lane & 15, fq = lane >> 4;
    const int K = g.K, nt = K / BK;
    static_assert(!GATHER || SP2, "GATHER is written for the SP2 loop");
    unsigned voffA[2], voffB[2], voffA1[2], nvoA[2], nvoA1[2]; int gR[2]; unsigned gC2[2];
#pragma unroll
    for (int i = 0; i < 2; ++i) { int R, C; stage_rc(tid * 16 + i * 8192, R, C); const int Rb = Epi::COLMAP2 ? (64 * (R >> 5) + perm32(R & 31)) : Epi::PERM ? ((R & ~31) + perm32(R & 31)) : R;
        voffA[i] = AIMG ? (unsigned)(((R >> 4) * (K >> 3) + (C >> 3)) * 256 + (R & 15) * 16) : (unsigned)(R * K + C) * 2u; voffB[i] = (unsigned)(Rb * K + C) * 2u; gR[i] = R; gC2[i] = (unsigned)C * 2u; voffA1[i] = voffA[i]; nvoA[i] = voffA[i]; nvoA1[i] = voffA[i]; }
    const size_t kstep = (size_t)(BK * 2);
    const size_t kstepA = AIMG ? (size_t)2048 : kstep;
    const size_t hstep = (size_t)HALF * K * 2;
    const size_t tstep = 2 * hstep;
    const size_t hstepB = Epi::COLMAP2 ? (size_t)32 * K * 2 : hstep;
    const size_t hstepA = GATHER ? (size_t)0 : hstep;
    const unsigned ldsw = (unsigned)wid * 1024u;
    const int aoff = lds_byte(wr * 64 + fr, fq * 8), boff = lds_byte(wc * 32 + fr, fq * 8);
#define PG8_SA(b, h) (((b) * 2 + (h)) * HTB)
#define PG8_SB(b, h) ((4 + (b) * 2 + (h)) * HTB)
#define PG8_STAGE(bufoff, gbase, voff) do { _Pragma("unroll") for (int _i = 0; _i < 2; ++_i) \
        { unsigned vo_ = (voff)[_i]; asm volatile("" : "+v"(vo_));     \
        __builtin_amdgcn_global_load_lds((const unsigned*)((const char*)(gbase) + vo_), (PG8_LAS unsigned*)(lds + (bufoff) + ldsw + _i * 8192), 16, 0, 0); } } while (0)
#define PG8_LDA(dst, b, h) do { _Pragma("unroll") for (int m = 0; m < 4; ++m) _Pragma("unroll") for (int k = 0; k < 2; ++k) dst[m][k] = *(const PG8_LAS bf16x8*)(lds + PG8_SA(b, h) + aoff + m * 2048 + k * 1024); } while (0)
#define PG8_LDB(dst, b, h) do { _Pragma("unroll") for (int n = 0; n < 2; ++n) _Pragma("unroll") for (int k = 0; k < 2; ++k) dst[n][k] = *(const PG8_LAS bf16x8*)(lds + PG8_SB(b, h) + boff + n * 2048 + k * 1024); } while (0)
#define PG8_MMA(ai, bj, At, Bt) do { __builtin_amdgcn_s_setprio(1); _Pragma("unroll") for (int m = 0; m < 4; ++m) _Pragma("unroll") for (int n = 0; n < 2; ++n) _Pragma("unroll") for (int k = 0; k < 2; ++k) \
        acc[ai][bj][m][n] = __builtin_amdgcn_mfma_f32_16x16x32_bf16(Bt[n][k], At[m][k], acc[ai][bj][m][n], 0, 0, 0); __builtin_amdgcn_s_setprio(0); } while (0)
#define PG8_WAIT_V(n) asm volatile("s_waitcnt vmcnt(" #n ")" ::: "memory")
#define PG8_WAIT_VX(n) asm volatile("s_waitcnt vmcnt(%0)" :: "n"(n) : "memory")
#define PG8_WAIT_L(n) asm volatile("s_waitcnt lgkmcnt(" #n ")" ::: "memory")
#define PG8_BAR __builtin_amdgcn_s_barrier()
#define PG8_SCHED __builtin_amdgcn_sched_barrier(0)
    Unit cur, nxt; int ui = 0;
    if (!S.next(0, cur)) return;
    f32x4 acc[2][2][4][2];
#pragma unroll
    for (int a = 0; a < 2; ++a)
#pragma unroll
        for (int b = 0; b < 2; ++b)
#pragma unroll
            for (int m = 0; m < 4; ++m)
#pragma unroll
                for (int n = 0; n < 2; ++n) acc[a][b][m][n] = (f32x4){0.f, 0.f, 0.f, 0.f};
    bf16x8 At[4][2], B0[2][2], B1[2][2];
    const char* cA = GATHER ? (const char*)g.A : (const char*)g.A + (size_t)cur.pm * tstep; const char* cB = (const char*)g.Bt + (size_t)cur.pn * tstep;
    if constexpr (GATHER) {
        typedef const __attribute__((address_space(1))) int* gip_; const gip_ rix = (gip_)g.rowidx + cur.pm * BM;
        const int r0_ = rix[gR[0]], r1_ = rix[gR[1]], r2_ = rix[HALF + gR[0]], r3_ = rix[HALF + gR[1]];
        __builtin_amdgcn_sched_barrier(0);
        voffA[0] = (unsigned)r0_ * (unsigned)(K * 2) + gC2[0]; voffA[1] = (unsigned)r1_ * (unsigned)(K * 2) + gC2[1]; voffA1[0] = (unsigned)r2_ * (unsigned)(K * 2) + gC2[0]; voffA1[1] = (unsigned)r3_ * (unsigned)(K * 2) + gC2[1];
#pragma unroll
        for (int i = 0; i < 2; ++i) { nvoA[i] = voffA[i]; nvoA1[i] = voffA1[i]; } }
    S.a_ready(cur);
    if constexpr (SP2) {
        PG8_STAGE(PG8_SB(0, 0), cB, voffB); PG8_STAGE(PG8_SB(0, 1), cB + hstepB, voffB); PG8_STAGE(PG8_SA(0, 0), cA, voffA); PG8_STAGE(PG8_SA(0, 1), cA + hstepA, voffA1);
        if (wr == 1) PG8_BAR;
        PG8_WAIT_V(2); PG8_BAR;
        PG8_STAGE(PG8_SB(1, 0), cB + kstep, voffB); PG8_STAGE(PG8_SA(1, 0), cA + kstepA, voffA); PG8_STAGE(PG8_SB(1, 1), cB + hstepB + kstep, voffB);
        PG8_WAIT_V(6); PG8_BAR;
    } else {
        PG8_STAGE(PG8_SB(0, 0), cB, voffB); PG8_STAGE(PG8_SA(0, 0), cA, voffA); PG8_STAGE(PG8_SB(0, 1), cB + hstepB, voffB); PG8_STAGE(PG8_SA(0, 1), cA + hstep, voffA);
        if (wr == 1) PG8_BAR;
        PG8_WAIT_V(4); PG8_BAR;
        PG8_STAGE(PG8_SB(1, 0), cB + kstep, voffB); PG8_STAGE(PG8_SA(1, 0), cA + kstepA, voffA); PG8_STAGE(PG8_SB(1, 1), cB + hstepB + kstep, voffB);
        PG8_WAIT_V(6); PG8_BAR;
    }
    for (;;) {
        const bool has_next = S.next(ui + 1, nxt);
        const char* nA = GATHER ? (const char*)g.A : (has_next ? (const char*)g.A + (size_t)nxt.pm * tstep : cA); const char* nB = has_next ? (const char*)g.Bt + (size_t)nxt.pn * tstep : cB;
        if constexpr (GATHER) {
            if (has_next) { typedef const __attribute__((address_space(1))) int* gip_; const gip_ rix = (gip_)g.rowidx + nxt.pm * BM;
                const int r0_ = rix[gR[0]], r1_ = rix[gR[1]], r2_ = rix[HALF + gR[0]], r3_ = rix[HALF + gR[1]];
                __builtin_amdgcn_sched_barrier(0);
                nvoA[0] = (unsigned)r0_ * (unsigned)(K * 2) + gC2[0]; nvoA[1] = (unsigned)r1_ * (unsigned)(K * 2) + gC2[1]; nvoA1[0] = (unsigned)r2_ * (unsigned)(K * 2) + gC2[0]; nvoA1[1] = (unsigned)r3_ * (unsigned)(K * 2) + gC2[1]; } }
#define PG8_TRIP(WX_) do { \
            const bool last = (t == nt - 2); \
            const bool relax = (ui > 0) && (t == 0); \
            const char* a1 = cA + (size_t)(t + 1) * kstepA; \
            const char* a2 = last ? nA : cA + (size_t)(t + 2) * kstepA; const char* b2 = last ? nB : cB + (size_t)(t + 2) * kstep; \
            const char* a3 = a2 + kstepA; const char* b3 = b2 + kstep; \
            if (last && has_next) S.a_ready(nxt); \
            unsigned so0[2], so1[2]; \
_Pragma("unroll") \
            for (int i = 0; i < 2; ++i) { so0[i] = (GATHER && last) ? nvoA[i] : voffA[i]; so1[i] = (GATHER && last) ? nvoA1[i] : voffA1[i]; } \
            if constexpr (SP2) { \
            PG8_LDB(B0, 0, 0); PG8_LDB(B1, 0, 1); PG8_SCHED; PG8_LDA(At, 0, 0); PG8_STAGE(PG8_SA(1, 1), a1 + hstepA, voffA1); \
            WX_; PG8_WAIT_L(0); PG8_BAR; PG8_MMA(0, 0, At, B0); PG8_MMA(0, 1, At, B1); PG8_BAR; PG8_SCHED; \
            PG8_LDA(At, 0, 1); PG8_STAGE(PG8_SB(0, 0), b2, voffB); PG8_STAGE(PG8_SB(0, 1), b2 + hstepB, voffB); PG8_STAGE(PG8_SA(0, 0), a2, so0); \
            WX_; PG8_WAIT_L(0); PG8_BAR; PG8_MMA(1, 0, At, B0); PG8_MMA(1, 1, At, B1); PG8_BAR; PG8_SCHED; \
            PG8_LDB(B0, 1, 0); PG8_LDB(B1, 1, 1); PG8_SCHED; PG8_LDA(At, 1, 0); PG8_STAGE(PG8_SA(0, 1), a2 + hstepA, so1); \
            PG8_WAIT_V(8); PG8_WAIT_L(0); PG8_BAR; PG8_MMA(0, 0, At, B0); PG8_MMA(0, 1, At, B1); PG8_BAR; PG8_SCHED; \
            PG8_LDA(At, 1, 1); PG8_STAGE(PG8_SB(1, 0), b3, voffB); PG8_STAGE(PG8_SB(1, 1), b3 + hstepB, voffB); PG8_STAGE(PG8_SA(1, 0), a3, so0); \
            PG8_WAIT_V(8); PG8_WAIT_L(0); PG8_BAR; PG8_MMA(1, 0, At, B0); PG8_MMA(1, 1, At, B1); PG8_BAR; PG8_SCHED; \
            } else { \
            PG8_LDB(B0, 0, 0); PG8_SCHED; PG8_LDA(At, 0, 0); PG8_STAGE(PG8_SA(1, 1), a1 + hstep, voffA); \
            PG8_WAIT_L(8); PG8_BAR; PG8_WAIT_L(0); PG8_MMA(0, 0, At, B0); PG8_BAR; PG8_SCHED; \
            PG8_LDB(B1, 0, 1); PG8_STAGE(PG8_SB(0, 0), b2, voffB); \
            PG8_BAR; PG8_WAIT_L(0); PG8_MMA(0, 1, At, B1); PG8_BAR; \
            PG8_LDA(At, 0, 1); PG8_STAGE(PG8_SA(0, 0), a2, voffA); \
            PG8_BAR; PG8_WAIT_L(0); PG8_MMA(1, 0, At, B0); PG8_BAR; PG8_SCHED; \
            PG8_STAGE(PG8_SB(0, 1), b2 + hstepB, voffB); \
            PG8_WAIT_V(6); PG8_BAR; PG8_MMA(1, 1, At, B1); PG8_BAR; \
            PG8_LDB(B0, 1, 0); PG8_SCHED; PG8_LDA(At, 1, 0); PG8_STAGE(PG8_SA(0, 1), a2 + hstep, voffA); \
            PG8_WAIT_L(8); PG8_BAR; PG8_WAIT_L(0); PG8_MMA(0, 0, At, B0); PG8_BAR; PG8_SCHED; \
            PG8_LDB(B1, 1, 1); PG8_STAGE(PG8_SB(1, 0), b3, voffB); \
            PG8_BAR; PG8_WAIT_L(0); PG8_MMA(0, 1, At, B1); PG8_BAR; \
            PG8_LDA(At, 1, 1); PG8_STAGE(PG8_SA(1, 0), a3, voffA); \
            PG8_BAR; PG8_WAIT_L(0); PG8_MMA(1, 0, At, B0); PG8_BAR; PG8_SCHED; \
            PG8_STAGE(PG8_SB(1, 1), b3 + hstepB, voffB); \
            PG8_WAIT_V(6); PG8_BAR; PG8_MMA(1, 1, At, B1); PG8_BAR; \
            } \
        } while (0)
        int t = 0;
        if constexpr (PEEL) { if (SP2 && ui > 0) { PG8_TRIP(PG8_WAIT_VX(8 + Epi::VMOPS)); t = 2; } }
        for (; t < nt; t += 2) { PG8_TRIP(PG8_WAIT_V(8)); }
#undef PG8_TRIP
        if constexpr (ALIGN_EPI) { if (wr == 0) PG8_BAR; }
        if constexpr (!Epi::AFTER_DRAIN) { int t2_ = threadIdx.x; asm volatile("" : "+v"(t2_)); E(acc, cur, wr, wc, t2_ & 15, (t2_ & 63) >> 4); S.done(cur); }
        if (!has_next) break;
#pragma unroll
        for (int a = 0; a < 2; ++a)
#pragma unroll
            for (int b = 0; b < 2; ++b)
#pragma unroll
                for (int m = 0; m < 4; ++m)
#pragma unroll
                    for (int n = 0; n < 2; ++n) acc[a][b][m][n] = (f32x4){0.f, 0.f, 0.f, 0.f};
        cur = nxt; cA = nA; cB = nB; ++ui;
        if constexpr (GATHER) {
#pragma unroll
            for (int i = 0; i < 2; ++i) { voffA[i] = nvoA[i]; voffA1[i] = nvoA1[i]; } }
        if constexpr (ALIGN_EPI) { if (wr == 1) PG8_BAR; }
    }
    PG8_WAIT_V(0);
    if constexpr (!ALIGN_EPI) { if (wr == 0) PG8_BAR; }
    PG8_BAR;
    if constexpr (Epi::AFTER_DRAIN) { E.fused(acc, cur, wr, wc, fr, fq, lds, wid, lane); S.done(cur); }
#undef PG8_SA
#undef PG8_SB
#undef PG8_STAGE
#undef PG8_LDA
#undef PG8_LDB
#undef PG8_MMA
#undef PG8_WAIT_V
#undef PG8_WAIT_VX
#undef PG8_WAIT_L
#undef PG8_BAR
#undef PG8_SCHED
}
}
#define GAS __attribute__((address_space(1)))
#define LAS __attribute__((address_space(3)))
typedef unsigned short bf16;
typedef short bf16x8 __attribute__((ext_vector_type(8)));
typedef short s16x4 __attribute__((ext_vector_type(4)));
typedef short v4i16_t __attribute__((ext_vector_type(4)));
typedef float f32x4 __attribute__((ext_vector_type(4)));
typedef float f32x16 __attribute__((ext_vector_type(16)));
typedef unsigned u32x4 __attribute__((ext_vector_type(4)));
typedef unsigned u32x2 __attribute__((ext_vector_type(2)));
typedef GAS unsigned gu32;
constexpr int NB = 8, SEQ = 4096, DM = 1024, T = NB * SEQ;
constexpr int NEXP = 32, HID = 512, SLOT_ROWS = 73728, MAX_TILES = SLOT_ROWS / 256;
constexpr int NCHUNK = T / 128;
constexpr float LOG2E = 1.4426950408889634f;
constexpr float C2 = 0.125f * LOG2E;
constexpr float ALPHA = 1.4142135623730951f;
constexpr float LN_EPS = 1e-5f, RMS_EPS = 1e-6f;
constexpr float LAM_INIT = 0.2f;

namespace att {
constexpr int KSLOT = 8192, VSLOT = 16384, LDS_V = 2 * KSLOT, SBSLOT = 16384, SBRING = 6, LDS_O1S = 65536, LDS_LUT = 131072, LDS_FLG = LDS_LUT + 1280, ATT_LDS = LDS_FLG + 64, LDS_GAIN = ATT_LDS, LDS_REL = LDS_GAIN + 512;
typedef LAS const unsigned char* lcp;
__device__ __forceinline__ void glds16(const void* sbase, unsigned voff, unsigned lds_dst) { unsigned keep;
    asm volatile("s_mov_b32 %0, m0\n\ts_mov_b32 m0, %2\n\ts_nop 0\n\tglobal_load_lds_dwordx4 %1, %3\n\ts_mov_b32 m0, %0" : "=&s"(keep) : "v"(voff), "s"(lds_dst), "s"(sbase) : "memory"); }
typedef float f32x2_t __attribute__((ext_vector_type(2))); typedef __bf16 bf16x2_t __attribute__((ext_vector_type(2)));
__device__ __forceinline__ unsigned cvtpk(float lo, float hi) { f32x2_t v = {lo, hi}; bf16x2_t b = __builtin_convertvector(v, bf16x2_t); return __builtin_bit_cast(unsigned, b); }
__device__ __forceinline__ s16x4 vtr(lcp p) { return __builtin_bit_cast(s16x4, __builtin_amdgcn_ds_read_tr16_b64_v4i16((LAS v4i16_t*)p)); }
#define ATT_MFMA(a, b, c) __builtin_amdgcn_mfma_f32_32x32x16_bf16((a), (b), (c), 0, 0, 0)
__device__ __forceinline__ float max3f(float a, float b, float c) { float r; asm("v_max3_f32 %0, %1, %2, %3" : "=v"(r) : "v"(a), "v"(b), "v"(c)); return r; }
__device__ __forceinline__ float max2f(float a, float b) { float r; asm("v_max_f32_e32 %0, %1, %2" : "=v"(r) : "v"(a), "v"(b)); return r; }
__device__ __forceinline__ float fadd_s(float a, float b) { float r; asm("v_add_f32_e32 %0, %1, %2" : "=v"(r) : "v"(a), "v"(b)); return r; }

struct LateT { static constexpr bool value = true; __device__ __forceinline__ constexpr operator bool() const { return true; } }; struct LateF { static constexpr bool value = false; __device__ __forceinline__ constexpr operator bool() const { return false; } };
template <int MODE, int VAR = 0>
__device__ __forceinline__ void attn_unit(LAS unsigned char* lds, const bf16* Qb, const bf16* Kb, const bf16* Vb, bf16* Ob,
                                          int b, int qcol0, int vcol0, int qb, const float* rel_table, int h, int cmap = 0, float lam = 0.f, const float* subg = nullptr) {
    constexpr int NDQ = MODE == 0 ? 4 : 2;
    int tid_ = threadIdx.x; asm volatile("" : "+v"(tid_));
    const int tid = tid_, lane = tid & 63, r32 = lane & 31, hi = lane >> 5;
    const int wid = __builtin_amdgcn_readfirstlane(tid >> 6);
    const long rowbase = (long)b * SEQ; const int q0 = qb * 256, qw0 = q0 + wid * 32;
    const unsigned lds0 = (unsigned)(uintptr_t)lds;
    asm volatile("s_waitcnt vmcnt(0) lgkmcnt(0)\n\ts_barrier" ::: "memory");
    if (MODE == 1 && tid < 16) ((LAS int*)(lds + LDS_FLG))[tid] = 0;
    if (MODE == 0) {
        if (tid < 320) {
            const int n = tid < 64 ? 0 : tid - 64; int bk = n;
            if (n >= 16) { const float v = __logf((float)n * 0.0625f) / 2.0794415416798357f * 16.0f; bk = 16 + (int)v; bk = bk > 31 ? 31 : bk; }
            { const LAS float* relL = (const LAS float*)(lds + LDS_REL);
              ((LAS float*)(lds + LDS_LUT))[tid] = (relL[bk * 8 + h] - relL[31 * 8 + h]) * LOG2E; }
        }
    }
    const bf16* ksrc = Kb + (((long)b * 16 + (qcol0 >> 6)) * 64) * 4096 + wid * 512;
    const bf16* vsrc = Vb + (((long)b * 32 + (vcol0 >> 5) + (wid >> 2)) * 64) * 2048 + (wid & 3) * 512;
    const unsigned lane16 = (unsigned)lane * 16u;
#define ATT_KOFF(t, ii) (MODE == 0 ? ((ii) & 1) * KSLOT : ((t) % SBRING) * SBSLOT)
#define ATT_VOFF(t, ii) (MODE == 0 ? LDS_V + ((ii) % 3) * VSLOT : ((t) % SBRING) * SBSLOT + 8192)
#define ATT_DMA(t, ii) do { const long ko_ = (long)(t) * 4096, vo_ = (long)(t) * 2048; const unsigned kb_ = lds0 + (unsigned)ATT_KOFF(t, ii) + (unsigned)wid * 1024u, vb_ = lds0 + (unsigned)ATT_VOFF(t, ii) + (unsigned)wid * 1024u; \
        glds16(ksrc + ko_, lane16, (unsigned)__builtin_amdgcn_readfirstlane(kb_)); glds16(vsrc + vo_, lane16, (unsigned)__builtin_amdgcn_readfirstlane(vb_)); \
        if (MODE == 0) glds16(vsrc + vo_ + 2 * 64 * 2048, lane16, (unsigned)__builtin_amdgcn_readfirstlane(vb_ + 8192u)); } while (0)
    const int NT = 4 * qb + 4;
    const int dg = 4 * qb + (wid >> 1);
    if (VAR != 2) { if (MODE == 0) ATT_DMA(0, 0); else { ATT_DMA(NT - 1, 0); ATT_DMA(NT - 2, 0); ATT_DMA(NT - 3, 0); ATT_DMA(NT - 4, 0); } }
    bf16x8 qr[4];
    { const int sq = qw0 + r32; const bf16* Qw = Qb + ((((long)b * 16 + (qcol0 >> 6)) * 256 + (sq >> 4)) * 1024 + (sq & 15) * 8 + hi * 128);
#pragma unroll
      for (int d0 = 0; d0 < 4; ++d0) qr[d0] = *(const bf16x8*)(Qw + d0 * 256); }
    asm volatile("" : "+v"(qr[0]), "+v"(qr[1]), "+v"(qr[2]), "+v"(qr[3]));
    f32x16 o[NDQ];
#pragma unroll
    for (int d = 0; d < NDQ; ++d)
#pragma unroll
        for (int r = 0; r < 16; ++r) o[d][r] = 0.f;
    float mrun = 0.f, lrun = 0.f, Rrun = MODE == 1 ? 1.f : 0.f;
    bool anyref = false;
    const int vlane = ((lane >> 4) & 1) * 32 + (lane & 3) * 8 + (4 * hi + ((lane & 15) >> 2)) * 64;
    u32x4 pw[4]; int pvslot = LDS_V; bool pend = false; const bool late_w = wid >= 4;
#define ATT_VRD(buf, d) do { _Pragma("unroll") for (int ks = 0; ks < 4; ++ks) { buf[2 * ks] = vtr(vp_ + (d) * 4096 + ks * 1024); buf[2 * ks + 1] = vtr(vp_ + (d) * 4096 + ks * 1024 + 512); } } while (0)
#define ATT_VMM(buf, d) do { _Pragma("unroll") for (int ks = 0; ks < 4; ++ks) { const bf16x8 vf_ = (bf16x8){buf[2 * ks][0], buf[2 * ks][1], buf[2 * ks][2], buf[2 * ks][3], buf[2 * ks + 1][0], buf[2 * ks + 1][1], buf[2 * ks + 1][2], buf[2 * ks + 1][3]}; \
        o[d] = ATT_MFMA(vf_, __builtin_bit_cast(bf16x8, pw[ks]), o[d]); } } while (0)
#define ATT_PV(vs) do { lcp vp_ = (lcp)(lds + (vs)) + vlane; s16x4 va_[8], vb_[8]; \
        ATT_VRD(va_, 0); ATT_VRD(vb_, 1); __builtin_amdgcn_sched_barrier(0); ATT_VMM(va_, 0); \
        if (NDQ == 4) { ATT_VRD(va_, 2); __builtin_amdgcn_sched_barrier(0); ATT_VMM(vb_, 1); ATT_VRD(vb_, 3); __builtin_amdgcn_sched_barrier(0); ATT_VMM(va_, 2); __builtin_amdgcn_sched_barrier(0); ATT_VMM(vb_, NDQ - 1); } \
        else { __builtin_amdgcn_sched_barrier(0); ATT_VMM(vb_, 1); } } while (0)
    auto tile_loop = [&](const auto late) {
    for (int i = 0; i < NT; ++i) {
        const int t = MODE == 0 ? i : dg - i;
        asm volatile("s_waitcnt vmcnt(0) lgkmcnt(0)\n\ts_barrier" ::: "memory");
        if (MODE == 1 && i > 0) {
            const LAS int* fl = (const LAS int*)(lds + LDS_FLG) + ((i - 1) & 1) * 8;
            const int all_done = fl[0] & fl[1] & fl[2] & fl[3] & fl[4] & fl[5] & fl[6] & fl[7];
            if (__builtin_amdgcn_readfirstlane(all_done)) break;
        }
        bf16x8 kpre[8];
        if constexpr (decltype(late)::value) { const int tk_ = (MODE == 1 && t < 0) ? 0 : t; lcp kq_ = (lcp)(lds + ATT_KOFF(tk_, i)) + hi * 1024 + r32 * 16;
            _Pragma("unroll") for (int j = 0; j < 8; ++j) kpre[j] = *(LAS const bf16x8*)(kq_ + (j >> 1) * 2048 + (j & 1) * 512);
            __builtin_amdgcn_sched_barrier(0); }
        if (VAR != 2) { if (MODE == 0) { if (i + 1 < NT) ATT_DMA(i + 1, i + 1); } else if (NT - 5 - i >= 0) ATT_DMA(NT - 5 - i, 0); }
        if (VAR == 1) continue;
        if (late && pend) { ATT_PV(pvslot); pend = false; }
        const int k0 = 64 * t;
        if (MODE == 0 ? (k0 > qw0 + 31) : (t < 0)) { if (MODE == 1 && lane == 0) ((LAS int*)(lds + LDS_FLG))[(i & 1) * 8 + wid] = 1; continue; }
        lcp kp = (lcp)(lds + ATT_KOFF(t, i)) + hi * 1024 + r32 * 16;
        const int qrel = qw0 + r32 - k0 - 4 * hi;
        f32x16 p0, p1;
        if (MODE == 0) {
            const bool nearb = (qw0 - k0) < 176;
            { bf16x8 kf[8];
#pragma unroll
              for (int j = 0; j < 8; ++j) { if constexpr (decltype(late)::value) kf[j] = kpre[j]; else kf[j] = *(LAS const bf16x8*)(kp + (j >> 1) * 2048 + (j & 1) * 512); }
              __builtin_amdgcn_sched_barrier(0);
              { f32x16 z_; _Pragma("unroll") for (int r = 0; r < 16; ++r) z_[r] = 0.f; p0 = ATT_MFMA(kf[0], qr[0], z_); p1 = ATT_MFMA(kf[1], qr[0], z_); }
#pragma unroll
              for (int d0 = 1; d0 < 4; ++d0) { p0 = ATT_MFMA(kf[2 * d0], qr[d0], p0); p1 = ATT_MFMA(kf[2 * d0 + 1], qr[d0], p1); } }
            __builtin_amdgcn_sched_barrier(0);
            if (nearb) {
                unsigned lb_ = lds0 + (unsigned)LDS_LUT + 4u * (unsigned)(qrel + 5); asm volatile("" : "+v"(lb_));
                float bia[32];
#pragma unroll
                for (int r = 0; r < 16; ++r) { bia[r] = *(const LAS float*)(uintptr_t)(lb_ + 4u * (unsigned)(59 - ((r & 3) + 8 * (r >> 2)))); bia[16 + r] = *(const LAS float*)(uintptr_t)(lb_ + 4u * (unsigned)(27 - ((r & 3) + 8 * (r >> 2)))); }
                __builtin_amdgcn_sched_barrier(0);
#pragma unroll
                for (int r = 0; r < 16; ++r) { p0[r] += bia[r]; p1[r] += bia[16 + r]; }
                if (k0 + 63 > qw0) {
#pragma unroll
                    for (int r = 0; r < 16; ++r) { const int n0 = qrel - ((r & 3) + 8 * (r >> 2)), n1 = n0 - 32;
                        p0[r] = n0 >= 0 ? p0[r] : -INFINITY; p1[r] = n1 >= 0 ? p1[r] : -INFINITY; }
                }
            }
            if (anyref) {
#pragma unroll
                for (int r = 0; r < 16; ++r) { p0[r] -= mrun; p1[r] -= mrun; } }
            asm volatile("s_nop 15\n\ts_nop 7" : "+v"(p0), "+v"(p1));
            if (VAR != 3) {
            float rm;
            { float a = max3f(p0[0], p0[1], p1[0]), b = max3f(p0[2], p0[3], p1[1]); a = max3f(a, p1[2], p1[3]);
#pragma unroll
              for (int r = 4; r < 16; r += 4) { a = max3f(a, p0[r], p0[r + 1]); b = max3f(b, p0[r + 2], p0[r + 3]); a = max3f(a, p1[r], p1[r + 1]); b = max3f(b, p1[r + 2], p1[r + 3]); }
              rm = max2f(a, b);
              const auto rr = __builtin_amdgcn_permlane32_swap(__float_as_uint(rm), __float_as_uint(rm), false, false); rm = max2f(__uint_as_float(rr[0]), __uint_as_float(rr[1])); }
            if (__any(rm > 8.0f)) {
                const float dl = fmaxf(rm, 0.f); mrun += dl; const float f = __builtin_amdgcn_exp2f(-dl); lrun *= f;
                anyref = true;
#pragma unroll
                for (int r = 0; r < 16; ++r) { p0[r] -= dl; p1[r] -= dl; }
#pragma unroll
                for (int d = 0; d < NDQ; ++d)
#pragma unroll
                    for (int r = 0; r < 16; ++r) o[d][r] *= f;
            }
            float ls0 = 0.f, ls1 = 0.f;
#pragma unroll
            for (int r = 0; r < 16; ++r) { p0[r] = __builtin_amdgcn_exp2f(p0[r]); p1[r] = __builtin_amdgcn_exp2f(p1[r]); ls0 += p0[r]; ls1 += p1[r]; asm volatile("" : "+v"(ls0), "+v"(ls1)); }
            lrun += ls0 + ls1;
            } else lrun = 1.f;
        } else {
#pragma unroll
            for (int r = 0; r < 16; ++r) { p0[r] = 0.f; p1[r] = 0.f; }
            { bf16x8 kf[8];
#pragma unroll
              for (int j = 0; j < 8; ++j) { if constexpr (decltype(late)::value) kf[j] = kpre[j]; else kf[j] = *(LAS const bf16x8*)(kp + (j >> 1) * 2048 + (j & 1) * 512); }
              __builtin_amdgcn_sched_barrier(0);
#pragma unroll
              for (int d0 = 0; d0 < 4; ++d0) { p0 = ATT_MFMA(kf[2 * d0], qr[d0], p0); p1 = ATT_MFMA(kf[2 * d0 + 1], qr[d0], p1); } }
            const bool diag = (k0 + 63 >= qw0);
            f32x16 a0v, a1v;
#pragma unroll
            for (int r = 0; r < 16; ++r) { const int n0 = qrel - ((r & 3) + 8 * (r >> 2)), n1 = n0 - 32;
                const float e0 = __builtin_amdgcn_exp2f(p0[r]), e1 = __builtin_amdgcn_exp2f(p1[r]);
                float x0 = __builtin_amdgcn_rcpf(1.0f + e0), x1 = __builtin_amdgcn_rcpf(1.0f + e1);
                if (diag) { if (n0 <= 0) x0 = 1.f; if (n1 <= 0) x1 = 1.f; }
                a0v[r] = x0; a1v[r] = x1; p0[r] = 1.0f - x0; p1[r] = 1.0f - x1; }
#define ATT_GRP(av, m) ((av[4 * (m)] * av[4 * (m) + 1]) * (av[4 * (m) + 2] * av[4 * (m) + 3]))
#define ATT_XCH(v, lo_, hi_) do { const auto rr_ = __builtin_amdgcn_permlane32_swap(__float_as_uint(v), __float_as_uint(v), false, false); lo_ = __uint_as_float(rr_[0]); hi_ = __uint_as_float(rr_[1]); } while (0)
#define ATT_INGRP(av, wv, m, P0_) do { float P_ = (P0_); wv[4 * (m) + 3] *= P_; P_ *= av[4 * (m) + 3]; wv[4 * (m) + 2] *= P_; P_ *= av[4 * (m) + 2]; wv[4 * (m) + 1] *= P_; P_ *= av[4 * (m) + 1]; wv[4 * (m)] *= P_; } while (0)
#define ATT_SCAN(av, wv, C, Tt) do { \
                const float l0_ = ATT_GRP(av, 0), l1_ = ATT_GRP(av, 1), l2_ = ATT_GRP(av, 2), l3_ = ATT_GRP(av, 3); \
                float G0_, G1_, G2_, G3_, G4_, G5_, G6_, G7_; ATT_XCH(l0_, G0_, G1_); ATT_XCH(l1_, G2_, G3_); ATT_XCH(l2_, G4_, G5_); ATT_XCH(l3_, G6_, G7_); \
                const float S7_ = (C), S6_ = S7_ * G7_, S5_ = S6_ * G6_, S4_ = S5_ * G5_, S3_ = S4_ * G4_, S2_ = S3_ * G3_, S1_ = S2_ * G2_, S0_ = S1_ * G1_; \
                Tt = S0_ * G0_; \
                ATT_INGRP(av, wv, 0, hi ? S1_ : S0_); ATT_INGRP(av, wv, 1, hi ? S3_ : S2_); ATT_INGRP(av, wv, 2, hi ? S5_ : S4_); ATT_INGRP(av, wv, 3, hi ? S7_ : S6_); } while (0)
            float T1, T0;
            ATT_SCAN(a1v, p1, Rrun, T1);
            ATT_SCAN(a0v, p0, T1, T0);
#undef ATT_SCAN
#undef ATT_GRP
#undef ATT_XCH
#undef ATT_INGRP
            Rrun = T0;
            { const int dn = __all(Rrun < 3.5527137e-15f) ? 1 : 0; if (lane == 0) ((LAS int*)(lds + LDS_FLG))[(i & 1) * 8 + wid] = dn; }
        }
        pw[0] = (u32x4){cvtpk(p0[0], p0[1]), cvtpk(p0[2], p0[3]), cvtpk(p0[4], p0[5]), cvtpk(p0[6], p0[7])};
        pw[1] = (u32x4){cvtpk(p0[8], p0[9]), cvtpk(p0[10], p0[11]), cvtpk(p0[12], p0[13]), cvtpk(p0[14], p0[15])};
        pw[2] = (u32x4){cvtpk(p1[0], p1[1]), cvtpk(p1[2], p1[3]), cvtpk(p1[4], p1[5]), cvtpk(p1[6], p1[7])};
        pw[3] = (u32x4){cvtpk(p1[8], p1[9]), cvtpk(p1[10], p1[11]), cvtpk(p1[12], p1[13]), cvtpk(p1[14], p1[15])};
        pvslot = ATT_VOFF(t, i);
        if (VAR != 4) { if (late) pend = true; else ATT_PV(pvslot); } else { asm volatile("" :: "v"(pw[0]), "v"(pw[1]), "v"(pw[2]), "v"(pw[3])); }
    }
    if (late && pend) ATT_PV(pvslot);
    };
    if (late_w) tile_loop(LateT{}); else tile_loop(LateF{});
    bf16* Ow = Ob + (((rowbase + qw0 + r32) >> 4) * 128 + (vcol0 >> 3) + hi) * 128 + ((qw0 + r32) & 15) * 8;
#define ATT_OST(d, gg, w0, w1) do { const auto sx_ = __builtin_amdgcn_permlane32_swap((w0).x, (w1).x, false, false); const auto sy_ = __builtin_amdgcn_permlane32_swap((w0).y, (w1).y, false, false); \
        *(u32x4*)(Ow + (4 * (d) + 2 * (gg)) * 128) = (u32x4){sx_[0], sy_[0], sx_[1], sy_[1]}; } while (0)
    if (MODE == 0) {
        { const auto rr = __builtin_amdgcn_permlane32_swap(__float_as_uint(lrun), __float_as_uint(lrun), false, false); lrun = __uint_as_float(rr[0]) + __uint_as_float(rr[1]); }
        const float inv = 1.0f / lrun;
        LAS u32x2* stg = (LAS u32x2*)(lds + LDS_O1S + wid * 8192) + lane;
        if (cmap == 0) {
#pragma unroll
            for (int d = 0; d < NDQ; ++d)
#pragma unroll
                for (int g = 0; g < 4; ++g) { u32x2 w; w.x = cvtpk(o[d][4 * g] * inv, o[d][4 * g + 1] * inv); w.y = cvtpk(o[d][4 * g + 2] * inv, o[d][4 * g + 3] * inv); stg[(d * 4 + g) * 64] = w; }
        } else {
            float ss = 0.f;
#pragma unroll
            for (int d = 0; d < NDQ; ++d)
#pragma unroll
                for (int g = 0; g < 4; ++g) { const u32x2 w = stg[(d * 4 + g) * 64];
                    o[d][4 * g] = __uint_as_float(w.x << 16) - lam * (o[d][4 * g] * inv); o[d][4 * g + 1] = __uint_as_float(w.x & 0xffff0000u) - lam * (o[d][4 * g + 1] * inv);
                    o[d][4 * g + 2] = __uint_as_float(w.y << 16) - lam * (o[d][4 * g + 2] * inv); o[d][4 * g + 3] = __uint_as_float(w.y & 0xffff0000u) - lam * (o[d][4 * g + 3] * inv);
                    ss += (o[d][4 * g] * o[d][4 * g] + o[d][4 * g + 1] * o[d][4 * g + 1]) + (o[d][4 * g + 2] * o[d][4 * g + 2] + o[d][4 * g + 3] * o[d][4 * g + 3]); }
            { const auto rr = __builtin_amdgcn_permlane32_swap(__float_as_uint(ss), __float_as_uint(ss), false, false); ss = __uint_as_float(rr[0]) + __uint_as_float(rr[1]); }
            const float rs = (1.0f - LAM_INIT) / sqrtf(ss * (1.0f / 128.0f) + RMS_EPS);
#pragma unroll
            for (int d = 0; d < NDQ; ++d)
#pragma unroll
                for (int g2 = 0; g2 < 2; ++g2) { u32x2 w[2];
#pragma unroll
                    for (int gi = 0; gi < 2; ++gi) { const int g = 2 * g2 + gi; const f32x4 gg = *(const LAS f32x4*)((const LAS float*)(lds + LDS_GAIN) + 32 * d + 8 * g + 4 * hi);
                        w[gi].x = cvtpk(o[d][4 * g] * rs * gg[0], o[d][4 * g + 1] * rs * gg[1]); w[gi].y = cvtpk(o[d][4 * g + 2] * rs * gg[2], o[d][4 * g + 3] * rs * gg[3]); }
                    ATT_OST(d, g2, w[0], w[1]); }
        }
    } else {
#pragma unroll
        for (int d = 0; d < NDQ; ++d)
#pragma unroll
            for (int g2 = 0; g2 < 2; ++g2) { u32x2 w[2];
#pragma unroll
                for (int gi = 0; gi < 2; ++gi) { const int g = 2 * g2 + gi; w[gi].x = cvtpk(o[d][4 * g], o[d][4 * g + 1]); w[gi].y = cvtpk(o[d][4 * g + 2], o[d][4 * g + 3]); }
                ATT_OST(d, g2, w[0], w[1]); }
    }
#undef ATT_OST
#undef ATT_DMA
#undef ATT_KOFF
#undef ATT_VOFF
#undef ATT_PV
#undef ATT_VRD
#undef ATT_VMM
#undef ATT_BF
}
}
constexpr size_t MiB = 1u << 20;
constexpr size_t WS_CTL = 0, CTL_ZERO_BYTES = 1 * MiB;
constexpr size_t WS_TOK = 1 * MiB;
constexpr size_t TOK_E = WS_TOK, TOK_W = TOK_E + (size_t)T * 4, TOK_SLOT = TOK_W + (size_t)T * 8, BLKCNT = TOK_SLOT + (size_t)T * 8, EOFF = BLKCNT + (size_t)NCHUNK * 32 * 4, SLOT_TOK = EOFF + 256;
static_assert(SLOT_TOK + (size_t)SLOT_ROWS * 4 <= 2 * MiB, "router tables");
constexpr size_t WS_WQKV = 2 * MiB;
constexpr size_t WS_WO = 14 * MiB;
constexpr size_t WS_W13 = 18 * MiB;
constexpr size_t WS_W2 = 82 * MiB;
constexpr size_t WS_XB = 114 * MiB;
constexpr size_t WS_Q = 178 * MiB, WS_K = 242 * MiB, WS_V = 306 * MiB;
static_assert(WS_V - WS_K == WS_K - WS_Q, "Q | K | V at one stride");
constexpr size_t WS_O1 = 370 * MiB, WS_O2 = 434 * MiB;
constexpr size_t WS_XS = 178 * MiB;
constexpr size_t WS_H = 322 * MiB;
constexpr size_t WS_Y = 178 * MiB;
constexpr size_t WS_W13B = 434 * MiB, WS_W2B = 498 * MiB;
constexpr size_t WS_END = 538 * MiB;
static_assert(WS_Y + (size_t)SLOT_ROWS * 2048 <= WS_H && WS_H + (size_t)SLOT_ROWS * 1024 <= 434 * MiB && WS_W13B + 64 * MiB <= WS_W2B && WS_W2B + 32 * MiB <= WS_END && WS_O1 + 64 * MiB <= WS_W13B, "MoE overlay");
constexpr int CW_BAR = 4096;
constexpr int RING_BYTES = 131072;
constexpr int MISC_OFF = 147456;
constexpr int LDS_BYTES = MISC_OFF + 4096 + 256;
constexpr int MI_BAR = 0, MI_LAM = 12, MI_EOFF = 16, MI_CNT = 64, MI_TILE = 128, MI_LGT = 424, MI_PTR = 1000;
static_assert(MI_LGT >= MI_TILE + MAX_TILES && MI_PTR >= MI_LGT + 8 * 72 && (MI_PTR + 52) * 4 <= 4096 + 256 && MI_PTR % 2 == 0, "MISC map");
constexpr int NWAVES = 8;

#define XB_TMO      128
#define XB_XCNT(j)  (256  + 64 * (j))
#define XB_XSUB(j)  (1280 + 64 * (j))
#define XB_XGEN(j)  (2304 + 64 * (j))
#define XB_TOP      3328
#define XB_TOPGEN   3392
#define XCD_BAR_WORDS 3456
#define XB_SPIN_CAP (1u << 18)

__device__ __forceinline__ unsigned xb_ld(unsigned* p)              { return __hip_atomic_load(p, __ATOMIC_RELAXED, __HIP_MEMORY_SCOPE_AGENT); }
__device__ __forceinline__ unsigned xb_add(unsigned* p, unsigned v) { return __hip_atomic_fetch_add(p, v, __ATOMIC_RELAXED, __HIP_MEMORY_SCOPE_AGENT); }
__device__ __forceinline__ unsigned xb_xcc_id() { return (unsigned)__builtin_amdgcn_s_getreg((3 << 11) | 20) & 0xFu; }
#define XB_SPIN(cond, bar) do { unsigned _sp = 0; while (cond) { __builtin_amdgcn_s_sleep(1); \
    if ((++_sp & 255u) == 0u) { if (xb_ld(&(bar)[XB_TMO])) break; if (_sp > XB_SPIN_CAP) { atomicAdd(&(bar)[XB_TMO], 1u); break; } } } } while (0)

struct XcdBarrier {
    unsigned* bar; unsigned x;
    volatile LAS unsigned* st;
};

__device__ __forceinline__ XcdBarrier xcd_barrier_post(unsigned* bar, volatile LAS unsigned* st) {
    XcdBarrier b; b.bar = bar; b.x = xb_xcc_id(); b.st = st;
    if (threadIdx.x == 0) (void)xb_add(&bar[XB_XCNT(b.x)], 1u);
    return b;
}
__device__ __forceinline__ void xcd_barrier_complete(unsigned* bar, unsigned x, unsigned& nloc, unsigned& nx) {
    const unsigned G = gridDim.x * gridDim.y * gridDim.z;
    unsigned sum, cnt, mine, sp = 0u;
    for (;;) {
        sum = 0u; cnt = 0u; mine = 0u;
        unsigned cv[16];
        { const __attribute__((address_space(1))) unsigned* cb = (const __attribute__((address_space(1))) unsigned*)&bar[XB_XCNT(0)];
          asm volatile("global_load_dword %0, %16, off sc1\n\tglobal_load_dword %1, %16, off offset:256 sc1\n\tglobal_load_dword %2, %16, off offset:512 sc1\n\tglobal_load_dword %3, %16, off offset:768 sc1\n\t"
                       "global_load_dword %4, %16, off offset:1024 sc1\n\tglobal_load_dword %5, %16, off offset:1280 sc1\n\tglobal_load_dword %6, %16, off offset:1536 sc1\n\tglobal_load_dword %7, %16, off offset:1792 sc1\n\t"
                       "global_load_dword %8, %16, off offset:2048 sc1\n\tglobal_load_dword %9, %16, off offset:2304 sc1\n\tglobal_load_dword %10, %16, off offset:2560 sc1\n\tglobal_load_dword %11, %16, off offset:2816 sc1\n\t"
                       "global_load_dword %12, %16, off offset:3072 sc1\n\tglobal_load_dword %13, %16, off offset:3328 sc1\n\tglobal_load_dword %14, %16, off offset:3584 sc1\n\tglobal_load_dword %15, %16, off offset:3840 sc1\n\ts_waitcnt vmcnt(0)"
                       : "=&v"(cv[0]), "=&v"(cv[1]), "=&v"(cv[2]), "=&v"(cv[3]), "=&v"(cv[4]), "=&v"(cv[5]), "=&v"(cv[6]), "=&v"(cv[7]), "=&v"(cv[8]), "=&v"(cv[9]), "=&v"(cv[10]), "=&v"(cv[11]), "=&v"(cv[12]), "=&v"(cv[13]), "=&v"(cv[14]), "=&v"(cv[15])
                       : "v"(cb) : "memory"); }
#pragma unroll
        for (unsigned j = 0; j < 16; ++j) { const unsigned c = cv[j]; sum += c; cnt += (c > 0u) ? 1u : 0u; mine = (j == x) ? c : mine; }
        if (sum == G) break;
        __builtin_amdgcn_s_sleep(1);
        if ((++sp & 255u) == 0u) { if (xb_ld(&bar[XB_TMO])) break; if (sp > XB_SPIN_CAP) { atomicAdd(&bar[XB_TMO], 1u); break; } }
    }
    nloc = mine > 0u ? mine : 1u; nx = cnt > 0u ? cnt : 1u;
}

__device__ __forceinline__ void xcd_barrier(const XcdBarrier& b) {
    asm volatile("s_waitcnt vmcnt(0)" ::: "memory");
    __syncthreads();
    if (threadIdx.x == 0) {
        unsigned* bar = b.bar;
        __builtin_amdgcn_s_waitcnt(0);
        unsigned nloc = b.st[0], nx = b.st[1];
        if (nloc == 0u) { xcd_barrier_complete(bar, b.x, nloc, nx); b.st[0] = nloc; b.st[1] = nx; }
        const unsigned old = xb_add(&bar[XB_XSUB(b.x)], 1u);
        const unsigned gen = old / nloc;
        if (old + 1u == (gen + 1u) * nloc) {
            __builtin_amdgcn_fence(__ATOMIC_RELEASE, "agent");
            asm volatile("s_waitcnt vmcnt(0)" ::: "memory");
            const unsigned og = xb_add(&bar[XB_TOP], 1u);
            const unsigned tg = og / nx;
            if (og + 1u == (tg + 1u) * nx) xb_add(&bar[XB_TOPGEN], 1u);
            else XB_SPIN(xb_ld(&bar[XB_TOPGEN]) == tg, bar);
            __builtin_amdgcn_fence(__ATOMIC_ACQUIRE, "agent");
            xb_add(&bar[XB_XGEN(b.x)], 1u);
            asm volatile("s_waitcnt vmcnt(0)" ::: "memory");
        } else {
            XB_SPIN(xb_ld(&bar[XB_XGEN(b.x)]) == gen, bar);
            __builtin_amdgcn_fence(__ATOMIC_ACQUIRE, "agent");
            asm volatile("s_waitcnt vmcnt(0)" ::: "memory");
        }
    }
    __syncthreads();
}
#define RLX_AGENT __ATOMIC_RELAXED, __HIP_MEMORY_SCOPE_AGENT
#define LDS_WAIT() asm volatile("s_waitcnt lgkmcnt(0)" ::: "memory")
__device__ __forceinline__ unsigned f2bf(float f) { unsigned u = __builtin_bit_cast(unsigned, f); return (u + 0x7fffu + ((u >> 16) & 1u)) >> 16; }
__device__ __forceinline__ unsigned pk2(float lo, float hi) { return f2bf(lo) | (f2bf(hi) << 16); }
__device__ __forceinline__ float bflo(unsigned w) { return __uint_as_float(w << 16); }
__device__ __forceinline__ float bfhi(unsigned w) { return __uint_as_float(w & 0xffff0000u); }
template <int CTRL> __device__ __forceinline__ float dpp_f(float v) { return __builtin_bit_cast(float, __builtin_amdgcn_update_dpp(0, __builtin_bit_cast(int, v), CTRL, 0xf, 0xf, true)); }
__device__ __forceinline__ float row_sum16(float v) { v += dpp_f<0xB1>(v); v += dpp_f<0x4E>(v); v += dpp_f<0x141>(v); v += dpp_f<0x140>(v); return v; }
__device__ __forceinline__ float swap16_sum(float v) { const auto r = __builtin_amdgcn_permlane16_swap(__float_as_uint(v), __float_as_uint(v), false, false); return __uint_as_float(r[0]) + __uint_as_float(r[1]); }
__device__ __forceinline__ float swap32_sum(float v) { const auto r = __builtin_amdgcn_permlane32_swap(__float_as_uint(v), __float_as_uint(v), false, false); return __uint_as_float(r[0]) + __uint_as_float(r[1]); }
__device__ __forceinline__ float wave_sum(float v) { return swap32_sum(swap16_sum(row_sum16(v))); }
struct Frame {
    LAS unsigned char* lds; LAS int* MISC; unsigned char* ws;
    int tid, lane, wave, vcu, G, bx;
    float* out;
};
__device__ __forceinline__ Frame launder(const Frame& F0) {
    Frame F = F0;
    asm volatile("" : "+s"(F.ws), "+s"(F.out), "+s"(F.G), "+s"(F.vcu), "+s"(F.bx), "+v"(F.tid));
    F.lane = F.tid & 63; F.wave = __builtin_amdgcn_readfirstlane(F.tid >> 6);
    return F;
}
__device__ __forceinline__ const float* inp(const Frame& F, int k) {
    const unsigned long long v = ((const LAS unsigned long long*)(F.MISC + MI_PTR))[k];
    const unsigned lo = __builtin_amdgcn_readfirstlane((unsigned)v), hi = __builtin_amdgcn_readfirstlane((unsigned)(v >> 32));
    return (const float*)(((unsigned long long)hi << 32) | lo);
}

template <class RowMap>
__device__ __forceinline__ void transpose_item(const float* W, int K, int N, bf16* WT, const RowMap& rm, LAS float* scr, int item, int lane) {
    const int nblk = N / 32, kb = item / nblk, nb = item % nblk, k0 = 64 * kb, n0 = 32 * nb;
    float tv[32];
#pragma unroll
    for (int i = 0; i < 32; ++i) tv[i] = W[(size_t)(k0 + 2 * i + (lane >> 5)) * N + n0 + (lane & 31)];
#pragma unroll
    for (int i = 0; i < 32; ++i) scr[(2 * i + (lane >> 5)) * 33 + (lane & 31)] = tv[i];
    LDS_WAIT(); asm volatile("" ::: "memory");
    const int c = lane & 7;
#pragma unroll
    for (int j = 0; j < 4; ++j) { const int n = (lane >> 3) + 8 * j; const LAS float* s = scr + (8 * c) * 33 + n;
        u32x4 o; o.x = pk2(s[0 * 33], s[1 * 33]); o.y = pk2(s[2 * 33], s[3 * 33]); o.z = pk2(s[4 * 33], s[5 * 33]); o.w = pk2(s[6 * 33], s[7 * 33]);
        *(u32x4*)(WT + (size_t)rm(n0 + n) * K + k0 + 8 * c) = o; }
    LDS_WAIT(); asm volatile("" ::: "memory");
}
struct RowId { int off; __device__ __forceinline__ int operator()(int n) const { return off + n; } };
struct RowW13 { int type; __device__ __forceinline__ int operator()(int n) const { const int jh = n & 127; return 256 * (n >> 7) + 128 * ((jh >> 2) & 1) + 32 * (jh >> 5) + 8 * ((jh >> 3) & 3) + 4 * type + (jh & 3); } };

__device__ __forceinline__ void attn_weight_item(Frame& F, int it, LAS float* scr) {
    bf16* Wqkv = (bf16*)(F.ws + WS_WQKV); bf16* Wo = (bf16*)(F.ws + WS_WO);
    const int l = it >> 11, mtx = (it >> 9) & 3, r = it & 511;
    const int pk = (l == 0 ? 2 : 11) + mtx;
    const float* W = (const float*)((const LAS unsigned long long*)(F.MISC + MI_PTR))[pk];
    if (mtx < 3) transpose_item(W, 1024, 1024, Wqkv + (size_t)l * 3072 * 1024, RowId{mtx * 1024}, scr, r, F.lane);
    else transpose_item(W, 1024, 1024, Wo + (size_t)l * 1024 * 1024, RowId{0}, scr, r, F.lane);
}
__device__ __forceinline__ void phase_prologue(Frame& F) {
    LAS float* scr = (LAS float*)(F.lds + F.wave * 16384);
    const int gw = F.vcu * NWAVES + F.wave, NGW = F.G * NWAVES;
    bf16* Wqkv = (bf16*)(F.ws + WS_WQKV); bf16* Wo = (bf16*)(F.ws + WS_WO);
    for (int it = gw; it < 4 * 512; it += NGW) attn_weight_item(F, it, scr);
    const float* x = inp(F, 0); bf16* xb = (bf16*)(F.ws + WS_XB);
    { const size_t step = (size_t)F.G * 512 * 8;
      for (size_t i = (size_t)(F.bx * 512 + F.tid) * 8; i < (size_t)T * DM; i += 4 * step) {
        f32x4 a[4], b[4];
#pragma unroll
        for (int u = 0; u < 4; ++u) { a[u] = *(const f32x4*)(x + i + u * step); b[u] = *(const f32x4*)(x + i + u * step + 4); }
#pragma unroll
        for (int u = 0; u < 4; ++u) { u32x4 o; o.x = pk2(a[u][0], a[u][1]); o.y = pk2(a[u][2], a[u][3]); o.z = pk2(b[u][0], b[u][1]); o.w = pk2(b[u][2], b[u][3]); *(u32x4*)(xb + i + u * step) = o; } } }
    if (F.wave == 0) {
        const float s1 = wave_sum(inp(F, 6)[F.lane] * inp(F, 7)[F.lane]);
        const float s2 = wave_sum(inp(F, 8)[F.lane] * inp(F, 9)[F.lane]);
        if (F.lane == 0) F.MISC[MI_LAM] = __float_as_int(expf(s1) - expf(s2) + LAM_INIT); }
}
__device__ __forceinline__ void moe_weight_item(Frame& F, int layer, int it, LAS float* scr) {
    bf16* W13 = (bf16*)(F.ws + (layer == 0 ? WS_W13 : WS_W13B)); bf16* W2 = (bf16*)(F.ws + (layer == 0 ? WS_W2 : WS_W2B));
    const float* w1 = inp(F, 23) + (size_t)layer * NEXP * 1024 * 512; const float* w3 = inp(F, 24) + (size_t)layer * NEXP * 1024 * 512; const float* w2 = inp(F, 25) + (size_t)layer * NEXP * 512 * 1024;
    const int mtx = it >> 13, e = (it >> 8) & 31, r = it & 255;
    if (mtx == 0) transpose_item(w1 + (size_t)e * 1024 * 512, 1024, 512, W13 + (size_t)e * 1024 * 1024, RowW13{0}, scr, r, F.lane);
    else if (mtx == 1) transpose_item(w3 + (size_t)e * 1024 * 512, 1024, 512, W13 + (size_t)e * 1024 * 1024, RowW13{1}, scr, r, F.lane);
    else transpose_item(w2 + (size_t)e * 512 * 1024, 512, 1024, W2 + (size_t)e * 1024 * 512, RowId{0}, scr, r, F.lane);
}
constexpr int MW_ITEMS = 3 * NEXP * 256;
__device__ __forceinline__ void phase_moe_weights(Frame& F, int layer, int first = 0, int end = MW_ITEMS) {
    LAS float* scr = (LAS float*)(F.lds + F.wave * 16384);
    const int gw = F.vcu * NWAVES + F.wave, NGW = F.G * NWAVES;
    for (int it = first + gw; it < end; it += NGW) moe_weight_item(F, layer, it, scr);
}
constexpr int W2_FIRST = 2 * NEXP * 256, WIN1 = W2_FIRST - 3072, AW1_ITEMS = 4 * 512;
constexpr int WIN_ITEMS = MW_ITEMS + (W2_FIRST - WIN1) + AW1_ITEMS;
__device__ __forceinline__ void window_convert(Frame& F, int cw, int ncw) {
    LAS float* scr = (LAS float*)(F.lds + F.wave * 16384);
    for (int j = cw; j < WIN_ITEMS; j += ncw) { if (j < MW_ITEMS) moe_weight_item(F, 0, j, scr); else if (j < WIN_ITEMS - AW1_ITEMS) moe_weight_item(F, 1, j - MW_ITEMS + WIN1, scr); else attn_weight_item(F, 2048 + (j - (WIN_ITEMS - AW1_ITEMS)), scr); }
}
constexpr int UP_PER = 48, DN_PER = 24;
__device__ __forceinline__ int moe_idle_blocks(int ntiles, int G) { const int rem = (ntiles * 4) % G; return rem == 0 ? 0 : G - rem; }
__device__ __forceinline__ void moe_tail_items(Frame& F, int ntiles, int base, int per) {
    const int rem = (ntiles * 4) % F.G; if (rem == 0 || F.bx < rem) return;
    LAS float* scr = (LAS float*)(F.lds + F.wave * 16384);
    const int first = base + (F.bx - rem) * per;
    for (int it = first + F.wave; it < first + per && it < WIN1; it += NWAVES) moe_weight_item(F, 1, it, scr);
}
__device__ __forceinline__ void moe_tail_w2(Frame& F, int ntiles) {
    LAS float* scr = (LAS float*)(F.lds + F.wave * 16384);
    const int rem = (ntiles * 4) % F.G;
    if (rem == 0) { for (int it = W2_FIRST + F.bx * NWAVES + F.wave; it < MW_ITEMS; it += F.G * NWAVES) moe_weight_item(F, 1, it, scr); return; }
    if (F.bx < rem) return;
    const int idle = F.G - rem, per = (MW_ITEMS - W2_FIRST + idle - 1) / idle, first = W2_FIRST + (F.bx - rem) * per;
    for (int it = first + F.wave; it < first + per && it < MW_ITEMS; it += NWAVES) moe_weight_item(F, 1, it, scr);
}

template <int MODE, int VAR = 0, class PreFn>
__device__ __forceinline__ void phase_attention(Frame& F, PreFn pre) {
    const bf16* Q = (const bf16*)(F.ws + WS_Q); const bf16* K = (const bf16*)(F.ws + WS_K); const bf16* V = (const bf16*)(F.ws + WS_V);
    bf16* O1 = VAR ? (bf16*)F.out : (bf16*)(F.ws + WS_O1);
    const float* rel = inp(F, 1);
    if (MODE == 0) {
        const float lam = __int_as_float(F.MISC[MI_LAM]);
        const float* subg = inp(F, 10);
        if (F.tid < 256) ((LAS float*)(F.lds + att::LDS_REL))[F.tid] = rel[F.tid];
        if (F.tid < 128) ((LAS float*)(F.lds + att::LDS_GAIN))[F.tid] = subg[F.tid];
        pre();
        for (int P = F.vcu; P < 512; P += F.G) {
            const int bh = P >> 3, s = P & 7, b = bh >> 3, h = bh & 7;
#pragma unroll 1
            for (int k = 0; k < 4; ++k) {
                const int qb = k < 2 ? 15 - s : s, c = k & 1;
                att::attn_unit<0, VAR>(F.lds, Q, K, V, O1, b, 128 * h + 64 * c, 128 * h, qb, rel, h, c, lam, subg);
            }
        }
    } else {
        pre();
        for (int P = F.vcu; P < 1024; P += F.G) {
            const int bh = P >> 3, s = P & 7, b = bh >> 4, hh = bh & 15;
#pragma unroll 1
            for (int k = 0; k < 2; ++k) att::attn_unit<1, VAR>(F.lds, Q, K, V, O1, b, 64 * hh, 64 * hh, k == 0 ? 15 - s : s, rel, 0);
        }
    }
    asm volatile("s_waitcnt vmcnt(0) lgkmcnt(0)\n\ts_barrier" ::: "memory");
}
__device__ __forceinline__ void ln16(f32x4 (&v)[4], const f32x4 (&g)[4], const f32x4 (&bb)[4]) {
    float s = 0.f;
#pragma unroll
    for (int j = 0; j < 4; ++j) s += (v[j][0] + v[j][1]) + (v[j][2] + v[j][3]);
    const float mean = wave_sum(s) * (1.0f / DM); float s2 = 0.f;
#pragma unroll
    for (int j = 0; j < 4; ++j) { v[j] = v[j] - mean; s2 += (v[j][0] * v[j][0] + v[j][1] * v[j][1]) + (v[j][2] * v[j][2] + v[j][3] * v[j][3]); }
    const float rstd = 1.0f / sqrtf(wave_sum(s2) * (1.0f / DM) + LN_EPS);
#pragma unroll
    for (int j = 0; j < 4; ++j) v[j] = v[j] * rstd * g[j] + bb[j];
}
template <class PreFn>
__device__ __forceinline__ void phase_ln_router(Frame& F, int layer, PreFn pre) {
    constexpr int AROW = 2064, A_HI = 0, A_LO = 16 * AROW, RED = 2 * 16 * AROW, LGO = RED + 8 * 3 * 1024, RBIAS = LGO + 2304;
    const float* wg = inp(F, 19) + (size_t)layer * 1024 * 4; const float* we = inp(F, 21) + (size_t)layer * 1024 * 32;
    const int lane = F.lane, wave = F.wave, col = lane & 15, kq = lane >> 4;
    u32x4 bh[4][3], bl[4][3];
#pragma unroll
    for (int s = 0; s < 4; ++s)
#pragma unroll
        for (int blk = 0; blk < 3; ++blk) { const int o = 16 * blk + col; float w8[8];
#pragma unroll
            for (int j = 0; j < 8; ++j) { const int k = 128 * wave + 32 * s + 8 * kq + j; w8[j] = o < 4 ? wg[k * 4 + o] : (o < 36 ? we[k * 32 + o - 4] : 0.f); }
#pragma unroll
            for (int jp = 0; jp < 4; ++jp) { const unsigned wh = pk2(w8[2 * jp], w8[2 * jp + 1]); bh[s][blk][jp] = wh; bl[s][blk][jp] = pk2(w8[2 * jp] - bflo(wh), w8[2 * jp + 1] - bfhi(wh)); } }
    const float* bg = inp(F, 20) + layer * 4; const float* be = inp(F, 22) + layer * 32;
    const float* lg = inp(F, 15) + layer * 1024; const float* lb = inp(F, 16) + layer * 1024;
    LAS int* cnt = F.MISC + MI_CNT; const LAS float* lgv = (const LAS float*)(F.lds + LGO);
    int* tok_e = (int*)(F.ws + TOK_E); float* tok_w = (float*)(F.ws + TOK_W); int* blkcnt = (int*)(F.ws + BLKCNT);
    GAS bf16* xb = (GAS bf16*)(F.ws + WS_XB); const GAS bf16* tb = (const GAS bf16*)(F.ws + WS_Q);
    LAS float* rbL = (LAS float*)(F.lds + RBIAS);
    if (F.tid < 4) rbL[F.tid] = bg[F.tid]; else if (F.tid >= 32 && F.tid < 64) rbL[4 + F.tid - 32] = be[F.tid - 32];
    pre();
    for (int c = F.bx; c < NCHUNK; c += F.G) {
        if (F.tid < 32) cnt[F.tid] = 0;
        u32x2 ra[4], rb[4];
        { const GAS bf16* xr = tb + (size_t)(c * 128 + 2 * wave) * DM;
#pragma unroll
          for (int j = 0; j < 4; ++j) { ra[j] = *(const GAS u32x2*)(xr + 4 * lane + 256 * j); rb[j] = *(const GAS u32x2*)(xr + DM + 4 * lane + 256 * j); } }
        __syncthreads();
#pragma unroll 1
        for (int st = 0; st < 8; ++st) {
            const int tok = c * 128 + st * 16 + 2 * wave;
            f32x4 va[4], vb[4];
#pragma unroll
            for (int j = 0; j < 4; ++j) { va[j] = (f32x4){bflo(ra[j].x), bfhi(ra[j].x), bflo(ra[j].y), bfhi(ra[j].y)}; vb[j] = (f32x4){bflo(rb[j].x), bfhi(rb[j].x), bflo(rb[j].y), bfhi(rb[j].y)}; }
            { const GAS float* lgp = (const GAS float*)lg; const GAS float* lbp = (const GAS float*)lb; asm volatile("" : "+s"(lgp), "+s"(lbp));
              f32x4 gv[4], bv[4];
#pragma unroll
              for (int j = 0; j < 4; ++j) { gv[j] = *(const GAS f32x4*)(lgp + 4 * lane + 256 * j); bv[j] = *(const GAS f32x4*)(lbp + 4 * lane + 256 * j); }
              { const GAS bf16* xr = tb + (size_t)(st < 7 ? tok + 16 : tok) * DM;
#pragma unroll
                  for (int j = 0; j < 4; ++j) { ra[j] = *(const GAS u32x2*)(xr + 4 * lane + 256 * j); rb[j] = *(const GAS u32x2*)(xr + DM + 4 * lane + 256 * j); } }
              ln16(va, gv, bv); ln16(vb, gv, bv); }
#pragma unroll
            for (int j = 0; j < 4; ++j) {
                const unsigned ah0 = pk2(va[j][0], va[j][1]), ah1 = pk2(va[j][2], va[j][3]), bh0 = pk2(vb[j][0], vb[j][1]), bh1 = pk2(vb[j][2], vb[j][3]);
                *(GAS u32x2*)(xb + (size_t)tok * DM + 4 * lane + 256 * j) = (u32x2){ah0, ah1}; *(GAS u32x2*)(xb + (size_t)(tok + 1) * DM + 4 * lane + 256 * j) = (u32x2){bh0, bh1};
                const unsigned al0 = pk2(va[j][0] - bflo(ah0), va[j][1] - bfhi(ah0)), al1 = pk2(va[j][2] - bflo(ah1), va[j][3] - bfhi(ah1));
                const unsigned bl0 = pk2(vb[j][0] - bflo(bh0), vb[j][1] - bfhi(bh0)), bl1 = pk2(vb[j][2] - bflo(bh1), vb[j][3] - bfhi(bh1));
                const int ko = (4 * lane + 256 * j) * 2;
                *(LAS u32x2*)(F.lds + A_HI + (2 * wave) * AROW + ko) = (u32x2){ah0, ah1}; *(LAS u32x2*)(F.lds + A_LO + (2 * wave) * AROW + ko) = (u32x2){al0, al1};
                *(LAS u32x2*)(F.lds + A_HI + (2 * wave + 1) * AROW + ko) = (u32x2){bh0, bh1}; *(LAS u32x2*)(F.lds + A_LO + (2 * wave + 1) * AROW + ko) = (u32x2){bl0, bl1}; }
            __syncthreads();
            f32x4 acc[3];
#pragma unroll
            for (int blk = 0; blk < 3; ++blk) acc[blk] = (f32x4){0.f, 0.f, 0.f, 0.f};
#pragma unroll
            for (int s = 0; s < 4; ++s) { const int kb = (128 * wave + 32 * s + 8 * kq) * 2;
                const bf16x8 ah = *(const LAS bf16x8*)(F.lds + A_HI + col * AROW + kb), al = *(const LAS bf16x8*)(F.lds + A_LO + col * AROW + kb);
#pragma unroll
                for (int blk = 0; blk < 3; ++blk) {
                    acc[blk] = __builtin_amdgcn_mfma_f32_16x16x32_bf16(ah, __builtin_bit_cast(bf16x8, bh[s][blk]), acc[blk], 0, 0, 0);
                    acc[blk] = __builtin_amdgcn_mfma_f32_16x16x32_bf16(al, __builtin_bit_cast(bf16x8, bh[s][blk]), acc[blk], 0, 0, 0);
                    acc[blk] = __builtin_amdgcn_mfma_f32_16x16x32_bf16(ah, __builtin_bit_cast(bf16x8, bl[s][blk]), acc[blk], 0, 0, 0); } }
#pragma unroll
            for (int blk = 0; blk < 3; ++blk) *(LAS f32x4*)(F.lds + RED + ((wave * 3 + blk) * 64 + lane) * 16) = acc[blk];
            __syncthreads();
            { const int t = F.tid >> 5, oo = F.tid & 31;
              float s0 = 0.f, s1 = 0.f;
#pragma unroll
              for (int w = 0; w < 8; ++w) { s0 += *(const LAS float*)(F.lds + RED + ((w * 3 + (oo >> 4)) * 64 + (t >> 2) * 16 + (oo & 15)) * 16 + (t & 3) * 4);
                  if (oo < 4) s1 += *(const LAS float*)(F.lds + RED + ((w * 3 + 2) * 64 + (t >> 2) * 16 + oo) * 16 + (t & 3) * 4); }
              ((LAS float*)(F.lds + LGO))[t * 36 + oo] = s0; if (oo < 4) ((LAS float*)(F.lds + LGO))[t * 36 + 32 + oo] = s1; }
            __syncthreads();
            if (lane < 2) {
                const LAS float* L = lgv + 36 * (2 * wave + lane); const int mytok = tok + lane;
                float gl[4];
#pragma unroll
                for (int j = 0; j < 4; ++j) gl[j] = L[j] + rbL[j];
                int gi = 0; float gm = gl[0];
#pragma unroll
                for (int j = 1; j < 4; ++j) if (gl[j] > gm) { gm = gl[j]; gi = j; }
                float gs = 0.f;
#pragma unroll
                for (int j = 0; j < 4; ++j) gs += expf(gl[j] - gm);
                const float ggate = 1.0f / gs;
                float el[8];
#pragma unroll
                for (int j = 0; j < 8; ++j) el[j] = L[4 + 8 * gi + j] + rbL[4 + 8 * gi + j];
                int i1 = 0; float m1 = el[0];
#pragma unroll
                for (int j = 1; j < 8; ++j) if (el[j] > m1) { m1 = el[j]; i1 = j; }
                int i2 = -1; float m2 = -INFINITY;
#pragma unroll
                for (int j = 0; j < 8; ++j) if (j != i1 && el[j] > m2) { m2 = el[j]; i2 = j; }
                const float ex = expf(m2 - m1); const float wa = ggate / (1.0f + ex), wb = ggate * ex / (1.0f + ex);
                const int ea = gi * 8 + i1, eb = gi * 8 + i2;
                tok_e[mytok] = ea | (eb << 8); tok_w[2 * mytok] = wa; tok_w[2 * mytok + 1] = wb;
                __hip_atomic_fetch_add(cnt + ea, 1, __ATOMIC_RELAXED, __HIP_MEMORY_SCOPE_WORKGROUP); __hip_atomic_fetch_add(cnt + eb, 1, __ATOMIC_RELAXED, __HIP_MEMORY_SCOPE_WORKGROUP);
            }
        }
        __syncthreads();
        if (F.tid < 32) blkcnt[c * 32 + F.tid] = cnt[F.tid];
        __syncthreads();
    }
}
__device__ __forceinline__ void phase_slots(Frame& F) {
    LAS int* tab = (LAS int*)F.lds;
    const int* blkcnt = (const int*)(F.ws + BLKCNT);
    const int* tok_e = (const int*)(F.ws + TOK_E);
    const int te0 = (F.tid < 256 && F.bx < NCHUNK) ? tok_e[F.bx * 128 + (F.tid >> 1)] : 0;
    { int tv[16];
#pragma unroll
      for (int i = 0; i < 16; ++i) tv[i] = __hip_atomic_load(blkcnt + F.tid + 512 * i, RLX_AGENT);
#pragma unroll
      for (int i = 0; i < 16; ++i) tab[F.tid + 512 * i] = tv[i]; }
    __syncthreads();
    LAS int* eoff = F.MISC + MI_EOFF; LAS int* cur = F.MISC + MI_CNT;
    {
        const int e = F.tid & 31, g = F.tid >> 5; LAS int* gsum = F.MISC + MI_LGT;
        int v[16], acc = 0;
#pragma unroll
        for (int i = 0; i < 16; ++i) v[i] = tab[(16 * g + i) * 32 + e];
#pragma unroll
        for (int i = 0; i < 16; ++i) { const int t = v[i]; v[i] = acc; acc += t; }
        gsum[g * 32 + e] = acc;
        __syncthreads();
        int goff = 0;
#pragma unroll
        for (int gg = 0; gg < 16; ++gg) { const int t = gsum[gg * 32 + e]; goff += gg < g ? t : 0; }
#pragma unroll
        for (int i = 0; i < 16; ++i) tab[(16 * g + i) * 32 + e] = v[i] + goff;
        if (g == 15) cur[e] = goff + acc;
    }
    __syncthreads();
    if (F.tid < 33) {
        typedef int i32x4_ __attribute__((ext_vector_type(4))); i32x4_ cv[8];
#pragma unroll
        for (int q = 0; q < 8; ++q) cv[q] = ((const LAS i32x4_*)cur)[q];
        __builtin_amdgcn_sched_barrier(0);
        int o = 0;
#pragma unroll
        for (int q = 0; q < 8; ++q)
#pragma unroll
            for (int c4 = 0; c4 < 4; ++c4) o += (4 * q + c4 < F.tid) ? ((cv[q][c4] + 255) & ~255) : 0;
        eoff[F.tid] = o; }
    __syncthreads();
    { LAS int* tile_e = F.MISC + MI_TILE; int ntl = eoff[32] >> 8; ntl = ntl > MAX_TILES ? MAX_TILES : ntl;
      if (F.tid < ntl) { typedef int i32x4_ __attribute__((ext_vector_type(4))); i32x4_ ev[8];
#pragma unroll
          for (int q = 0; q < 8; ++q) ev[q] = ((const LAS i32x4_*)eoff)[q];
          __builtin_amdgcn_sched_barrier(0);
          int e = 0;
#pragma unroll
          for (int q = 0; q < 8; ++q)
#pragma unroll
              for (int c4 = 0; c4 < 4; ++c4) if (4 * q + c4 >= 1 && ev[q][c4] <= 256 * F.tid) e = 4 * q + c4;
          tile_e[F.tid] = e; } }
    int* slot_tok = (int*)(F.ws + SLOT_TOK);
    for (int e = F.bx; e < 32; e += F.G) for (int s = eoff[e] + cur[e] + F.tid; s < eoff[e + 1]; s += 512) slot_tok[s] = 0;
    int* tok_slot = (int*)(F.ws + TOK_SLOT);
    for (int c = F.bx; c < NCHUNK; c += F.G) {
        const int te = (c == F.bx) ? te0 : ((F.tid < 256) ? tok_e[c * 128 + (F.tid >> 1)] : 0);
        __syncthreads();
        if (F.tid < 32) cur[F.tid] = 0;
        __syncthreads();
        if (F.tid < 256) { const int tok = c * 128 + (F.tid >> 1), k = F.tid & 1; const int e = (te >> (8 * k)) & 255;
            const int pos = eoff[e] + tab[c * 32 + e] + __hip_atomic_fetch_add(cur + e, 1, __ATOMIC_RELAXED, __HIP_MEMORY_SCOPE_WORKGROUP);
            tok_slot[2 * tok + k] = pos; slot_tok[pos] = tok; }
    }
}
__device__ __forceinline__ int load_tiles(Frame& F) {
    LAS int* eoff = F.MISC + MI_EOFF;
    __syncthreads();
    int nt = eoff[32] >> 8; nt = nt > MAX_TILES ? MAX_TILES : nt;
    return __builtin_amdgcn_readfirstlane(nt);
}
template <class PreFn>
__device__ __forceinline__ void phase_moe_combine(Frame& F, int layer, PreFn pre) {
    const float* lg = inp(F, 17) + layer * 1024; const float* lb = inp(F, 18) + layer * 1024;
    f32x4 gv[4], bv[4];
#pragma unroll
    for (int j = 0; j < 4; ++j) { gv[j] = *(const f32x4*)(lg + 4 * F.lane + 256 * j); bv[j] = *(const f32x4*)(lb + 4 * F.lane + 256 * j); }
    pre();
    const float* tok_w = (const float*)(F.ws + TOK_W); const int* tok_slot = (const int*)(F.ws + TOK_SLOT);
    const bf16* Y = (const bf16*)(F.ws + WS_Y); bf16* xb = (bf16*)(F.ws + WS_XB);
    const int gw = F.vcu * NWAVES + F.wave, NGW = F.G * NWAVES;
    int slv = 0; float wvv = 0.f;
    if (2 * gw < T) { slv = __hip_atomic_load(tok_slot + 2 * (2 * gw) + (F.lane & 3), RLX_AGENT); wvv = __hip_atomic_load(tok_w + 2 * (2 * gw) + (F.lane & 3), RLX_AGENT); }
    for (int tok = 2 * gw; tok < T; tok += 2 * NGW) {
        const int ntok = tok + 2 * NGW < T ? tok + 2 * NGW : tok;
        const int nslv = __hip_atomic_load(tok_slot + 2 * ntok + (F.lane & 3), RLX_AGENT); const float nwvv = __hip_atomic_load(tok_w + 2 * ntok + (F.lane & 3), RLX_AGENT);
        const int sa0 = __builtin_amdgcn_readlane(slv, 0), sa1 = __builtin_amdgcn_readlane(slv, 1), sb0 = __builtin_amdgcn_readlane(slv, 2), sb1 = __builtin_amdgcn_readlane(slv, 3);
        float wv[4];
#pragma unroll
        for (int i = 0; i < 4; ++i) wv[i] = __uint_as_float(__builtin_amdgcn_readlane(__float_as_uint(wvv), i));
        bf16* xbr = xb + (size_t)tok * DM;
        f32x4 va[4], vb[4]; u32x2 xa[4], xc[4], ya0[4], ya1[4], yb0[4], yb1[4];
#pragma unroll
        for (int j = 0; j < 4; ++j) { const int o = 4 * F.lane + 256 * j;
            xa[j] = *(const u32x2*)(xbr + o); xc[j] = *(const u32x2*)(xbr + DM + o);
            ya0[j] = *(const u32x2*)(Y + (size_t)sa0 * DM + o); ya1[j] = *(const u32x2*)(Y + (size_t)sa1 * DM + o);
            yb0[j] = *(const u32x2*)(Y + (size_t)sb0 * DM + o); yb1[j] = *(const u32x2*)(Y + (size_t)sb1 * DM + o); }
#pragma unroll
        for (int j = 0; j < 4; ++j) {
            va[j][0] = ALPHA * bflo(xa[j].x) + (wv[0] * bflo(ya0[j].x) + wv[1] * bflo(ya1[j].x)); va[j][1] = ALPHA * bfhi(xa[j].x) + (wv[0] * bfhi(ya0[j].x) + wv[1] * bfhi(ya1[j].x));
            va[j][2] = ALPHA * bflo(xa[j].y) + (wv[0] * bflo(ya0[j].y) + wv[1] * bflo(ya1[j].y)); va[j][3] = ALPHA * bfhi(xa[j].y) + (wv[0] * bfhi(ya0[j].y) + wv[1] * bfhi(ya1[j].y));
            vb[j][0] = ALPHA * bflo(xc[j].x) + (wv[2] * bflo(yb0[j].x) + wv[3] * bflo(yb1[j].x)); vb[j][1] = ALPHA * bfhi(xc[j].x) + (wv[2] * bfhi(yb0[j].x) + wv[3] * bfhi(yb1[j].x));
            vb[j][2] = ALPHA * bflo(xc[j].y) + (wv[2] * bflo(yb0[j].y) + wv[3] * bflo(yb1[j].y)); vb[j][3] = ALPHA * bfhi(xc[j].y) + (wv[2] * bfhi(yb0[j].y) + wv[3] * bfhi(yb1[j].y)); }
        ln16(va, gv, bv); ln16(vb, gv, bv);
#pragma unroll
        for (int j = 0; j < 4; ++j) { const int o = 4 * F.lane + 256 * j;
            if (layer == 0) { u32x2 w; w.x = pk2(va[j][0], va[j][1]); w.y = pk2(va[j][2], va[j][3]); *(u32x2*)(xbr + o) = w;
                w.x = pk2(vb[j][0], vb[j][1]); w.y = pk2(vb[j][2], vb[j][3]); *(u32x2*)(xbr + DM + o) = w; }
            else { float* xr = F.out + (size_t)tok * DM; *(f32x4*)(xr + o) = va[j]; *(f32x4*)(xr + DM + o) = vb[j]; } }
        slv = nslv; wvv = nwvv;
    }
}
constexpr int NPH = 19;
#ifndef PROBE_QKV
#define PROBE_QKV 0
#endif
#ifndef NCVG
#define NCVG 8
#endif
#ifndef REP_QKV
#define REP_QKV 1
#endif
#ifndef PROBE_DA
#define PROBE_DA 0
#endif
#ifndef REP_SB
#define REP_SB 1
#endif
#ifndef REP_UP
#define REP_UP 1
#endif
#ifndef REP_DOWN
#define REP_DOWN 1
#endif
#ifndef REP_PRO
#define REP_PRO 1
#endif
#ifndef REP_WO
#define REP_WO 1
#endif
#ifndef REP_LNR
#define REP_LNR 1
#endif
#ifndef REP_SLOTS
#define REP_SLOTS 1
#endif
#ifndef REP_COMB1
#define REP_COMB1 1
#endif
#ifndef REP_MW1
#define REP_MW1 1
#endif
#ifndef MK_SPLIT
#define MK_SPLIT 0
#endif
struct Args { const float* in[26]; float* out; unsigned char* ws; int ph_lo, ph_hi, li, pad; };
__global__ void __launch_bounds__(NWAVES * 64, 2) fwd(Args args) {
    extern __shared__ __attribute__((aligned(16))) unsigned char lds_raw[];
    Frame F;
    F.lds = (LAS unsigned char*)lds_raw; F.MISC = (LAS int*)(F.lds + MISC_OFF); F.ws = args.ws; F.out = args.out;
    F.tid = threadIdx.x; F.lane = F.tid & 63; F.wave = __builtin_amdgcn_readfirstlane(F.tid >> 6);
    F.G = gridDim.x; F.bx = blockIdx.x; F.vcu = (F.G % 8 == 0) ? (F.bx % 8) * (F.G / 8) + F.bx / 8 : F.bx;
    if (F.tid < 64) F.MISC[F.tid] = 0;
    if (F.tid == 0) {
#pragma unroll
        for (int i = 0; i < 26; ++i) ((LAS unsigned long long*)(F.MISC + MI_PTR))[i] = (unsigned long long)args.in[i];
    }
    __syncthreads();
    XcdBarrier bar = xcd_barrier_post((unsigned*)(F.ws + WS_CTL) + CW_BAR + args.li * XCD_BAR_WORDS, (volatile LAS unsigned*)(F.MISC + MI_BAR));
    const int lo = args.ph_lo, hi = args.ph_hi;
#define IN(k) (lo <= (k) && (k) < hi)
#ifndef SKEW_SLEEP
#define SKEW_SLEEP 0
#endif
#define PHASE_SKEW(P) do { if (SKEW_SLEEP) { const int g_ = ((P).bx >> 3) & 7; for (int i_ = 0; i_ < g_; ++i_) __builtin_amdgcn_s_sleep(SKEW_SLEEP); } } while (0)
#define SEAM(k) do { if ((k) + 1 < hi) { XcdBarrier b_ = bar; asm volatile("" : "+s"(b_.bar), "+s"(b_.x)); xcd_barrier(b_); } } while (0)
    if (IN(0)) { Frame P = launder(F); for (int rep = 0; rep < REP_PRO; ++rep) { phase_prologue(P); } SEAM(0); }
#pragma unroll 1
    for (int l = 0; l < 2; ++l) {
        const int pb = 1 + 9 * l;
        if (IN(pb + 0)) { Frame P = launder(F);
            pg8::Gemm g{(const bf16*)(P.ws + WS_XB), (const bf16*)(P.ws + WS_WQKV) + (size_t)l * 3072 * 1024, T, 3072, 1024, nullptr}; pg8::StaticOrder S;
            bool conv = false; { int G2 = P.G, c2 = P.bx;
              if (l == 0) { const int ng = P.G >> 3, ncvg = ((P.G & 7) == 0 && ng >= 2 * NCVG) ? NCVG : 0;
                if (ncvg == 0) window_convert(P, P.bx * NWAVES + P.wave, P.G * NWAVES);
                else { const int grp = P.bx >> 3, ncb = grp * ncvg / ng; conv = ((grp + 1) * ncvg / ng) != ncb; G2 = P.G - 8 * ncvg; c2 = (grp - ncb) * 8 + (P.bx & 7);
                       if (conv) window_convert(P, (ncb * 8 + (P.bx & 7)) * NWAVES + P.wave, 8 * ncvg * NWAVES); } }
              S.init(T, 3072, G2, c2); }
            pg8::EpiQKV E{(bf16*)(P.ws + WS_Q), (size_t)(WS_K - WS_Q) / 2, C2};
            if (PROBE_QKV) { pg8::EpiQKV_<PROBE_QKV> E2{(bf16*)(P.ws + WS_Q), (size_t)(WS_K - WS_Q) / 2, C2}; if (PROBE_QKV != 4 || (P.bx & 1) == 0) pg8::gemm_phase<pg8::EpiQKV_<PROBE_QKV>, pg8::StaticOrder, true, true>(P.lds, g, S, E2); }
            PHASE_SKEW(P);
            if (!conv) for (int rep = 0; rep < REP_QKV; ++rep) pg8::gemm_phase<pg8::EpiQKV, pg8::StaticOrder, true, true, false, false, true>(P.lds, g, S, E);
            if (!IN(pb + 1)) SEAM(pb + 0);
        }
        if (IN(pb + 1)) { Frame P = launder(F);
            const bool seam0 = IN(pb + 0); auto pre0 = [&]() { if (seam0) SEAM(pb + 0); };
            if (l == 0) phase_attention<0, 0>(P, pre0); else phase_attention<1, 0>(P, pre0);
            SEAM(pb + 1);
        }
        if (IN(pb + 3)) { Frame P = launder(F);
            pg8::Gemm g{(const bf16*)(P.ws + WS_O1), (const bf16*)(P.ws + WS_WO) + (size_t)l * 1024 * 1024, T, 1024, 1024, nullptr}; pg8::StaticOrder S; S.init(T, 1024, P.G, P.bx);
            pg8::EpiRes E{(const bf16*)(P.ws + WS_XB), (bf16*)(P.ws + WS_Q), ALPHA};
            PHASE_SKEW(P);
            for (int rep = 0; rep < REP_WO; ++rep) pg8::gemm_phase<pg8::EpiRes, pg8::StaticOrder, true, true, false, true, true>(P.lds, g, S, E);
            if (!IN(pb + 4)) SEAM(pb + 3);
        }
        if (IN(pb + 4)) { Frame P = launder(F); const bool seam3 = IN(pb + 3); phase_ln_router(P, l, [&]() { if (seam3) SEAM(pb + 3); }); SEAM(pb + 4); }
        if (IN(pb + 5)) { Frame P = launder(F); for (int rep = 0; rep < REP_SLOTS; ++rep) phase_slots(P); SEAM(pb + 5); }
        if (IN(pb + 6)) { Frame P = launder(F);
            const int nt = load_tiles(P);
            pg8::Gemm g{(const bf16*)(P.ws + WS_XB), (const bf16*)(P.ws + (l == 0 ? WS_W13 : WS_W13B)), SLOT_ROWS, 1024, 1024, (const int*)(P.ws + SLOT_TOK)};     pg8::GroupedOrder S{P.MISC + MI_TILE, nt, P.G, P.bx};
            pg8::EpiSwiGLU E{(bf16*)(P.ws + WS_H)};
            PHASE_SKEW(P);
            for (int rep = 0; rep < REP_UP; ++rep) pg8::gemm_phase<pg8::EpiSwiGLU, pg8::GroupedOrder, true, true, true>(P.lds, g, S, E);
            if (l == 0) moe_tail_items(P, nt, 0, UP_PER); else moe_tail_w2(P, nt);
            SEAM(pb + 6);
        }
        if (IN(pb + 7)) { Frame P = launder(F);
            const int nt = load_tiles(P);
            pg8::Gemm g{(const bf16*)(P.ws + WS_H), (const bf16*)(P.ws + (l == 0 ? WS_W2 : WS_W2B)), SLOT_ROWS, 1024, 512, nullptr}; pg8::GroupedOrder S{P.MISC + MI_TILE, nt, P.G, P.bx};
            pg8::EpiY E{(bf16*)(P.ws + WS_Y)};
            PHASE_SKEW(P);
            for (int rep = 0; rep < REP_DOWN; ++rep) pg8::gemm_phase<pg8::EpiY, pg8::GroupedOrder, true, true, false, true, true>(P.lds, g, S, E);
            if (l == 0) moe_tail_items(P, nt, moe_idle_blocks(nt, P.G) * UP_PER, DN_PER);
            if (!IN(pb + 8)) SEAM(pb + 7);
        }
        if (IN(pb + 8)) { Frame P = launder(F); const bool seam7 = IN(pb + 7); phase_moe_combine(P, l, [&]() { if (seam7) SEAM(pb + 7); }); if (l == 0) { const int nt = load_tiles(P); for (int rep = 0; rep < REP_MW1; ++rep) phase_moe_weights(P, 1, moe_idle_blocks(nt, P.G) * (UP_PER + DN_PER), WIN1); } SEAM(pb + 8); }
    }
#undef IN
#undef SEAM
}

extern "C" void kernel_launch(void* const* d_in, const int* in_sizes, int n_in, void* d_out, int out_size, void* d_ws, size_t ws_size, hipStream_t stream) {
    static int grid = 0;
    if (grid == 0) {
        if (n_in != 26 || in_sizes[0] != T * DM || out_size != T * DM || ws_size < WS_END) { fprintf(stderr, "kernel_launch: unexpected shapes / workspace (n_in %d, ws %zu); nothing launched\n", n_in, ws_size); grid = -1; return; }
        int dev = 0, cus = 0, per_cu = 0;
        if (hipGetDevice(&dev) != hipSuccess || hipDeviceGetAttribute(&cus, hipDeviceAttributeMultiprocessorCount, dev) != hipSuccess) { grid = -1; return; }
        if (hipFuncSetAttribute((const void*)fwd, hipFuncAttributeMaxDynamicSharedMemorySize, LDS_BYTES) != hipSuccess) { fprintf(stderr, "kernel_launch: hipFuncSetAttribute failed\n"); grid = -1; return; }
        if (hipOccupancyMaxActiveBlocksPerMultiprocessor(&per_cu, (const void*)fwd, NWAVES * 64, LDS_BYTES) != hipSuccess || per_cu < 1) { fprintf(stderr, "kernel_launch: occupancy query says %d\n", per_cu); }
        (void)hipGetLastError();
        grid = cus;
    }
    if (grid < 0) return;
    if (hipMemsetAsync((char*)d_ws + WS_CTL + (size_t)CW_BAR * 4, 0, (size_t)(MK_SPLIT ? NPH : 1) * XCD_BAR_WORDS * 4, stream) != hipSuccess) return;
    Args a{};
    for (int i = 0; i < 26; ++i) a.in[i] = (const float*)d_in[i];
    a.out = (float*)d_out; a.ws = (unsigned char*)d_ws; a.pad = 0;
#if MK_SPLIT
    int li = 0;
    for (int p = 0; p < NPH; ++p) { if (p == 1 + 9 + 2) continue; a.ph_lo = p; a.ph_hi = p + 1; a.li = li++; hipLaunchKernelGGL(fwd, dim3(grid), dim3(NWAVES * 64), LDS_BYTES, stream, a); }
#else
    a.ph_lo = 0; a.ph_hi = NPH; a.li = 0;
    hipLaunchKernelGGL(fwd, dim3(grid), dim3(NWAVES * 64), LDS_BYTES, stream, a);
#endif
}
```
